# Optimizing an MI355X kernel written in HIP

```python
import math
import jax
import jax.numpy as jnp
from jax import lax
import numpy as np


D_MODEL = 1024
BATCH = 8
SEQ = 4096
DEPTH = 4

GRID_W = 64
CTX_LEN = 256

HEAD_DIM = 128
N_Q_HEADS = 8
N_KV_HEADS = 2
GQA_GROUP = N_Q_HEADS // N_KV_HEADS
ATTN_WIDTH = N_Q_HEADS * HEAD_DIM
KV_WIDTH = N_KV_HEADS * HEAD_DIM
Q_BLOCK = 128
ROPE_THETA = 10000.0
ROPE_FREQS = HEAD_DIM // 4
ATTN_SCALE = HEAD_DIM ** -0.5

SSM_WIDTH = D_MODEL // 2
SSM_GROUP = 16
SSM_GROUPS = SSM_WIDTH // SSM_GROUP
SSM_STATE = 64
DT_MIN = 0.001
DT_MAX = 0.1

IN_SPLITS = (ATTN_WIDTH,
             ATTN_WIDTH + KV_WIDTH,
             ATTN_WIDTH + 2 * KV_WIDTH,
             ATTN_WIDTH + 2 * KV_WIDTH + SSM_WIDTH,
             ATTN_WIDTH + 2 * KV_WIDTH + SSM_WIDTH + D_MODEL)
IN_WIDTH = ATTN_WIDTH + 2 * KV_WIDTH + SSM_WIDTH + 2 * D_MODEL

PEER_HEADS = 8
PEER_N_KEYS = 128
PEER_N_EXPERTS = PEER_N_KEYS ** 2
PEER_QUERY_DIM = 256
PEER_HALF = PEER_QUERY_DIM // 2
PEER_TOPK = 16
PEER_CHUNK = 128

N_MOD = 6
EPS = 1e-6

kernel_name = 'hybrid_gqa_s5_peer_diffusion_block'


def rms_norm(x, g):
    xf = x.astype(jnp.float32)
    y = xf * lax.rsqrt(jnp.mean(xf * xf, axis=-1, keepdims=True) + EPS)
    return (y * g.astype(jnp.float32)).astype(x.dtype)


def modulate(x, shift, scale):
    return x * (1.0 + scale) + shift


def rope_1d(x, ang):
    x1, x2 = jnp.split(x, 2, axis=-1)
    cos = jnp.cos(ang)[:, None, :].astype(x.dtype)
    sin = jnp.sin(ang)[:, None, :].astype(x.dtype)
    return jnp.concatenate([x1 * cos - x2 * sin, x1 * sin + x2 * cos], axis=-1)


def axial_rope(x, ang_row, ang_col):
    x_row, x_col = jnp.split(x, 2, axis=-1)
    return jnp.concatenate([rope_1d(x_row, ang_row), rope_1d(x_col, ang_col)], axis=-1)


def split_heads(t, n_heads):
    return t.reshape(t.shape[0], t.shape[1], n_heads, HEAD_DIM)


def gqa_attend(q, k, v):
    s = jnp.einsum('bqkgd,bskd->bkgqs', q, k).astype(jnp.float32) * ATTN_SCALE
    p = jax.nn.softmax(s, axis=-1).astype(v.dtype)
    return jnp.einsum('bkgqs,bskd->bqkgd', p, v)


def latent_attention(q, k_all, v_all):
    bsz, n = q.shape[:2]
    nb = n // Q_BLOCK
    qb = q.reshape(bsz, nb, Q_BLOCK, N_KV_HEADS, GQA_GROUP, HEAD_DIM).transpose(1, 0, 2, 3, 4, 5)
    o = lax.map(lambda blk: gqa_attend(blk, k_all, v_all), qb)
    return o.transpose(1, 0, 2, 3, 4, 5).reshape(bsz, n, ATTN_WIDTH)


def _cmul(ar, ai, br, bi):
    return ar * br - ai * bi, ar * bi + ai * br


def _scan_combine(e_i, e_j):
    ai_r, ai_i, bi_r, bi_i = e_i
    aj_r, aj_i, bj_r, bj_i = e_j
    a_r, a_i = _cmul(aj_r, aj_i, ai_r, ai_i)
    t_r, t_i = _cmul(aj_r, aj_i, bi_r, bi_i)
    return a_r, a_i, t_r + bj_r, t_i + bj_i


def s5_discretise(a_re, a_im, log_dt, b_re, b_im):
    a_re = a_re.astype(jnp.float32)
    a_im = a_im.astype(jnp.float32)
    dt = jnp.exp(log_dt.astype(jnp.float32))[:, None]
    mag = jnp.exp(a_re * dt)
    ab_r = mag * jnp.cos(a_im * dt)
    ab_i = mag * jnp.sin(a_im * dt)
    den = a_re * a_re + a_im * a_im
    nr, ni = ab_r - 1.0, ab_i
    k_r = (nr * a_re + ni * a_im) / den
    k_i = (ni * a_re - nr * a_im) / den
    bb_r, bb_i = _cmul(k_r[..., None], k_i[..., None],
                       b_re.astype(jnp.float32), b_im.astype(jnp.float32))
    return ab_r, ab_i, bb_r, bb_i


def s5_scan(u, ab_r, ab_i, bb_r, bb_i, h0, reverse):
    bu_r = jnp.einsum('blgp,gnp->lbgn', u, bb_r)
    bu_i = jnp.einsum('blgp,gnp->lbgn', u, bb_i)
    if h0 is not None:
        first = -1 if reverse else 0
        s_r, s_i = _cmul(ab_r, ab_i, h0[0], h0[1])
        bu_r = bu_r.at[first].add(s_r)
        bu_i = bu_i.at[first].add(s_i)
    length = u.shape[1]
    a_r = jnp.broadcast_to(ab_r[None, None], (length, 1) + ab_r.shape)
    a_i = jnp.broadcast_to(ab_i[None, None], (length, 1) + ab_i.shape)
    _, _, h_r, h_i = lax.associative_scan(_scan_combine, (a_r, a_i, bu_r, bu_i),
                                          reverse=reverse, axis=0)
    return h_r, h_i


def s5_readout(c_re, c_im, h_r, h_i):
    return (jnp.einsum('gpn,lbgn->blgp', c_re.astype(jnp.float32), h_r)
            - jnp.einsum('gpn,lbgn->blgp', c_im.astype(jnp.float32), h_i))


def s5_output(y, u, d_skip, w_glu, b_glu):
    bsz, n = u.shape[:2]
    y = y.reshape(bsz, n, SSM_WIDTH).astype(u.dtype) + d_skip * u
    y = jax.nn.gelu(y)
    return y * jax.nn.sigmoid(y @ w_glu + b_glu)


def s5_mixer(u_ctx, u_lat, a_re, a_im, log_dt, b_re, b_im, c_re, c_im,
             d_skip, w_glu, b_glu, ctx_out):
    bsz, n_lat = u_lat.shape[:2]
    n_ctx = u_ctx.shape[1]
    uc = u_ctx.astype(jnp.float32).reshape(bsz, n_ctx, SSM_GROUPS, SSM_GROUP)
    ul = u_lat.astype(jnp.float32).reshape(bsz, n_lat, SSM_GROUPS, SSM_GROUP)
    ys_lat, ys_ctx = [], []
    for d, reverse in enumerate((False, True)):
        disc = s5_discretise(a_re[d], a_im[d], log_dt[d], b_re[d], b_im[d])
        hc_r, hc_i = s5_scan(uc, *disc, None, reverse)
        end = 0 if reverse else -1
        hl_r, hl_i = s5_scan(ul, *disc, (hc_r[end], hc_i[end]), reverse)
        ys_lat.append(s5_readout(c_re[d], c_im[d], hl_r, hl_i))
        if ctx_out:
            ys_ctx.append(s5_readout(c_re[d], c_im[d], hc_r, hc_i))
    y_lat = s5_output(ys_lat[0] + ys_lat[1], u_lat, d_skip, w_glu, b_glu)
    y_ctx = s5_output(ys_ctx[0] + ys_ctx[1], u_ctx, d_skip, w_glu, b_glu) if ctx_out else None
    return y_lat, y_ctx


def branch_merge(attn, ssm, gate_a, gate_s, w_ba, w_bs, w_o):
    y = jax.nn.sigmoid(gate_a) * (attn @ w_ba) + jax.nn.sigmoid(gate_s) * (ssm @ w_bs)
    return y @ w_o


def peer_ffn(x, w_q, keys, u_tab, v_tab):
    shape = x.shape
    chunks = x.reshape(-1, PEER_CHUNK, D_MODEL)

    def one_chunk(xc):
        q = (xc @ w_q).reshape(PEER_CHUNK, PEER_HEADS, 2, PEER_HALF)
        s = jnp.einsum('thpd,pkd->thpk', q, keys).astype(jnp.float32)
        s_top, i_top = lax.top_k(s, PEER_TOPK)
        cand = (s_top[:, :, 0, :, None] + s_top[:, :, 1, None, :]).reshape(
            PEER_CHUNK, PEER_HEADS, PEER_TOPK * PEER_TOPK)
        best, pos = lax.top_k(cand, PEER_TOPK)
        i1 = jnp.take_along_axis(i_top[:, :, 0], pos // PEER_TOPK, axis=-1)
        i2 = jnp.take_along_axis(i_top[:, :, 1], pos % PEER_TOPK, axis=-1)
        expert = i1 * PEER_N_KEYS + i2
        g = jax.nn.softmax(best, axis=-1).astype(xc.dtype)
        u_e = u_tab[expert]
        v_e = v_tab[expert]
        act = jax.nn.gelu(jnp.einsum('thkd,td->thk', u_e, xc))
        return jnp.einsum('thk,thkd->td', g * act, v_e)

    return lax.map(one_chunk, chunks).reshape(shape)


def setup_inputs(seed: int = 0) -> dict:
    key = jax.random.key(seed)
    ks = iter(jax.random.split(key, 32))

    def nrm(shape, scale):
        return jax.random.normal(next(ks), shape, jnp.float32) * scale

    L = DEPTH
    x = nrm((BATCH, SEQ, D_MODEL), 1.0)
    c = nrm((BATCH, D_MODEL), 1.0)
    ctx = nrm((BATCH, CTX_LEN, D_MODEL), 1.0)
    c_ctx = nrm((D_MODEL,), 1.0)
    w_mod = nrm((L, D_MODEL, N_MOD * D_MODEL), 0.5 * D_MODEL ** -0.5)
    b_mod = nrm((L, N_MOD * D_MODEL), 0.02)
    norm_mix_g = 1.0 + nrm((L, D_MODEL), 0.02)
    w_in = nrm((L, D_MODEL, IN_WIDTH), D_MODEL ** -0.5)
    q_norm_g = 1.0 + nrm((L, HEAD_DIM), 0.02)
    k_norm_g = 1.0 + nrm((L, HEAD_DIM), 0.02)
    ssm_a_re = -0.5 + nrm((L, 2, SSM_GROUPS, SSM_STATE), 0.01)
    ssm_a_im = (jnp.pi * jnp.arange(SSM_STATE, dtype=jnp.float32)
                + nrm((L, 2, SSM_GROUPS, SSM_STATE), 0.01))
    ssm_log_dt = jax.random.uniform(next(ks), (L, 2, SSM_GROUPS), jnp.float32,
                                    minval=math.log(DT_MIN), maxval=math.log(DT_MAX))
    ssm_b_re = nrm((L, 2, SSM_GROUPS, SSM_STATE, SSM_GROUP), (2 * SSM_GROUP) ** -0.5)
    ssm_b_im = nrm((L, 2, SSM_GROUPS, SSM_STATE, SSM_GROUP), (2 * SSM_GROUP) ** -0.5)
    ssm_c_re = nrm((L, 2, SSM_GROUPS, SSM_GROUP, SSM_STATE), SSM_STATE ** -0.5)
    ssm_c_im = nrm((L, 2, SSM_GROUPS, SSM_GROUP, SSM_STATE), SSM_STATE ** -0.5)
    ssm_d = nrm((L, SSM_WIDTH), 0.5)
    w_glu = nrm((L, SSM_WIDTH, SSM_WIDTH), SSM_WIDTH ** -0.5)
    b_glu = nrm((L, SSM_WIDTH), 0.02)
    w_branch_attn = nrm((L, ATTN_WIDTH, D_MODEL), ATTN_WIDTH ** -0.5)
    w_branch_ssm = nrm((L, SSM_WIDTH, D_MODEL), SSM_WIDTH ** -0.5)
    w_out = nrm((L, D_MODEL, D_MODEL), D_MODEL ** -0.5)
    norm_ffn_g = 1.0 + nrm((L, D_MODEL), 0.02)
    peer_w_q = nrm((L, D_MODEL, PEER_HEADS * PEER_QUERY_DIM), D_MODEL ** -0.5)
    peer_keys = nrm((L, 2, PEER_N_KEYS, PEER_HALF), PEER_HALF ** -0.5)
    peer_u = nrm((L, PEER_N_EXPERTS, D_MODEL), D_MODEL ** -0.5)
    peer_v = nrm((L, PEER_N_EXPERTS, D_MODEL), 0.5)
    return {'x': x, 'c': c, 'ctx': ctx, 'c_ctx': c_ctx,
            'w_mod': w_mod, 'b_mod': b_mod, 'norm_mix_g': norm_mix_g, 'w_in': w_in,
            'q_norm_g': q_norm_g, 'k_norm_g': k_norm_g,
            'ssm_a_re': ssm_a_re, 'ssm_a_im': ssm_a_im, 'ssm_log_dt': ssm_log_dt,
            'ssm_b_re': ssm_b_re, 'ssm_b_im': ssm_b_im, 'ssm_c_re': ssm_c_re, 'ssm_c_im': ssm_c_im,
            'ssm_d': ssm_d, 'w_glu': w_glu, 'b_glu': b_glu,
            'w_branch_attn': w_branch_attn, 'w_branch_ssm': w_branch_ssm, 'w_out': w_out,
            'norm_ffn_g': norm_ffn_g, 'peer_w_q': peer_w_q, 'peer_keys': peer_keys,
            'peer_u': peer_u, 'peer_v': peer_v}


def reference(x, c, ctx, c_ctx, w_mod, b_mod, norm_mix_g, w_in, q_norm_g, k_norm_g,
              ssm_a_re, ssm_a_im, ssm_log_dt, ssm_b_re, ssm_b_im, ssm_c_re, ssm_c_im,
              ssm_d, w_glu, b_glu, w_branch_attn, w_branch_ssm, w_out, norm_ffn_g,
              peer_w_q, peer_keys, peer_u, peer_v):
    bsz, n_lat, _ = x.shape
    n_ctx = ctx.shape[1]
    ROWS = n_lat // GRID_W
    row = jnp.repeat(jnp.arange(ROWS), GRID_W)
    col = jnp.tile(jnp.arange(GRID_W), ROWS)
    inv_freq = ROPE_THETA ** (-jnp.arange(ROPE_FREQS, dtype=jnp.float32) / ROPE_FREQS)
    ang_row = row.astype(jnp.float32)[:, None] * inv_freq
    ang_col = col.astype(jnp.float32)[:, None] * inv_freq

    h_lat, h_ctx = x, ctx
    for i in range(DEPTH):
        last = i == DEPTH - 1
        mod_l = [m[:, None, :] for m in jnp.split(jax.nn.silu(c) @ w_mod[i] + b_mod[i], N_MOD, axis=-1)]
        mod_c = jnp.split(jax.nn.silu(c_ctx) @ w_mod[i] + b_mod[i], N_MOD, axis=-1)
        sh1_l, sc1_l, gt1_l, sh2_l, sc2_l, gt2_l = mod_l
        sh1_c, sc1_c, gt1_c, sh2_c, sc2_c, gt2_c = mod_c

        z_l = modulate(rms_norm(h_lat, norm_mix_g[i]), sh1_l, sc1_l) @ w_in[i]
        z_c = modulate(rms_norm(h_ctx, norm_mix_g[i]), sh1_c, sc1_c) @ w_in[i]
        q_l, k_l, v_l, u_l, ga_l, gb_l = jnp.split(z_l, IN_SPLITS, axis=-1)
        q_c, k_c, v_c, u_c, ga_c, gb_c = jnp.split(z_c, IN_SPLITS, axis=-1)

        q_l = axial_rope(rms_norm(split_heads(q_l, N_Q_HEADS), q_norm_g[i]), ang_row, ang_col)
        k_l = axial_rope(rms_norm(split_heads(k_l, N_KV_HEADS), k_norm_g[i]), ang_row, ang_col)
        k_c = rms_norm(split_heads(k_c, N_KV_HEADS), k_norm_g[i])
        v_c = split_heads(v_c, N_KV_HEADS)
        k_all = jnp.concatenate([k_l, k_c], axis=1)
        v_all = jnp.concatenate([split_heads(v_l, N_KV_HEADS), v_c], axis=1)
        attn_l = latent_attention(q_l, k_all, v_all)

        ssm_l, ssm_c = s5_mixer(u_c, u_l, ssm_a_re[i], ssm_a_im[i], ssm_log_dt[i],
                                ssm_b_re[i], ssm_b_im[i], ssm_c_re[i], ssm_c_im[i],
                                ssm_d[i], w_glu[i], b_glu[i], not last)

        out_l = branch_merge(attn_l, ssm_l, ga_l, gb_l, w_branch_attn[i], w_branch_ssm[i], w_out[i])
        h_lat = h_lat + gt1_l * out_l
        if not last:
            q_c = rms_norm(split_heads(q_c, N_Q_HEADS), q_norm_g[i]).reshape(
                bsz, n_ctx, N_KV_HEADS, GQA_GROUP, HEAD_DIM)
            attn_c = gqa_attend(q_c, k_c, v_c).reshape(bsz, n_ctx, ATTN_WIDTH)
            out_c = branch_merge(attn_c, ssm_c, ga_c, gb_c, w_branch_attn[i], w_branch_ssm[i], w_out[i])
            h_ctx = h_ctx + gt1_c * out_c

        xn_l = modulate(rms_norm(h_lat, norm_ffn_g[i]), sh2_l, sc2_l)
        h_lat = h_lat + gt2_l * peer_ffn(xn_l, peer_w_q[i], peer_keys[i], peer_u[i], peer_v[i])
        if not last:
            xn_c = modulate(rms_norm(h_ctx, norm_ffn_g[i]), sh2_c, sc2_c)
            h_ctx = h_ctx + gt2_c * peer_ffn(xn_c, peer_w_q[i], peer_keys[i], peer_u[i], peer_v[i])
    return h_lat
```

```cpp
#include <hip/hip_runtime.h>
#include <cstdio>
#include <cstdint>

#define GAS __attribute__((address_space(1)))
#define LAS __attribute__((address_space(3)))
typedef unsigned short bf16_t;
typedef short bf16x8 __attribute__((ext_vector_type(8)));
typedef short s16x4 __attribute__((ext_vector_type(4)));
typedef float f32x2 __attribute__((ext_vector_type(2)));
typedef float f32x4 __attribute__((ext_vector_type(4)));
typedef float f32x16 __attribute__((ext_vector_type(16)));
typedef unsigned u32x2 __attribute__((ext_vector_type(2)));
typedef unsigned u32x4 __attribute__((ext_vector_type(4)));

#ifndef MK_MULTI
#define MK_MULTI 0
#endif
#ifndef DIAG_MASK
#define DIAG_MASK 0xFFFF
#endif
#define DG(k) ((DIAG_MASK >> (k)) & 1)
#ifndef PEER_FP4
#define PEER_FP4 1
#endif
#ifndef PROBE_PHASE
#define PROBE_PHASE -1
#endif
#ifndef PROBE_REPS
#define PROBE_REPS 1
#endif
#define REPS(k) _Pragma("unroll 1") for (int rep_ = 0; rep_ < ((PROBE_PHASE == (k)) ? PROBE_REPS : 1); ++rep_)
#ifndef EN_ATTN
#define EN_ATTN 1
#endif
#ifndef EN_SSM
#define EN_SSM 1
#endif
#ifndef EN_PEER
#define EN_PEER 1
#endif

constexpr int DM = 1024, NB = 8, SEQ = 4096, DEPTH = 4, CTXL = 256;
constexpr int NLAT = NB * SEQ, NCTX = NB * CTXL, NTOK = NLAT + NCTX;
constexpr int HD = 128, NQH = 8, NKVH = 2, KVW = NKVH * HD, KVLEN = SEQ + CTXL;
constexpr int SSMW = 512, SG = 32, SP = 16, SN = 64, ST = 32;
constexpr int NCH = KVLEN / ST, NCHL = SEQ / ST, NCOL = NB * NCH, NCOLP = 1280, KCAT = 768;
constexpr int INW = 4096, NMOD = 6, MODW = NMOD * DM;
constexpr int PH = 8, PKEYS = 128, PEXP = PKEYS * PKEYS, PQW = 2048, PTOPK = 16;
constexpr float EPS = 1e-6f;

constexpr size_t MiB = 1u << 20;
constexpr size_t WS_CTL = 0, CTL_ZERO_BYTES = 64 * 1024;
constexpr size_t WS_MOD = 1 * MiB;
constexpr size_t WS_ROPE = 2 * MiB;
constexpr size_t WS_KEYS = 3 * MiB;
constexpr size_t WS_HCTX = 4 * MiB;
constexpr size_t WS_WT = 12 * MiB;
constexpr size_t WT_IN = 0, WT_BA = 8 * MiB, WT_BS = 10 * MiB, WT_O = 11 * MiB, WT_GLU = 13 * MiB, WT_Q = 13 * MiB + 512 * 1024, WT_LAYER = 17 * MiB + 512 * 1024;
constexpr size_t WS_WCAT = 82 * MiB;
constexpr size_t WS_WSTATE = 106 * MiB;
constexpr size_t WS_UCAT = 114 * MiB;
constexpr size_t WS_SX = 174 * MiB;
constexpr size_t WS_XN = 214 * MiB;
constexpr size_t WS_XN2 = 282 * MiB;
constexpr size_t WS_Q = 350 * MiB;
constexpr size_t WS_KB = 418 * MiB, WS_VB = 435 * MiB;
constexpr size_t WS_GA = 452 * MiB, WS_GB = 520 * MiB;
constexpr size_t WS_YG = 588 * MiB, WS_SSMO = 622 * MiB;
constexpr size_t WS_SELI = 656 * MiB, WS_SELW = 673 * MiB;
constexpr size_t WS_PU = 690 * MiB, WS_PV = 754 * MiB;
constexpr int PROW = PEER_FP4 ? 512 : 768;
constexpr float QMAX = PEER_FP4 ? 6.0f : 7.5f;
constexpr size_t WS_PSU = 818 * MiB, WS_PSV = 819 * MiB;
constexpr size_t WS_END = 820 * MiB;
constexpr int CW_BAR = 1024;

constexpr int RING_BYTES = 131072;
constexpr int MISC_OFF = RING_BYTES;
constexpr int LDS_BYTES = 147456;

__device__ __forceinline__ unsigned f2bf(float f) { unsigned u = __builtin_bit_cast(unsigned, f); return (u + 0x7fffu + ((u >> 16) & 1u)) >> 16; }
__device__ __forceinline__ unsigned pk2(float lo, float hi) { return f2bf(lo) | (f2bf(hi) << 16); }
__device__ __forceinline__ unsigned cvt_pk_bf16(float lo, float hi) { unsigned r; asm volatile("v_cvt_pk_bf16_f32 %0, %1, %2" : "=v"(r) : "v"(lo), "v"(hi)); return r; }
__device__ __forceinline__ float bflo(unsigned w) { return __builtin_bit_cast(float, w << 16); }
__device__ __forceinline__ float bfhi(unsigned w) { return __builtin_bit_cast(float, w & 0xffff0000u); }
__device__ __forceinline__ int lane_id_now() { int l_; asm volatile("v_mbcnt_lo_u32_b32 %0, -1, 0\n\tv_mbcnt_hi_u32_b32 %0, -1, %0" : "=v"(l_)); return l_; }
__device__ __forceinline__ float shflx(float v, int o, int lane) { return __builtin_bit_cast(float, __builtin_amdgcn_ds_bpermute((lane ^ o) << 2, __builtin_bit_cast(int, v))); }
__device__ __forceinline__ float wave_sum(float v, int lane) {
#pragma unroll
    for (int o = 1; o < 64; o <<= 1) v += shflx(v, o, lane);
    return v;
}
__device__ __forceinline__ float sigmoidf_(float x) { return __builtin_amdgcn_rcpf(1.0f + __builtin_amdgcn_exp2f(-1.4426950408889634f * x)); }
__device__ __forceinline__ float gelu_tanh(float x) {
    const float z = 0.7978845608028654f * (x + 0.044715f * x * x * x);
    const float t = 1.0f - 2.0f * __builtin_amdgcn_rcpf(__builtin_amdgcn_exp2f(2.0f * 1.4426950408889634f * z) + 1.0f);
    return 0.5f * x * (1.0f + t);
}
__device__ __forceinline__ u32x4 pack8(const f32x4 a, const f32x4 b) {
    u32x4 w; w.x = cvt_pk_bf16(a[0], a[1]); w.y = cvt_pk_bf16(a[2], a[3]); w.z = cvt_pk_bf16(b[0], b[1]); w.w = cvt_pk_bf16(b[2], b[3]); return w;
}
__device__ __forceinline__ void unpack8(const u32x4 w, f32x4& a, f32x4& b) {
    a[0] = bflo(w.x); a[1] = bfhi(w.x); a[2] = bflo(w.y); a[3] = bfhi(w.y); b[0] = bflo(w.z); b[1] = bfhi(w.z); b[2] = bflo(w.w); b[3] = bfhi(w.w);
}
__device__ __forceinline__ int modrow_of(int r) { return r < NLAT ? (r >> 12) : NB; }
__device__ __forceinline__ int kvrow_of(int r) { if (r < NLAT) return (r >> 12) * KVLEN + (r & 4095); const int q = r - NLAT; return (q >> 8) * KVLEN + SEQ + (q & 255); }

#define XB_TMO      128
#define XB_XCNT(j)  (256  + 64 * (j))
#define XB_XSUB(j)  (1280 + 64 * (j))
#define XB_XGEN(j)  (2304 + 64 * (j))
#define XB_TOP      3328
#define XB_TOPGEN   3392
#define XCD_BAR_WORDS 3456
#define XB_SPIN_CAP (1u << 18)
__device__ __forceinline__ unsigned xb_ld(unsigned* p)              { return __hip_atomic_load(p, __ATOMIC_RELAXED, __HIP_MEMORY_SCOPE_AGENT); }
__device__ __forceinline__ unsigned xb_add(unsigned* p, unsigned v) { return __hip_atomic_fetch_add(p, v, __ATOMIC_RELAXED, __HIP_MEMORY_SCOPE_AGENT); }
__device__ __forceinline__ unsigned xb_xcc_id() { return (unsigned)__builtin_amdgcn_s_getreg((3 << 11) | 20) & 0xFu; }
#define XB_SPIN(cond, bar) do { unsigned _sp = 0; while (cond) { __builtin_amdgcn_s_sleep(1); \
    if ((++_sp & 255u) == 0u) { if (xb_ld(&(bar)[XB_TMO])) break; if (_sp > XB_SPIN_CAP) { atomicAdd(&(bar)[XB_TMO], 1u); break; } } } } while (0)
struct XcdBarrier { unsigned* bar; unsigned x; volatile LAS unsigned* st; };
__device__ __forceinline__ XcdBarrier xcd_barrier_post(unsigned* bar, volatile LAS unsigned* st) {
    XcdBarrier b; b.bar = bar; b.x = xb_xcc_id(); b.st = st;
    if (threadIdx.x == 0) (void)xb_add(&bar[XB_XCNT(b.x)], 1u);
    return b;
}
__device__ __forceinline__ void xcd_barrier_complete(unsigned* bar, unsigned x, unsigned& nloc, unsigned& nx) {
    const unsigned G = gridDim.x * gridDim.y * gridDim.z;
    unsigned sum, cnt, mine, sp = 0u;
    for (;;) {
        sum = 0u; cnt = 0u; mine = 0u;
#pragma unroll
        for (unsigned j = 0; j < 16; ++j) { const unsigned c = xb_ld(&bar[XB_XCNT(j)]); sum += c; cnt += (c > 0u) ? 1u : 0u; mine = (j == x) ? c : mine; }
        if (sum == G) break;
        __builtin_amdgcn_s_sleep(1);
        if ((++sp & 255u) == 0u) { if (xb_ld(&bar[XB_TMO])) break; if (sp > XB_SPIN_CAP) { atomicAdd(&bar[XB_TMO], 1u); break; } }
    }
    nloc = mine > 0u ? mine : 1u; nx = cnt > 0u ? cnt : 1u;
}
__device__ __forceinline__ void xcd_barrier(const XcdBarrier& b, const bool t0  ) {
    asm volatile("s_waitcnt vmcnt(0)" ::: "memory");
    __syncthreads();
    if (t0) {
        unsigned* bar = b.bar;
        __builtin_amdgcn_s_waitcnt(0);
        unsigned nloc = b.st[0], nx = b.st[1];
        if (nloc == 0u) { unsigned x_ = b.x; asm volatile("" : "+s"(x_));
            xcd_barrier_complete(bar, x_, nloc, nx); b.st[0] = nloc; b.st[1] = nx; }
        const unsigned old = xb_add(&bar[XB_XSUB(b.x)], 1u);
        const unsigned gen = old / nloc;
        if (old + 1u == (gen + 1u) * nloc) {
            __builtin_amdgcn_fence(__ATOMIC_RELEASE, "agent");
            asm volatile("s_waitcnt vmcnt(0)" ::: "memory");
            const unsigned og = xb_add(&bar[XB_TOP], 1u);
            const unsigned tg = og / nx;
            if (og + 1u == (tg + 1u) * nx) xb_add(&bar[XB_TOPGEN], 1u);
            else XB_SPIN(xb_ld(&bar[XB_TOPGEN]) == tg, bar);
            __builtin_amdgcn_fence(__ATOMIC_ACQUIRE, "agent");
            xb_add(&bar[XB_XGEN(b.x)], 1u);
            asm volatile("s_waitcnt vmcnt(0)" ::: "memory");
        } else {
            XB_SPIN(xb_ld(&bar[XB_XGEN(b.x)]) == gen, bar);
            __builtin_amdgcn_fence(__ATOMIC_ACQUIRE, "agent");
            asm volatile("s_waitcnt vmcnt(0)" ::: "memory");
        }
    }
    __syncthreads();
}

namespace pg8 {
constexpr int BM = 256, BK = 64, HALF = 128, HTB = HALF * BK * 2, STAGE_BYTES = 8 * HTB, NXCD = 8, WGM = 8;
__host__ __device__ __forceinline__ int lds_byte(int r, int c) { const int st = (r >> 4) * 2 + (c >> 5), rr = r & 15, cc = c & 31, ob = rr * 64 + cc * 2; return st * 1024 + (ob ^ (((ob >> 9) & 1) << 5)); }
__host__ __device__ __forceinline__ void stage_rc(int b, int& R, int& C) { const int st = b / 1024, sb = b % 1024, swz = sb ^ (((sb >> 9) & 1) << 5); R = (st >> 1) * 16 + swz / 64; C = (st & 1) * 32 + (swz % 64) / 2; }
__host__ __device__ __forceinline__ int perm32(int rho) { const int n = rho >> 4, i = rho & 15; return 8 * (i >> 2) + 4 * n + (i & 3); }

struct Unit { int pm, pn, pb, hm; };
struct Gemm { const bf16_t* A; const bf16_t* Bt; };

struct StaticOrder {
    int nM, nN, nwg, G, c;
    __device__ void init(int M, int N, int G_, int c_) { nM = M / BM; nN = N / BM; nwg = nM * nN; G = G_; c = c_; }
    __device__ void map(int wgid, int& pm, int& pn) const {
        { const int q = nwg / NXCD, r = nwg % NXCD, xcd = wgid % NXCD, off = wgid / NXCD; wgid = (xcd < r ? xcd * (q + 1) : r * (q + 1) + (xcd - r) * q) + off; }
        const int nig = WGM * nN, gid = wgid / nig, fm = gid * WGM, gsz = (nM - fm) < WGM ? (nM - fm) : WGM;
        pm = fm + ((wgid % nig) % gsz); pn = (wgid % nig) / gsz;
    }
    __device__ bool next(int i, Unit& u) const {
        const long L = (long)i * G + c; if (L >= nwg) return false;
        int pm, pn; map((int)L, pm, pn); u.pm = pm; u.pn = pn; u.pb = 0; u.hm = -1; return true;
    }
};
struct SplitOrder {
    StaticOrder lat; int nN, nLat, nH, G, c;
    __device__ void init(int M, int N, int G_, int c_) { lat.init(NLAT, N, G_, c_); nN = N / BM; nLat = lat.nwg; nH = M > NLAT ? ((M - NLAT) / HALF) * nN : 0; G = G_; c = c_; }
    __device__ bool next(int i, Unit& u) const {
        const long L = (long)i * G + c; if (L >= (long)nLat + nH) return false;
        const bool isl = L < nLat;
        int pmL, pnL; lat.map(isl ? (int)L : 0, pmL, pnL);
        const int h = isl ? 0 : (int)(L - nLat);
        const int per = 2 * nN, hu = (nH % NXCD == 0) ? (h % NXCD) * (nH / NXCD) + h / NXCD : h, t = hu / per, j = hu - t * per;
        u.pm = isl ? pmL : NLAT / BM + t; u.pn = isl ? pnL : (j >> 1); u.pb = 0; u.hm = isl ? -1 : (j & 1); return true;
    }
};
struct BatchOrder {
    int nM, nN, nb, G, c, tailM;
    __device__ void init(int nM_, int nN_, int nb_, int G_, int c_, int tailM_ = -1) { nM = nM_; nN = nN_; nb = nb_; G = G_; c = c_; tailM = tailM_; }
    __device__ bool next(int i, Unit& u) const {
        const long L = (long)i * G + c; if (L >= (long)nM * nN * nb) return false;
        const int nMf = tailM >= 0 ? nM - 1 : nM, per = nMf * nN, nfull = per * nb, l = (int)L; const bool full = l < nfull;
        const int lf = full ? l : 0, pbF = lf / per, rF = lf - pbF * per, pnF = rF / nMf, pmF = rF - pnF * nMf;
        const int rT = full ? 0 : l - nfull, pbT = rT / nN, pnT = rT - pbT * nN;
        u.pb = full ? pbF : pbT; u.pn = full ? pnF : pnT; u.pm = full ? pmF : tailM; u.hm = full ? -1 : 0; return true;
    }
};

template <int K, int LDA, int LDB, size_t SA, size_t SB, class Epi, class Sched>
__device__ __forceinline__ void gemm_phase(LAS unsigned char* lds, const Gemm g, const Sched& S, const Epi& E, const int tid) {
    static_assert(Epi::PERM, "all epilogues here use the permuted column map");
    const int wid = __builtin_amdgcn_readfirstlane(tid >> 6), lane = tid & 63, wr = wid >> 2, wc = wid & 3, fr = lane & 15, fq = lane >> 4;
    constexpr int nt = K / BK;
    unsigned voffA[2], voffB[2];
#pragma unroll
    for (int i = 0; i < 2; ++i) { int R, C; stage_rc(tid * 16 + i * 8192, R, C); const int Rb = (R & ~31) + perm32(R & 31);
        voffA[i] = (unsigned)(R * LDA + C) * 2u; voffB[i] = (unsigned)(Rb * LDB + C) * 2u; }
    constexpr size_t kstep = (size_t)(BK * 2);
    constexpr size_t hstepA = (size_t)HALF * LDA * 2, hstepB = (size_t)HALF * LDB * 2;
    constexpr size_t tstepA = 2 * hstepA, tstepB = 2 * hstepB;
    const unsigned ldsw = (unsigned)wid * 1024u;
    const int aoff = lds_byte(wr * 64 + fr, fq * 8), boff = lds_byte(wc * 32 + fr, fq * 8);
#define PG8_SA(b, h) (((b) * 2 + (h)) * HTB)
#define PG8_SB(b, h) ((4 + (b) * 2 + (h)) * HTB)
#define PG8_STAGE(bufoff, gbase, voff) do { _Pragma("unroll") for (int _i = 0; _i < 2; ++_i) \
        __builtin_amdgcn_global_load_lds((const unsigned*)((const char*)(gbase) + (voff)[_i]), (LAS unsigned*)(lds + (bufoff) + ldsw + _i * 8192), 16, 0, 0); } while (0)
#define PG8_LDA(dst, b, h) do { _Pragma("unroll") for (int m = 0; m < 4; ++m) _Pragma("unroll") for (int k = 0; k < 2; ++k) dst[m][k] = *(const LAS bf16x8*)(lds + PG8_SA(b, h) + aoff + m * 2048 + k * 1024); } while (0)
#define PG8_LDB(dst, b, h) do { _Pragma("unroll") for (int n = 0; n < 2; ++n) _Pragma("unroll") for (int k = 0; k < 2; ++k) dst[n][k] = *(const LAS bf16x8*)(lds + PG8_SB(b, h) + boff + n * 2048 + k * 1024); } while (0)
#define PG8_MMA(ai, bj, At, Bt) do { __builtin_amdgcn_s_setprio(1); _Pragma("unroll") for (int m = 0; m < 4; ++m) _Pragma("unroll") for (int n = 0; n < 2; ++n) _Pragma("unroll") for (int k = 0; k < 2; ++k) \
        acc[ai][bj][m][n] = __builtin_amdgcn_mfma_f32_16x16x32_bf16(Bt[n][k], At[m][k], acc[ai][bj][m][n], 0, 0, 0); __builtin_amdgcn_s_setprio(0); } while (0)
#define PG8_WAIT_V(n) asm volatile("s_waitcnt vmcnt(" #n ")" ::: "memory")
#define PG8_WAIT_L(n) asm volatile("s_waitcnt lgkmcnt(" #n ")" ::: "memory")
#define PG8_BAR __builtin_amdgcn_s_barrier()
#define PG8_SCHED __builtin_amdgcn_sched_barrier(0)
    Unit cur, nxt; int ui = 0;
    if (!S.next(0, cur)) return;
    f32x4 acc[2][2][4][2];
#pragma unroll
    for (int a = 0; a < 2; ++a)
#pragma unroll
        for (int b = 0; b < 2; ++b)
#pragma unroll
            for (int m = 0; m < 4; ++m)
#pragma unroll
                for (int n = 0; n < 2; ++n) acc[a][b][m][n] = (f32x4){0.f, 0.f, 0.f, 0.f};
    bf16x8 At[4][2], B0[2][2], B1[2][2];
    const char* cA = (const char*)g.A + (size_t)cur.pb * SA + (size_t)cur.pm * tstepA + (cur.hm > 0 ? hstepA : (size_t)0); const char* cB = (const char*)g.Bt + (size_t)cur.pb * SB + (size_t)cur.pn * tstepB;
    unsigned cH = cur.hm < 0 ? (unsigned)hstepA : 0u;
    PG8_STAGE(PG8_SB(0, 0), cB, voffB); PG8_STAGE(PG8_SB(0, 1), cB + hstepB, voffB); PG8_STAGE(PG8_SA(0, 0), cA, voffA); PG8_STAGE(PG8_SA(0, 1), cA + cH, voffA);
    if (wr == 1) PG8_BAR;
    PG8_WAIT_V(2); PG8_BAR;
    PG8_STAGE(PG8_SB(1, 0), cB + kstep, voffB); PG8_STAGE(PG8_SA(1, 0), cA + kstep, voffA); PG8_STAGE(PG8_SB(1, 1), cB + hstepB + kstep, voffB);
    PG8_WAIT_V(6); PG8_BAR;
    for (;;) {
        const bool has_next = S.next(ui + 1, nxt);
        const char* nA = has_next ? (const char*)g.A + (size_t)nxt.pb * SA + (size_t)nxt.pm * tstepA + (nxt.hm > 0 ? hstepA : (size_t)0) : cA; const char* nB = has_next ? (const char*)g.Bt + (size_t)nxt.pb * SB + (size_t)nxt.pn * tstepB : cB;
        const unsigned nH = has_next ? (nxt.hm < 0 ? (unsigned)hstepA : 0u) : cH;
        const bool whole = cur.hm < 0;
        for (int t = 0; t < nt; t += 2) {
            const bool last = (t == nt - 2);
            const char* a1 = cA + (size_t)(t + 1) * kstep;
            const char* a2 = last ? nA : cA + (size_t)(t + 2) * kstep; const char* b2 = last ? nB : cB + (size_t)(t + 2) * kstep; const unsigned h2 = last ? nH : cH;
            const char* a3 = a2 + kstep; const char* b3 = b2 + kstep;
            PG8_LDB(B0, 0, 0); PG8_LDB(B1, 0, 1); PG8_SCHED; PG8_LDA(At, 0, 0); PG8_STAGE(PG8_SA(1, 1), a1 + cH, voffA);
            PG8_WAIT_V(8); PG8_WAIT_L(0); PG8_BAR; PG8_MMA(0, 0, At, B0); PG8_MMA(0, 1, At, B1); PG8_BAR; PG8_SCHED;
            PG8_LDA(At, 0, 1); PG8_STAGE(PG8_SB(0, 0), b2, voffB); PG8_STAGE(PG8_SB(0, 1), b2 + hstepB, voffB); PG8_STAGE(PG8_SA(0, 0), a2, voffA);
            PG8_WAIT_V(8); PG8_WAIT_L(0); PG8_BAR; if (whole) { PG8_MMA(1, 0, At, B0); PG8_MMA(1, 1, At, B1); } PG8_BAR; PG8_SCHED;
            PG8_LDB(B0, 1, 0); PG8_LDB(B1, 1, 1); PG8_SCHED; PG8_LDA(At, 1, 0); PG8_STAGE(PG8_SA(0, 1), a2 + h2, voffA);
            PG8_WAIT_V(8); PG8_WAIT_L(0); PG8_BAR; PG8_MMA(0, 0, At, B0); PG8_MMA(0, 1, At, B1); PG8_BAR; PG8_SCHED;
            PG8_LDA(At, 1, 1); PG8_STAGE(PG8_SB(1, 0), b3, voffB); PG8_STAGE(PG8_SB(1, 1), b3 + hstepB, voffB); PG8_STAGE(PG8_SA(1, 0), a3, voffA);
            PG8_WAIT_V(8); PG8_WAIT_L(0); PG8_BAR; if (whole) { PG8_MMA(1, 0, At, B0); PG8_MMA(1, 1, At, B1); } PG8_BAR; PG8_SCHED;
        }
        if (wr == 0) PG8_BAR;
        E(acc, cur, wr, wc, fr, fq);
        if (!has_next) break;
#pragma unroll
        for (int a = 0; a < 2; ++a)
#pragma unroll
            for (int b = 0; b < 2; ++b)
#pragma unroll
                for (int m = 0; m < 4; ++m)
#pragma unroll
                    for (int n = 0; n < 2; ++n) acc[a][b][m][n] = (f32x4){0.f, 0.f, 0.f, 0.f};
        cur = nxt; cA = nA; cB = nB; cH = nH; ++ui;
        if (wr == 1) PG8_BAR;
    }
    PG8_WAIT_V(0);
    PG8_BAR;
#undef PG8_SA
#undef PG8_SB
#undef PG8_STAGE
#undef PG8_LDA
#undef PG8_LDB
#undef PG8_MMA
#undef PG8_WAIT_V
#undef PG8_WAIT_L
#undef PG8_BAR
#undef PG8_SCHED
}

#define EPI_ON (uhm_ < 0 || ai == uhm_)
#define EPI_ACC(k_) ((ai == 1 && uhm_ >= 0) ? acc[0][bj][m][k_] : acc[ai][bj][m][k_])
#define EPI_FOR _Pragma("unroll") for (int ai = 0; ai < 2; ++ai) if (EPI_ON) _Pragma("unroll") for (int m = 0; m < 4; ++m) _Pragma("unroll") for (int bj = 0; bj < 2; ++bj)
#define EPI_COORDS const int ln_ = lane_id_now(), wr = wr_, wc = wc_, fr = ln_ & 15, fq = ln_ >> 4, uhm_ = u.hm;
#define EPI_V const f32x4 v0 = EPI_ACC(0), v1 = EPI_ACC(1);

struct EpiIn {
    static constexpr bool PERM = true;
    unsigned char* ws;
    __device__ __forceinline__ void operator()(const f32x4 (&acc)[2][2][4][2], const Unit& u, int wr_, int wc_, int fr_, int fq_) const {
        EPI_COORDS
        const int pn = u.pn, r0 = u.pm * BM, rl = wr * 64 + fr, cl0 = wc * 32 + 8 * fq;
        size_t boff; long sA, sM1, sM0, sB;
        if (pn == 4 || pn == 5) {
            int kv0; if (r0 < NLAT) kv0 = (r0 >> 12) * KVLEN + (r0 & 4095); else kv0 = ((r0 - NLAT) >> 8) * KVLEN + SEQ;
            boff = WS_KB + (size_t)(pn - 4) * (WS_VB - WS_KB) + ((size_t)(kv0 + rl) * KVW + cl0) * 2; sA = 128 * KVW; sM1 = 32 * KVW; sM0 = 16 * KVW; sB = 128;
        } else if (pn == 6 || pn == 7) {
            int col0; if (r0 < NLAT) col0 = ((r0 & 4095) >> 5) * 8 + (r0 >> 12); else col0 = NCHL * 8 + ((r0 - NLAT) >> 8);
            boff = WS_UCAT + ((size_t)(((pn - 6) * 16 + wc * 2 + (fq >> 1)) * NCOLP + col0 + wr * 16) * KCAT + fr * SP + (fq & 1) * 8) * 2;
            sA = (long)32 * KCAT; sM1 = (long)8 * KCAT; sM0 = 16 * SP; sB = (long)8 * NCOLP * KCAT;
        } else {
            const int grp = pn < 4 ? 0 : (pn < 12 ? 1 : 2), pc = pn - (grp == 0 ? 0 : (grp == 1 ? 8 : 12));
            const size_t tb = WS_Q + (size_t)grp * (WS_GA - WS_Q) - (grp == 2 ? (size_t)((WS_GA - WS_Q) - (WS_GB - WS_GA)) : 0);
            boff = tb + ((size_t)(r0 + rl) * DM + pc * 256 + cl0) * 2; sA = 128 * DM; sM1 = 32 * DM; sM0 = 16 * DM; sB = 128;
        }
        bf16_t* base = (bf16_t*)(ws + boff);
        EPI_FOR { EPI_V *(u32x4*)(base + ai * sA + (m >> 1) * sM1 + (m & 1) * sM0 + bj * sB) = pack8(v0, v1); }
    }
};
struct EpiBf16 {
    static constexpr bool PERM = true;
    bf16_t* O; int ldc;
    __device__ __forceinline__ void operator()(const f32x4 (&acc)[2][2][4][2], const Unit& u, int wr_, int wc_, int fr_, int fq_) const {
        EPI_COORDS
        bf16_t* base = O + (size_t)(u.pm * BM + wr * 64 + fr) * ldc + u.pn * BM + wc * 32 + 8 * fq; const long sR = (long)16 * ldc;
        EPI_FOR { EPI_V *(u32x4*)(base + (ai * 8 + m) * sR + bj * 128) = pack8(v0, v1); }
    }
};
struct EpiSX {
    static constexpr bool PERM = true;
    float* SX;
    __device__ __forceinline__ void operator()(const f32x4 (&acc)[2][2][4][2], const Unit& u, int wr_, int wc_, int fr_, int fq_) const {
        EPI_COORDS
        float* base = SX + ((size_t)(u.pb * NCOLP + u.pm * BM + wr * 64 + fr) * 256 + wc * 32 + 8 * fq);
        const bool tail = (u.pm == 4);
        EPI_FOR { EPI_V if (!tail || (ai == 0 && wr == 0)) { float* d = base + (ai * 8 + m) * (16 * 256) + bj * 128; *(f32x4*)d = v0; *(f32x4*)(d + 4) = v1; } }
    }
};
#define EPI_GROUPS _Pragma("unroll") for (int ai = 0; ai < 2; ++ai) if (EPI_ON) _Pragma("unroll") for (int mh = 0; mh < 2; ++mh)
#define EPI_IN_GROUP _Pragma("unroll") for (int e_ = 0; e_ < 4; ++e_)
#define EPI_GIDX const int m = 2 * mh + (e_ >> 1), bj = e_ & 1; (void)m; (void)bj;
struct EpiS3 {
    static constexpr bool PERM = true;
    const bf16_t* UCAT; const float* dsk; bf16_t* YG;
    __device__ __forceinline__ void operator()(const f32x4 (&acc)[2][2][4][2], const Unit& u, int wr_, int wc_, int fr_, int fq_) const {
        EPI_COORDS
        const int gg = u.pb, b = fr & 7, p0 = (fq & 1) * 8, tl = u.pn * 16 + wc * 2 + (fq >> 1);
        const bool tail = (u.pm == 4);
        const int tok0 = tail ? NLAT + b * CTXL + (fr >> 3) * ST + tl : b * SEQ + (u.pm * 32 + wr * 8 + (fr >> 3)) * ST + tl;
        const bf16_t* ub = UCAT + ((size_t)(gg * NCOLP + u.pm * BM + wr * 64 + fr) * KCAT + tl * SP + p0);
        bf16_t* yb = YG + (size_t)tok0 * SSMW + gg * SP + p0;
        const f32x4 d0 = *(const f32x4*)(dsk + gg * SP + p0), d1 = *(const f32x4*)(dsk + gg * SP + p0 + 4);
        EPI_GROUPS { if (!tail || (ai == 0 && wr == 0)) {
            u32x4 uw[4];
            EPI_IN_GROUP { EPI_GIDX uw[e_] = *(const u32x4*)(ub + (size_t)(ai * 128 + m * 16) * KCAT + bj * 8 * SP); }
            EPI_IN_GROUP { EPI_GIDX const f32x4 v0 = EPI_ACC(0), v1 = EPI_ACC(1);
                f32x4 u0, u1; unpack8(uw[e_], u0, u1);
                f32x4 y0 = v0 + d0 * u0, y1 = v1 + d1 * u1;
#pragma unroll
                for (int i = 0; i < 4; ++i) { y0[i] = gelu_tanh(y0[i]); y1[i] = gelu_tanh(y1[i]); }
                *(u32x4*)(yb + (size_t)((ai * 16 + m * 2) * ST + bj * 8) * SSMW) = pack8(y0, y1); } } }
    }
};
struct EpiGlu {
    static constexpr bool PERM = true;
    const bf16_t* YG; const float* bias; bf16_t* O;
    __device__ __forceinline__ void operator()(const f32x4 (&acc)[2][2][4][2], const Unit& u, int wr_, int wc_, int fr_, int fq_) const {
        EPI_COORDS
        const int c0 = u.pn * BM + wc * 32 + 8 * fq; const size_t off = (size_t)(u.pm * BM + wr * 64 + fr) * SSMW + c0;
        f32x4 bb[2][2];
#pragma unroll
        for (int bj = 0; bj < 2; ++bj) { bb[bj][0] = *(const f32x4*)(bias + c0 + bj * 128); bb[bj][1] = *(const f32x4*)(bias + c0 + bj * 128 + 4); }
        EPI_GROUPS {
            u32x4 yw[4];
            EPI_IN_GROUP { EPI_GIDX yw[e_] = *(const u32x4*)(YG + off + (size_t)(ai * 128 + m * 16) * SSMW + bj * 128); }
            EPI_IN_GROUP { EPI_GIDX const f32x4 v0 = EPI_ACC(0), v1 = EPI_ACC(1);
                f32x4 y0, y1; unpack8(yw[e_], y0, y1);
                f32x4 o0, o1;
#pragma unroll
                for (int i = 0; i < 4; ++i) { o0[i] = y0[i] * sigmoidf_(v0[i] + bb[bj][0][i]); o1[i] = y1[i] * sigmoidf_(v1[i] + bb[bj][1][i]); }
                *(u32x4*)(O + off + (size_t)(ai * 128 + m * 16) * SSMW + bj * 128) = pack8(o0, o1); } }
    }
};
template <bool ADD> struct EpiMerge {
    static constexpr bool PERM = true;
    const bf16_t* G; bf16_t* Y;
    __device__ __forceinline__ void operator()(const f32x4 (&acc)[2][2][4][2], const Unit& u, int wr_, int wc_, int fr_, int fq_) const {
        EPI_COORDS
        const size_t off = (size_t)(u.pm * BM + wr * 64 + fr) * DM + u.pn * BM + wc * 32 + 8 * fq;
        EPI_GROUPS {
            u32x4 gw[4], yw[4];
            EPI_IN_GROUP { EPI_GIDX const size_t o = off + (size_t)(ai * 128 + m * 16) * DM + bj * 128; gw[e_] = *(const u32x4*)(G + o); if (ADD) yw[e_] = *(const u32x4*)(Y + o); }
            EPI_IN_GROUP { EPI_GIDX const size_t o = off + (size_t)(ai * 128 + m * 16) * DM + bj * 128; const f32x4 v0 = EPI_ACC(0), v1 = EPI_ACC(1);
                f32x4 g0, g1; unpack8(gw[e_], g0, g1);
                f32x4 o0, o1;
#pragma unroll
                for (int i = 0; i < 4; ++i) { o0[i] = sigmoidf_(g0[i]) * v0[i]; o1[i] = sigmoidf_(g1[i]) * v1[i]; }
                if (ADD) { f32x4 y0, y1; unpack8(yw[e_], y0, y1); o0 += y0; o1 += y1; }
                *(u32x4*)(Y + o) = pack8(o0, o1); } }
    }
};
struct EpiWo {
    static constexpr bool PERM = true;
    const float* hsrc; float* hlat; float* hctx; const float* gate;
    __device__ __forceinline__ void operator()(const f32x4 (&acc)[2][2][4][2], const Unit& u, int wr_, int wc_, int fr_, int fq_) const {
        EPI_COORDS
        const int r0 = u.pm * BM, c0 = u.pn * BM + wc * 32 + 8 * fq;
        const size_t roff = (size_t)(wr * 64 + fr) * DM + c0;
        const float* sb = (r0 < NLAT ? hsrc + (size_t)r0 * DM : hctx + (size_t)(r0 - NLAT) * DM) + roff;
        float* hb = (r0 < NLAT ? hlat + (size_t)r0 * DM : hctx + (size_t)(r0 - NLAT) * DM) + roff;
        const float* gr = gate + (size_t)(r0 < NLAT ? (r0 >> 12) : NB) * MODW + c0;
        f32x4 gg[2][2];
#pragma unroll
        for (int bj = 0; bj < 2; ++bj) { gg[bj][0] = *(const f32x4*)(gr + bj * 128); gg[bj][1] = *(const f32x4*)(gr + bj * 128 + 4); }
        EPI_GROUPS {
            f32x4 h0[4], h1[4];
            EPI_IN_GROUP { EPI_GIDX const size_t o = (size_t)(ai * 128 + m * 16) * DM + bj * 128; h0[e_] = *(const f32x4*)(sb + o); h1[e_] = *(const f32x4*)(sb + o + 4); }
            EPI_IN_GROUP { EPI_GIDX const size_t o = (size_t)(ai * 128 + m * 16) * DM + bj * 128; const f32x4 v0 = EPI_ACC(0), v1 = EPI_ACC(1);
                *(f32x4*)(hb + o) = h0[e_] + gg[bj][0] * v0; *(f32x4*)(hb + o + 4) = h1[e_] + gg[bj][1] * v1; } }
    }
};
#undef EPI_GROUPS
#undef EPI_IN_GROUP
#undef EPI_GIDX
}

namespace att {
constexpr int D = 128, NW = 8, QBLK = 32, KVBLK = 64;
constexpr float SCALE = 0.088388347648318440f;
constexpr float THR = 8.f;
#ifndef ATT_SDEPTH
#define ATT_SDEPTH 1
#endif
constexpr int SDEPTH = ATT_SDEPTH;
constexpr int LDQ = DM, LDK = KVW, LDO = DM;
constexpr size_t SHM_V = KVBLK * D * 2, SHM_K = KVBLK * D * 2, SHM_ATTN = 2 * SHM_V + 2 * SHM_K + NW * 64 * 4;
#define KSWZ(row, colB) ((row) * 256 + ((colB) ^ (((row) & 7) << 4)))
#define SBAR() __builtin_amdgcn_sched_barrier(0)
__device__ __forceinline__ int crow(int r, int hi) { return (r & 3) + 8 * (r >> 2) + 4 * hi; }
__device__ __forceinline__ unsigned cvtpk(float lo, float hi) { unsigned r; asm volatile("v_cvt_pk_bf16_f32 %0, %1, %2" : "=v"(r) : "v"(lo), "v"(hi)); return r; }
__device__ __forceinline__ void partialSM(f32x16& p0) {
  for (int r = 0; r < 16; ++r) p0[r] = __builtin_amdgcn_exp2f(p0[r]);
}
__device__ __forceinline__ void finishSM(f32x16& p0, f32x16& p1, float& l_reg, bf16x8& pa0, bf16x8& pa1, bf16x8& pa2, bf16x8& pa3) {
  for (int r = 0; r < 16; ++r) p1[r] = __builtin_amdgcn_exp2f(p1[r]);
  float ps = 0; for (int r = 0; r < 16; ++r) ps += p0[r]; for (int r = 0; r < 16; ++r) ps += p1[r];
  l_reg += ps;
#define PK4(P, BASE, OUT) do { unsigned a0 = cvtpk(P[BASE + 0], P[BASE + 1]), a1 = cvtpk(P[BASE + 2], P[BASE + 3]);   \
    unsigned b0 = cvtpk(P[BASE + 4], P[BASE + 5]), b1 = cvtpk(P[BASE + 6], P[BASE + 7]);                              \
    auto r0 = __builtin_amdgcn_permlane32_swap(a0, b0, false, false); auto r1 = __builtin_amdgcn_permlane32_swap(a1, b1, false, false); \
    u32x4 w = {r0[0], r1[0], r0[1], r1[1]}; OUT = *reinterpret_cast<bf16x8*>(&w); } while (0)
  PK4(p0, 0, pa0); PK4(p0, 8, pa1); PK4(p1, 0, pa2); PK4(p1, 8, pa3);
#undef PK4
}
__device__ __forceinline__ void qkt(f32x16& p0, f32x16& p1, const bf16_t* Ks, const bf16x8* qr, int r32, int hi, float nm0) {
#pragma unroll
  for (int r = 0; r < 16; ++r) { p0[r] = nm0; p1[r] = nm0; }
  const char* kb0 = (const char*)Ks + r32 * 256; const char* kb1 = kb0 + 32 * 256; const int swz = (r32 & 7) << 4;
#define KFRAG(base, d0) (*reinterpret_cast<const bf16x8*>((base) + ((((d0) * 32) + hi * 16) ^ swz)))
  bf16x8 fa0 = KFRAG(kb0, 0), fa1 = KFRAG(kb1, 0), fb0 = KFRAG(kb0, 1), fb1 = KFRAG(kb1, 1);
#pragma unroll
  for (int d0 = 0; d0 < 8; d0 += 2) {
    bf16x8 na0 = fa0, na1 = fa1, nb0 = fb0, nb1 = fb1;
    if (d0 + 2 < 8) { na0 = KFRAG(kb0, d0 + 2); na1 = KFRAG(kb1, d0 + 2); }
    p0 = __builtin_amdgcn_mfma_f32_32x32x16_bf16(fa0, qr[d0], p0, 0, 0, 0);
    p1 = __builtin_amdgcn_mfma_f32_32x32x16_bf16(fa1, qr[d0], p1, 0, 0, 0);
    __builtin_amdgcn_sched_group_barrier(0x100, 2, 0); __builtin_amdgcn_sched_group_barrier(0x008, 2, 0);
    if (d0 + 3 < 8) { nb0 = KFRAG(kb0, d0 + 3); nb1 = KFRAG(kb1, d0 + 3); }
    p0 = __builtin_amdgcn_mfma_f32_32x32x16_bf16(fb0, qr[d0 + 1], p0, 0, 0, 0);
    p1 = __builtin_amdgcn_mfma_f32_32x32x16_bf16(fb1, qr[d0 + 1], p1, 0, 0, 0);
    __builtin_amdgcn_sched_group_barrier(0x100, 2, 0); __builtin_amdgcn_sched_group_barrier(0x008, 2, 0);
    fa0 = na0; fa1 = na1; fb0 = nb0; fb1 = nb1;
  }
#undef KFRAG
}
__device__ __forceinline__ int v_st(int k, int c) { const int kk = (k & ~0xC) | ((k & 4) << 1) | ((k & 8) >> 1); return ((kk >> 3) * 4 + (c >> 5)) * 512 + ((kk & 7) * 32 + (c & 31)) * 2; }
__device__ __forceinline__ int v_rd_base(int lane) { return ((lane & 3) << 3) | (((lane >> 2) & 3) << 6) | (((lane >> 4) & 1) << 5) | (((lane >> 5) & 1) << 8); }
constexpr int v_rd_off(int d0, int ks, int half) { return d0 * 512 + ks * 4096 + half * 2048; }
template <int OFF> __device__ __forceinline__ s16x4 tr_read(int vb) {
  s16x4 r; asm volatile("ds_read_b64_tr_b16 %0, %1 offset:%2" : "=&v"(r) : "v"(vb), "i"(OFF) : "memory"); return r;
}
template <int D0> __device__ __forceinline__ void pv_one(f32x16& od, int vb, bf16x8 pa0, bf16x8 pa1, bf16x8 pa2, bf16x8 pa3) {
  const s16x4 l0 = tr_read<v_rd_off(D0, 0, 0)>(vb), h0 = tr_read<v_rd_off(D0, 0, 1)>(vb), l1 = tr_read<v_rd_off(D0, 1, 0)>(vb), h1 = tr_read<v_rd_off(D0, 1, 1)>(vb);
  const s16x4 l2 = tr_read<v_rd_off(D0, 2, 0)>(vb), h2 = tr_read<v_rd_off(D0, 2, 1)>(vb), l3 = tr_read<v_rd_off(D0, 3, 0)>(vb), h3 = tr_read<v_rd_off(D0, 3, 1)>(vb);
  asm volatile("s_waitcnt lgkmcnt(0)" ::: "memory"); SBAR();
#define PK(L, H) (bf16x8){L[0], L[1], L[2], L[3], H[0], H[1], H[2], H[3]}
  od = __builtin_amdgcn_mfma_f32_32x32x16_bf16(pa0, PK(l0, h0), od, 0, 0, 0);
  od = __builtin_amdgcn_mfma_f32_32x32x16_bf16(pa1, PK(l1, h1), od, 0, 0, 0);
  od = __builtin_amdgcn_mfma_f32_32x32x16_bf16(pa2, PK(l2, h2), od, 0, 0, 0);
  od = __builtin_amdgcn_mfma_f32_32x32x16_bf16(pa3, PK(l3, h3), od, 0, 0, 0);
#undef PK
}
__device__ __forceinline__ void pv_d0(f32x16* o, int vb, bf16x8 pa0, bf16x8 pa1, bf16x8 pa2, bf16x8 pa3) {
  pv_one<0>(o[0], vb, pa0, pa1, pa2, pa3); pv_one<1>(o[1], vb, pa0, pa1, pa2, pa3); pv_one<2>(o[2], vb, pa0, pa1, pa2, pa3); pv_one<3>(o[3], vb, pa0, pa1, pa2, pa3);
}
__device__ __forceinline__ void attn_dense_body(bf16_t* Qb, const bf16_t* Kh, int seq, char* lds, const int tid, const long odelta, const float nm0) {
  const bf16_t* Vh = (const bf16_t*)((const char*)Kh + (WS_VB - WS_KB)); bf16_t* Ob = (bf16_t*)((char*)Qb + odelta);
  const int wid = tid >> 6, lane = tid & 63, r32 = lane & 31, hi = lane >> 5;
  bf16_t* V_lds = (bf16_t*)lds; bf16_t* K_lds = (bf16_t*)(lds + 2 * SHM_V);
  float* ws = (float*)(lds + 2 * SHM_V + 2 * SHM_K) + wid * 64; float* li_l = ws;
  float l_reg = 0; f32x16 o[4] = {}; bf16x8 qr[8];
  const bf16_t* Qw = Qb + (long)(wid * QBLK + r32) * LDQ + hi * 8;
#pragma unroll
  for (int d0 = 0; d0 < 8; ++d0) qr[d0] = *reinterpret_cast<const bf16x8*>(Qw + d0 * 16);
  const int sr = tid >> 4, sc = (tid & 15) * 8, vst0 = v_st(sr, sc), vst1 = v_st(32 + sr, sc);
  const int vb0 = (int)(uintptr_t)V_lds + v_rd_base(lane);
  struct { bf16x8 vs0, vs1, ks0, ks1; } sr_[SDEPTH];
#define LD8(p) (*reinterpret_cast<const bf16x8*>(p))
#define SLOAD(i, k0) do { sr_[i].vs0 = LD8(&Vh[(long)((k0) + sr) * LDK + sc]); sr_[i].vs1 = LD8(&Vh[(long)((k0) + 32 + sr) * LDK + sc]); \
    sr_[i].ks0 = LD8(&Kh[(long)((k0) + sr) * LDK + sc]); sr_[i].ks1 = LD8(&Kh[(long)((k0) + 32 + sr) * LDK + sc]); } while (0)
#define SWRITE(b, i) do { *(bf16x8*)((char*)V_lds + (b) * SHM_V + vst0) = sr_[i].vs0;          \
    *(bf16x8*)((char*)V_lds + (b) * SHM_V + vst1) = sr_[i].vs1; int kc = sc * 2;               \
    *(bf16x8*)((char*)K_lds + (b) * SHM_K + KSWZ(sr, kc)) = sr_[i].ks0;                       \
    *(bf16x8*)((char*)K_lds + (b) * SHM_K + KSWZ(32 + sr, kc)) = sr_[i].ks1; } while (0)
#define SWAIT() do { if constexpr (SDEPTH == 2) asm volatile("s_waitcnt vmcnt(4)" ::: "memory"); else asm volatile("s_waitcnt vmcnt(0)" ::: "memory"); } while (0)
  f32x16 pA0, pA1, pB0, pB1; bf16x8 pa0, pa1, pa2, pa3; const int NT = seq / KVBLK;
  constexpr int SE = 0, SO = SDEPTH - 1;
  SLOAD(SE, 0); asm volatile("s_waitcnt vmcnt(0)" ::: "memory"); SWRITE(0, SE); __syncthreads();
  qkt(pA0, pA1, K_lds, qr, r32, hi, nm0); partialSM(pA0);
  SLOAD(SO, KVBLK); if constexpr (SDEPTH == 2) { if (2 < NT) SLOAD(SE, 2 * KVBLK); }
  SWAIT(); SWRITE(1, SO); __syncthreads();
  for (int j = 1; j + 1 < NT; j += 2) {
    SBAR(); qkt(pB0, pB1, (bf16_t*)((char*)K_lds + SHM_K), qr, r32, hi, nm0);
    finishSM(pA0, pA1, l_reg, pa0, pa1, pa2, pa3); SBAR();
    SLOAD(SO, (j + SDEPTH) * KVBLK); SBAR();
    pv_d0(o, vb0, pa0, pa1, pa2, pa3); partialSM(pB0);
    __syncthreads(); SWAIT(); SWRITE(0, SE);
    __syncthreads();
    SBAR(); qkt(pA0, pA1, K_lds, qr, r32, hi, nm0);
    finishSM(pB0, pB1, l_reg, pa0, pa1, pa2, pa3); SBAR();
    if (SDEPTH == 1 || j + 3 < NT) SLOAD(SE, (j + 1 + SDEPTH) * KVBLK); SBAR();
    pv_d0(o, vb0 + (int)SHM_V, pa0, pa1, pa2, pa3); partialSM(pA0);
    __syncthreads(); SWAIT(); SWRITE(1, SO);
    __syncthreads();
  }
  SBAR(); qkt(pB0, pB1, (bf16_t*)((char*)K_lds + SHM_K), qr, r32, hi, nm0);
  finishSM(pA0, pA1, l_reg, pa0, pa1, pa2, pa3); SBAR();
  pv_d0(o, vb0, pa0, pa1, pa2, pa3); partialSM(pB0);
  __syncthreads();
  finishSM(pB0, pB1, l_reg, pa0, pa1, pa2, pa3); SBAR();
  pv_d0(o, vb0 + (int)SHM_V, pa0, pa1, pa2, pa3);
  { auto rr = __builtin_amdgcn_permlane32_swap(__float_as_uint(l_reg), __float_as_uint(l_reg), false, false); l_reg = __uint_as_float(rr[0]) + __uint_as_float(rr[1]); }
  if (hi == 0) li_l[r32] = l_reg; asm volatile("s_waitcnt lgkmcnt(0)" ::: "memory");
  float rli[16];
#pragma unroll
  for (int r = 0; r < 16; ++r) rli[r] = __builtin_amdgcn_rcpf(li_l[crow(r, hi)]);
  bf16_t* Ow = Ob + (long)(wid * QBLK) * LDO;
#pragma unroll
  for (int r = 0; r < 16; ++r) { int orow = crow(r, hi);
    for (int d0 = 0; d0 < 4; ++d0) Ow[(long)orow * LDO + d0 * 32 + r32] = (bf16_t)f2bf(o[d0][r] * rli[r]); }
  __syncthreads();
#undef LD8
#undef SLOAD
#undef SWRITE
#undef SWAIT
}
constexpr int SLOT = 32768;
__device__ __forceinline__ void attn_dense_body_dma(bf16_t* Qb, const bf16_t* Kh, int seq, char* lds, LAS unsigned char* ldsl, const int tid, const long odelta, const float nm0,
                                                    const float* qgain, const float* rope, const int lpos0) {
  const bf16_t* Vh = (const bf16_t*)((const char*)Kh + (WS_VB - WS_KB)); bf16_t* Ob = (bf16_t*)((char*)Qb + odelta);
  const int wid = __builtin_amdgcn_readfirstlane(tid >> 6), lane = tid & 63, r32 = lane & 31, hi = lane >> 5;
  float* li_l = (float*)(lds + 3 * SLOT) + wid * 64;
  float l_reg = 0; f32x16 o[4] = {}; bf16x8 qr[8];
  const bf16_t* Qw = Qb + (long)(wid * QBLK + r32) * LDQ + hi * 8;
#pragma unroll
  for (int d0 = 0; d0 < 8; ++d0) qr[d0] = *reinterpret_cast<const bf16x8*>(Qw + d0 * 16);
  { f32x4 x[8][2]; float ss = 0.f;
#pragma unroll
    for (int d0 = 0; d0 < 8; ++d0) { unpack8(*reinterpret_cast<const u32x4*>(&qr[d0]), x[d0][0], x[d0][1]);
#pragma unroll
        for (int i = 0; i < 4; ++i) ss += x[d0][0][i] * x[d0][0][i] + x[d0][1][i] * x[d0][1][i]; }
    { auto rr = __builtin_amdgcn_permlane32_swap(__float_as_uint(ss), __float_as_uint(ss), false, false); ss = __uint_as_float(rr[0]) + __uint_as_float(rr[1]); }
    const float rstd = (SCALE * 1.4426950408889634f) * __builtin_amdgcn_rsqf(ss * (1.0f / D) + EPS);
#pragma unroll
    for (int d0 = 0; d0 < 8; ++d0) { const f32x4 g0 = *(const f32x4*)(qgain + d0 * 16 + hi * 8), g1 = *(const f32x4*)(qgain + d0 * 16 + hi * 8 + 4); x[d0][0] = x[d0][0] * rstd * g0; x[d0][1] = x[d0][1] * rstd * g1; }
    if (lpos0 >= 0) { const int lpos = lpos0 + wid * QBLK + r32;
#pragma unroll
      for (int ax = 0; ax < 2; ++ax) { const int posi = ax == 0 ? (lpos >> 6) : (lpos & 63);
#pragma unroll
        for (int dd = 0; dd < 2; ++dd) { const float* cp = rope + posi * 32 + dd * 16 + hi * 8; const int d1 = ax * 4 + dd, d2 = d1 + 2;
#pragma unroll
          for (int hf = 0; hf < 2; ++hf) { const f32x4 cs = *(const f32x4*)(cp + 4 * hf), sn = *(const f32x4*)(cp + 2048 + 4 * hf); const f32x4 x1 = x[d1][hf], x2 = x[d2][hf];
              x[d1][hf] = x1 * cs - x2 * sn; x[d2][hf] = x1 * sn + x2 * cs; } } } }
#pragma unroll
    for (int d0 = 0; d0 < 8; ++d0) { const u32x4 w = pack8(x[d0][0], x[d0][1]); qr[d0] = *reinterpret_cast<const bf16x8*>(&w); } }
  unsigned ksrc[2], vsrc[2];
#pragma unroll
  for (int q = 0; q < 2; ++q) { const int b = q * 8192 + wid * 1024 + lane * 16;
      const int row = b >> 8, cb = (b & 255) ^ ((row & 7) << 4); ksrc[q] = (unsigned)(row * (LDK * 2) + cb);
      const int sub = b >> 9, w = (b & 511) >> 1, kk = (sub >> 2) * 8 + (w >> 5), c = (sub & 3) * 32 + (w & 31), k = (kk & ~0xC) | ((kk & 4) << 1) | ((kk & 8) >> 1);
      vsrc[q] = (unsigned)(k * (LDK * 2) + c * 2); }
#define ADMA(tile, s) do { const char* kb_ = (const char*)Kh + (size_t)(tile) * (KVBLK * LDK * 2); const char* vb_ = (const char*)Vh + (size_t)(tile) * (KVBLK * LDK * 2); \
    _Pragma("unroll") for (int q = 0; q < 2; ++q) __builtin_amdgcn_global_load_lds((const unsigned*)(kb_ + ksrc[q]), (LAS unsigned*)(ldsl + (s) * SLOT + q * 8192 + wid * 1024), 16, 0, 0); \
    _Pragma("unroll") for (int q = 0; q < 2; ++q) __builtin_amdgcn_global_load_lds((const unsigned*)(vb_ + vsrc[q]), (LAS unsigned*)(ldsl + (s) * SLOT + 16384 + q * 8192 + wid * 1024), 16, 0, 0); } while (0)
#define KSLOT(s) ((const bf16_t*)(lds + (s) * SLOT))
#define VBASE(s) (vbl + (s) * SLOT)
#define NEXT3(s) ((s) == 2 ? 0 : (s) + 1)
  const int vbl = (int)(uintptr_t)(lds + 16384) + v_rd_base(lane);
  f32x16 pA0, pA1, pB0, pB1; bf16x8 pa0, pa1, pa2, pa3; const int NT = seq / KVBLK;
  ADMA(0, 0);
  __syncthreads(); ADMA(1, 1);
  qkt(pA0, pA1, KSLOT(0), qr, r32, hi, nm0); partialSM(pA0);
  int sj = 1;
  for (int j = 1; j + 1 < NT; j += 2) {
    { const int sp = sj == 0 ? 2 : sj - 1, sn = NEXT3(sj);
      __syncthreads(); ADMA(j + 1, sn);
      SBAR(); qkt(pB0, pB1, KSLOT(sj), qr, r32, hi, nm0);
      finishSM(pA0, pA1, l_reg, pa0, pa1, pa2, pa3); SBAR();
      pv_d0(o, VBASE(sp), pa0, pa1, pa2, pa3); partialSM(pB0);
      sj = sn; }
    { const int sp = sj == 0 ? 2 : sj - 1, sn = NEXT3(sj);
      __syncthreads(); if (j + 2 < NT) ADMA(j + 2, sn);
      SBAR(); qkt(pA0, pA1, KSLOT(sj), qr, r32, hi, nm0);
      finishSM(pB0, pB1, l_reg, pa0, pa1, pa2, pa3); SBAR();
      pv_d0(o, VBASE(sp), pa0, pa1, pa2, pa3); partialSM(pA0);
      sj = sn; }
  }
  { const int sp = sj == 0 ? 2 : sj - 1;
    __syncthreads();
    SBAR(); qkt(pB0, pB1, KSLOT(sj), qr, r32, hi, nm0);
    finishSM(pA0, pA1, l_reg, pa0, pa1, pa2, pa3); SBAR();
    pv_d0(o, VBASE(sp), pa0, pa1, pa2, pa3); partialSM(pB0);
    finishSM(pB0, pB1, l_reg, pa0, pa1, pa2, pa3); SBAR();
    pv_d0(o, VBASE(sj), pa0, pa1, pa2, pa3); }
  { auto rr = __builtin_amdgcn_permlane32_swap(__float_as_uint(l_reg), __float_as_uint(l_reg), false, false); l_reg = __uint_as_float(rr[0]) + __uint_as_float(rr[1]); }
  if (hi == 0) li_l[r32] = l_reg; asm volatile("s_waitcnt lgkmcnt(0)" ::: "memory");
  float rli[16];
#pragma unroll
  for (int r = 0; r < 16; ++r) rli[r] = __builtin_amdgcn_rcpf(li_l[crow(r, hi)]);
  bf16_t* Ow = Ob + (long)(wid * QBLK) * LDO;
  LAS unsigned char* stg = ldsl + 3 * SLOT + 2048 + wid * 2048;
#pragma unroll
  for (int pp = 0; pp < 4; ++pp) {
#pragma unroll
    for (int rr = 0; rr < 4; ++rr)
#pragma unroll
      for (int d0 = 0; d0 < 4; ++d0) *(LAS bf16_t*)(stg + (4 * hi + rr) * 256 + (d0 * 32 + r32) * 2) = (bf16_t)f2bf(o[d0][4 * pp + rr] * rli[4 * pp + rr]);
#pragma unroll
    for (int k = 0; k < 2; ++k) { const int id = k * 64 + lane; const u32x4 w = *(const LAS u32x4*)(stg + id * 16);
      *(u32x4*)(Ow + (long)(8 * pp + (id >> 4)) * LDO + (id & 15) * 8) = w; }
  }
  __syncthreads();
#undef ADMA
#undef KSLOT
#undef VBASE
#undef NEXT3
}
}

namespace peer {
__device__ __forceinline__ float vmax(float a, float b) { float r; asm("v_max_f32 %0, %1, %2" : "=v"(r) : "v"(a), "v"(b)); return r; }
__device__ __forceinline__ float vmin(float a, float b) { float r; asm("v_min_f32 %0, %1, %2" : "=v"(r) : "v"(a), "v"(b)); return r; }
__device__ __forceinline__ void cswap(float& hi_, float& lo_) { const float mx = vmax(hi_, lo_), mn = vmin(hi_, lo_); hi_ = mx; lo_ = mn; }
__device__ __forceinline__ void sort16(float (&v)[16]) {
    constexpr int NET[63][2] = {{0,1},{2,3},{0,2},{1,3},{1,2},{4,5},{6,7},{4,6},{5,7},{5,6},{0,4},{2,6},{2,4},{1,5},{3,7},{3,5},{1,2},{3,4},{5,6},{8,9},{10,11},{8,10},{9,11},{9,10},{12,13},{14,15},{12,14},{13,15},{13,14},
        {8,12},{10,14},{10,12},{9,13},{11,15},{11,13},{9,10},{11,12},{13,14},{0,8},{4,12},{4,8},{2,10},{6,14},{6,10},{2,4},{6,8},{10,12},{1,9},{5,13},{5,9},{3,11},{7,15},{7,11},{3,5},{7,9},{11,13},{1,2},{3,4},{5,6},{7,8},{9,10},{11,12},{13,14}};
#pragma unroll
    for (int k = 0; k < 63; ++k) cswap(v[NET[k][0]], v[NET[k][1]]);
}
__device__ __forceinline__ void bmerge16(float (&v)[16]) {
#pragma unroll
    for (int j = 8; j > 0; j >>= 1)
#pragma unroll
        for (int i = 0; i < 16; ++i) { const int l = i ^ j; if (l > i) cswap(v[i], v[l]); }
}
__device__ __forceinline__ void merge_top16(float (&a)[16], const float (&b)[16]) {
#pragma unroll
    for (int i = 0; i < 16; ++i) a[i] = vmax(a[i], b[15 - i]);
    bmerge16(a);
}
__device__ __forceinline__ float setlow(float v, unsigned mask, unsigned bits) { return __uint_as_float((__float_as_uint(v) & ~mask) | bits); }
__device__ __forceinline__ void top16_of_acc(const f32x16 (&acc)[4], int hi, float (&out)[16]) {
    float t[16];
#pragma unroll
    for (int blk = 0; blk < 4; ++blk) {
#pragma unroll
        for (int r = 0; r < 16; ++r) { const unsigned key = (unsigned)(32 * blk + (r & 3) + 8 * (r >> 2)) | ((unsigned)hi << 2); if (blk == 0) out[r] = setlow(acc[blk][r], 0x7Fu, key); else t[r] = setlow(acc[blk][r], 0x7Fu, key); }
        if (blk == 0) sort16(out); else { sort16(t); merge_top16(out, t); }
    }
}
}

struct Args { const float* in[28]; float* out; unsigned char* ws; int ph_lo, ph_hi; };
enum { I_X = 0, I_C, I_CTX, I_CCTX, I_WMOD, I_BMOD, I_NMG, I_WIN, I_QNG, I_KNG, I_ARE, I_AIM, I_LDT, I_BRE, I_BIM, I_CRE, I_CIM, I_SD, I_WGLU, I_BGLU, I_WBA, I_WBS, I_WO, I_NFG, I_PWQ, I_PKEYS, I_PU, I_PV };

__device__ __forceinline__ void transpose_item(const float* W, int K, int N, bf16_t* WT, LAS float* scr, int item, int lane) {
    const int nblk = N / 32, kb = item / nblk, nb = item % nblk, k0 = 64 * kb, n0 = 32 * nb;
    { f32x4 t[8]; const int kr = lane >> 3, nq = (lane & 7) * 4;
#pragma unroll
      for (int i = 0; i < 8; ++i) t[i] = *(const f32x4*)(W + (size_t)(k0 + 8 * i + kr) * N + n0 + nq);
#pragma unroll
      for (int i = 0; i < 8; ++i) { LAS float* d = scr + (8 * i + kr) * 33 + nq; d[0] = t[i][0]; d[1] = t[i][1]; d[2] = t[i][2]; d[3] = t[i][3]; } }
    asm volatile("s_waitcnt lgkmcnt(0)" ::: "memory");
    const int c = lane & 7;
#pragma unroll
    for (int j = 0; j < 4; ++j) { const int n = (lane >> 3) + 8 * j; const LAS float* s = scr + (8 * c) * 33 + n;
        u32x4 o; o.x = pk2(s[0 * 33], s[1 * 33]); o.y = pk2(s[2 * 33], s[3 * 33]); o.z = pk2(s[4 * 33], s[5 * 33]); o.w = pk2(s[6 * 33], s[7 * 33]);
        *(u32x4*)(WT + (size_t)(n0 + n) * K + k0 + 8 * c) = o; }
    asm volatile("s_waitcnt lgkmcnt(0)" ::: "memory");
}

__device__ __forceinline__ void norm_mod_row(const float* hr, const float* g, const float* sh, const float* sc, bf16_t* orow, int lane) {
    f32x4 v[4]; float ss = 0.f;
#pragma unroll
    for (int j = 0; j < 4; ++j) { v[j] = *(const f32x4*)(hr + (j >> 1) * 512 + lane * 8 + (j & 1) * 4); ss += (v[j][0] * v[j][0] + v[j][1] * v[j][1]) + (v[j][2] * v[j][2] + v[j][3] * v[j][3]); }
    ss = wave_sum(ss, lane);
    const float rstd = __builtin_amdgcn_rsqf(ss * (1.0f / DM) + EPS);
#pragma unroll
    for (int hh = 0; hh < 2; ++hh) {
        const int c0 = hh * 512 + lane * 8; f32x4 o[2];
#pragma unroll
        for (int j = 0; j < 2; ++j) { const f32x4 gg = *(const f32x4*)(g + c0 + 4 * j), s1 = *(const f32x4*)(sc + c0 + 4 * j), s0 = *(const f32x4*)(sh + c0 + 4 * j);
            o[j] = v[hh * 2 + j] * rstd * gg * (1.0f + s1) + s0; }
        *(u32x4*)(orow + c0) = pack8(o[0], o[1]);
    }
}
__device__ __forceinline__ const float* hrow_c(const float* hlat, const float* hctx, int r) { return r < NLAT ? hlat + (size_t)r * DM : hctx + (size_t)(r - NLAT) * DM; }
__device__ __forceinline__ float* hrow_m(float* hlat, float* hctx, int r) { return r < NLAT ? hlat + (size_t)r * DM : hctx + (size_t)(r - NLAT) * DM; }

__device__ __forceinline__ void p0a(const Args& a, LAS unsigned char* lds, int bx, int G, int tid) {
    const int lane = tid & 63, wave = tid >> 6, gw = bx * 8 + wave, NGW = G * 8;
    unsigned char* ws = a.ws;
    { LAS float* scr = (LAS float*)(lds + wave * 16384);
      constexpr int I_IN = 16 * 128, I_BA = 16 * 32, I_BS = 8 * 32, I_OO = 16 * 32, I_GL = 8 * 16, I_QQ = 16 * 64, PER = I_IN + I_BA + I_BS + I_OO + I_GL + I_QQ;
      for (int it = gw; it < PER * DEPTH; it += NGW) {
          const int l = it / PER; int r = it - l * PER; bf16_t* base = (bf16_t*)(ws + WS_WT + (size_t)l * WT_LAYER);
          if (r < I_IN) { transpose_item(a.in[I_WIN] + (size_t)l * DM * INW, DM, INW, (bf16_t*)((char*)base + WT_IN), scr, r, lane); continue; } r -= I_IN;
          if (r < I_BA) { transpose_item(a.in[I_WBA] + (size_t)l * DM * DM, DM, DM, (bf16_t*)((char*)base + WT_BA), scr, r, lane); continue; } r -= I_BA;
          if (r < I_BS) { transpose_item(a.in[I_WBS] + (size_t)l * SSMW * DM, SSMW, DM, (bf16_t*)((char*)base + WT_BS), scr, r, lane); continue; } r -= I_BS;
          if (r < I_OO) { transpose_item(a.in[I_WO] + (size_t)l * DM * DM, DM, DM, (bf16_t*)((char*)base + WT_O), scr, r, lane); continue; } r -= I_OO;
          if (r < I_GL) { transpose_item(a.in[I_WGLU] + (size_t)l * SSMW * SSMW, SSMW, SSMW, (bf16_t*)((char*)base + WT_GLU), scr, r, lane); continue; } r -= I_GL;
          transpose_item(a.in[I_PWQ] + (size_t)l * DM * PQW, DM, PQW, (bf16_t*)((char*)base + WT_Q), scr, r, lane);
      } }
    { const size_t gt = (size_t)bx * 512 + tid, GT = (size_t)G * 512;
      { typedef float v16f_ __attribute__((ext_vector_type(16))); typedef int v6i_ __attribute__((ext_vector_type(6)));
        constexpr int NROWS = 2 * DEPTH * PEXP;
        f32x4 cur[2][4];
#define P0A_TLOAD(dst, r0_) do { _Pragma("unroll") for (int rr = 0; rr < 2; ++rr) { const int row = ((r0_) + rr * NGW < NROWS) ? (r0_) + rr * NGW : (r0_); const bool isU = row < DEPTH * PEXP; const int idx = isU ? row : row - DEPTH * PEXP; \
            const float* src = (isU ? a.in[I_PU] : a.in[I_PV]) + (size_t)idx * DM + lane * 16; _Pragma("unroll") for (int j = 0; j < 4; ++j) dst[rr][j] = *(const f32x4*)(src + 4 * j); } } while (0)
        if (gw < NROWS) P0A_TLOAD(cur, gw);
        for (int row0 = gw; row0 < NROWS; row0 += 2 * NGW) {
          f32x4 nx[2][4];
          if (row0 + 2 * NGW < NROWS) P0A_TLOAD(nx, row0 + 2 * NGW);
          float v[2][16]; float sc[2], inv[2];
#pragma unroll
          for (int rr = 0; rr < 2; ++rr)
#pragma unroll
              for (int j = 0; j < 4; ++j) { v[rr][4 * j] = cur[rr][j][0]; v[rr][4 * j + 1] = cur[rr][j][1]; v[rr][4 * j + 2] = cur[rr][j][2]; v[rr][4 * j + 3] = cur[rr][j][3]; }
#pragma unroll
          for (int rr = 0; rr < 2; ++rr) { float mx = 0.f;
#pragma unroll
              for (int j = 0; j < 16; ++j) mx = fmaxf(mx, fabsf(v[rr][j]));
#pragma unroll
              for (int o = 1; o < 64; o <<= 1) mx = fmaxf(mx, shflx(mx, o, lane));
              sc[rr] = mx > 0.f ? QMAX / mx : 1.0f; inv[rr] = mx > 0.f ? mx * (1.0f / QMAX) : 1.0f; }
#if PEER_FP4
#pragma unroll
          for (int rr = 0; rr < 2; ++rr) { const int row = row0 + rr * NGW; if (row < NROWS) { const bool isU = row < DEPTH * PEXP; const int idx = isU ? row : row - DEPTH * PEXP;
              unsigned w0 = 0u, w1 = 0u;
#define P0A_PK(b) w0 = __builtin_amdgcn_cvt_scalef32_pk_fp4_f32(w0, v[rr][2 * b] * sc[rr], v[rr][2 * b + 1] * sc[rr], 1.0f, b); w1 = __builtin_amdgcn_cvt_scalef32_pk_fp4_f32(w1, v[rr][8 + 2 * b] * sc[rr], v[rr][8 + 2 * b + 1] * sc[rr], 1.0f, b);
              P0A_PK(0) P0A_PK(1) P0A_PK(2) P0A_PK(3)
#undef P0A_PK
              unsigned* dst = (unsigned*)(ws + (isU ? WS_PU : WS_PV) + (size_t)idx * PROW + lane * 8);
              dst[0] = w0; dst[1] = w1;
              if (lane == 0) ((float*)(ws + (isU ? WS_PSU : WS_PSV)))[idx] = inv[rr]; } }
#else
          v16f_ ga, gb;
#pragma unroll
          for (int j = 0; j < 8; ++j) { ga[j] = v[0][2 * j] * sc[0]; gb[j] = v[0][2 * j + 1] * sc[0]; ga[8 + j] = v[1][2 * j] * sc[1]; gb[8 + j] = v[1][2 * j + 1] * sc[1]; }
          const v6i_ pk = __builtin_amdgcn_cvt_scalef32_2xpk16_fp6_f32(ga, gb, 1.0f);
#pragma unroll
          for (int rr = 0; rr < 2; ++rr) { const int row = row0 + rr * NGW; if (row < NROWS) { const bool isU = row < DEPTH * PEXP; const int idx = isU ? row : row - DEPTH * PEXP;
              unsigned* dst = (unsigned*)(ws + (isU ? WS_PU : WS_PV) + (size_t)idx * 768 + lane * 12);
              dst[0] = (unsigned)pk[3 * rr]; dst[1] = (unsigned)pk[3 * rr + 1]; dst[2] = (unsigned)pk[3 * rr + 2];
              if (lane == 0) ((float*)(ws + (isU ? WS_PSU : WS_PSV)))[idx] = inv[rr]; } }
#endif
#pragma unroll
          for (int rr = 0; rr < 2; ++rr)
#pragma unroll
              for (int j = 0; j < 4; ++j) cur[rr][j] = nx[rr][j];
        } }
#undef P0A_TLOAD
      const size_t k8 = (size_t)DEPTH * 2 * PKEYS * 128 / 8;
      for (size_t i = gt; i < k8; i += GT) { const float* src = a.in[I_PKEYS] + i * 8; const f32x4 x0 = *(const f32x4*)src, x1 = *(const f32x4*)(src + 4);
          u32x4 o; o.x = pk2(x0[0], x0[1]); o.y = pk2(x0[2], x0[3]); o.z = pk2(x1[0], x1[1]); o.w = pk2(x1[2], x1[3]);
          *(u32x4*)((bf16_t*)(ws + WS_KEYS) + i * 8) = o; }
      const size_t nc4 = (size_t)NCTX * DM / 4;
      for (size_t i = gt; i < nc4; i += GT) ((f32x4*)(ws + WS_HCTX))[i] = ((const f32x4*)a.in[I_CTX])[i];
      if (bx == 0) { float* ct = (float*)(ws + WS_ROPE); for (int i = tid; i < 64 * 32; i += 512) { const int pos = i >> 5, f = i & 31;
          const float invf = (float)pow(10000.0, -(double)f / 32.0); const float ang = (float)pos * invf; ct[i] = (float)cos((double)ang); ct[2048 + i] = (float)sin((double)ang); } }
    }
    { __syncthreads();
      LAS float* sv = (LAS float*)lds;
      LAS float* part = (LAS float*)(lds + 9 * 1024 * 4);
      for (int i = tid; i < 9 * DM; i += 512) { const int m = i >> 10, k = i & 1023; const float c = m < NB ? a.in[I_C][m * DM + k] : a.in[I_CCTX][k]; sv[i] = c / (1.0f + __expf(-c)); }
      __syncthreads();
      for (int it = bx; it < DEPTH * (MODW / 32); it += G) {
          const int l = it / (MODW / 32), jb = it % (MODW / 32), kh = lane >> 5, j = jb * 32 + (lane & 31), kb = wave * 128 + kh * 64;
          const float* w = a.in[I_WMOD] + ((size_t)l * DM + kb) * MODW + j;
          float acc[9];
#pragma unroll
          for (int m = 0; m < 9; ++m) acc[m] = 0.f;
#pragma unroll 1
          for (int k0 = 0; k0 < 64; k0 += 16) { float wv[16];
#pragma unroll
              for (int i = 0; i < 16; ++i) wv[i] = w[(size_t)(k0 + i) * MODW];
#pragma unroll
              for (int i = 0; i < 16; ++i)
#pragma unroll
                  for (int m = 0; m < 9; ++m) acc[m] += sv[m * DM + kb + k0 + i] * wv[i]; }
#pragma unroll
          for (int m = 0; m < 9; ++m) part[(wave * 9 + m) * 64 + lane] = acc[m];
          __syncthreads();
          for (int i = tid; i < 9 * 32; i += 512) { const int m = i >> 5, jj = i & 31; float s = 0.f;
#pragma unroll
              for (int w8 = 0; w8 < 8; ++w8) s += part[(w8 * 9 + m) * 64 + jj] + part[(w8 * 9 + m) * 64 + 32 + jj];
              ((float*)(ws + WS_MOD))[((size_t)l * 9 + m) * MODW + jb * 32 + jj] = s + a.in[I_BMOD][(size_t)l * MODW + jb * 32 + jj]; }
          __syncthreads();
      }
    }
}

__device__ __forceinline__ void norm_pass(const Args& a, int l, int sel, bf16_t* dst, int gw, int NGW, int lane, int nrows, const float* hlat) {
    const float* mod = (const float*)(a.ws + WS_MOD) + (size_t)l * 9 * MODW;
    const float* g = a.in[sel ? I_NFG : I_NMG] + (size_t)l * DM;
    const float* hctx = (const float*)(a.ws + WS_HCTX);
    for (int r = gw; r < nrows; r += NGW) { const float* mr = mod + (size_t)modrow_of(r) * MODW + sel * 3 * DM;
        norm_mod_row(hrow_c(hlat, hctx, r), g, mr, mr + DM, dst + (size_t)r * DM, lane); }
}

__device__ __forceinline__ void ssm_tables(const Args& a, int l, LAS unsigned char* lds, int bx, int G, int tid) {
    LAS float* ErT = (LAS float*)lds;
    LAS float* EiT = ErT + 1024;
    LAS float* kr = EiT + 1024;
    LAS float* ki = kr + 128;
    LAS float* red = ki + 128;
    LAS float* E2r = red + 2048;
    LAS float* E2i = E2r + 512;
    LAS float* E3r = E2i + 512;
    LAS float* E3i = E3r + 512;
    LAS float* Cr = E3i + 512;
    LAS float* Ci = Cr + 2048;
    LAS float* kBr = Ci + 2048;
    LAS float* kBi = kBr + 2048;
    bf16_t* WCAT = (bf16_t*)(a.ws + WS_WCAT); bf16_t* WST = (bf16_t*)(a.ws + WS_WSTATE);
    for (int unit = bx; unit < SG * 8; unit += G) {
        const int g = unit >> 3, oc = unit & 7;
        __syncthreads();
        { const int d = tid >> 8, v = tid & 255; const size_t o4 = (((size_t)l * 2 + d) * SG + g) * (SP * SN) + v * 4;
          *(LAS f32x4*)(Cr + tid * 4) = *(const f32x4*)(a.in[I_CRE] + o4); *(LAS f32x4*)(Ci + tid * 4) = *(const f32x4*)(a.in[I_CIM] + o4);
          *(LAS f32x4*)(kBr + tid * 4) = *(const f32x4*)(a.in[I_BRE] + o4); *(LAS f32x4*)(kBi + tid * 4) = *(const f32x4*)(a.in[I_BIM] + o4); }
        {   const int dn = tid & 127, d = dn >> 6, n = dn & 63; const size_t o = (((size_t)l * 2 + d) * SG + g) * SN + n;
            const float are = a.in[I_ARE][o], aim = a.in[I_AIM][o], dt = expf(a.in[I_LDT][((size_t)l * 2 + d) * SG + g]);
            const float th = aim * dt;
            if (tid < 128) { const float mag = expf(are * dt), abr = mag * cosf(th), abi = mag * sinf(th);
                const float den = are * are + aim * aim, nr = abr - 1.0f, ni = abi;
                kr[tid] = (nr * are + ni * aim) / den; ki[tid] = (ni * are - nr * aim) / den; }
#pragma unroll
            for (int ii = 0; ii < 2; ++ii) { const int i = (tid >> 7) + 4 * ii, dl = -31 + 8 * oc + i; const int e = dl < 0 ? -dl : dl;
                const bool on = (dl == 0) || (dl > 0 && d == 0) || (dl < 0 && d == 1);
                const float mg = expf((float)e * are * dt), ph = (float)e * th;
                ErT[dn * 8 + i] = (on && dl <= 31) ? mg * cosf(ph) : 0.f; EiT[dn * 8 + i] = (on && dl <= 31) ? mg * sinf(ph) : 0.f; }
        }
        {
            const int q4 = tid >> 7, d = (tid >> 6) & 1, n = tid & 63; const size_t o = (((size_t)l * 2 + d) * SG + g) * SN + n;
            const float are = a.in[I_ARE][o], aim = a.in[I_AIM][o], dt = expf(a.in[I_LDT][((size_t)l * 2 + d) * SG + g]);
            const int t = 4 * oc + q4;
            const int e2 = d == 0 ? t + 1 : ST - t;
            const int e3 = d == 0 ? ST - 1 - t : t;
            const float m2 = expf((float)e2 * are * dt), p2 = (float)e2 * aim * dt, m3 = expf((float)e3 * are * dt), p3 = (float)e3 * aim * dt;
            E2r[tid] = m2 * cosf(p2); E2i[tid] = m2 * sinf(p2); E3r[tid] = m3 * cosf(p3); E3i[tid] = m3 * sinf(p3);
        }
        __syncthreads();
        { const int dn = tid >> 2; const float k_r = kr[dn], k_i = ki[dn];
          const f32x4 br = *(LAS f32x4*)(kBr + tid * 4), bi = *(LAS f32x4*)(kBi + tid * 4);
          *(LAS f32x4*)(kBr + tid * 4) = k_r * br - k_i * bi; *(LAS f32x4*)(kBi + tid * 4) = k_r * bi + k_i * br; }
        __syncthreads();
        {
            const int pq = tid & 255, p = pq >> 4, q = pq & 15, nh = tid >> 8;
            float acc[8];
#pragma unroll
            for (int i = 0; i < 8; ++i) acc[i] = 0.f;
            for (int d = 0; d < 2; ++d) {
#pragma unroll 4
                for (int n = nh * 32; n < nh * 32 + 32; ++n) {
                    const float cr = Cr[d * 1024 + p * 64 + n], ci = Ci[d * 1024 + p * 64 + n], Br = kBr[d * 1024 + n * 16 + q], Bi = kBi[d * 1024 + n * 16 + q];
                    const float xr = cr * Br - ci * Bi, xi = cr * Bi + ci * Br;
                    const f32x4 e0 = *(LAS f32x4*)(ErT + (d * 64 + n) * 8), e1 = *(LAS f32x4*)(ErT + (d * 64 + n) * 8 + 4), f0 = *(LAS f32x4*)(EiT + (d * 64 + n) * 8), f1 = *(LAS f32x4*)(EiT + (d * 64 + n) * 8 + 4);
#pragma unroll
                    for (int i = 0; i < 4; ++i) { acc[i] += xr * e0[i] - xi * f0[i]; acc[4 + i] += xr * e1[i] - xi * f1[i]; }
                }
            }
            if (nh == 1) {
#pragma unroll
                for (int i = 0; i < 8; ++i) red[i * 256 + pq] = acc[i]; }
            __syncthreads();
            if (nh == 0) {
#pragma unroll
                for (int i = 0; i < 8; ++i) red[i * 256 + pq] += acc[i]; }
            __syncthreads();
            for (int idx = tid; idx < 8 * 32 * 32; idx += 512) {
                const int i = idx >> 10, j = (idx >> 5) & 31, p2 = (idx >> 1) & 15, qh = idx & 1, dl = -31 + 8 * oc + i;
                if (dl > 31) continue;
                const int ad = dl < 0 ? -dl : dl; if (j >= ST - ad) continue;
                const int t = (dl > 0 ? dl : 0) + j, s = t - dl;
                const f32x4 v0 = *(LAS f32x4*)(red + i * 256 + p2 * 16 + qh * 8), v1 = *(LAS f32x4*)(red + i * 256 + p2 * 16 + qh * 8 + 4);
                *(u32x4*)(WCAT + ((size_t)g * 512 + t * SP + p2) * KCAT + s * SP + qh * 8) = pack8(v0, v1);
            }
        }
        for (int idx = tid; idx < 4 * 16 * 32; idx += 512) {
            const int kk8 = idx & 31, rp = idx >> 5, q4 = rp >> 4, p = rp & 15, d = kk8 >> 4, part = (kk8 >> 3) & 1, n0 = (kk8 & 7) * 8, t = 4 * oc + q4;
            f32x4 o0, o1;
#pragma unroll
            for (int e = 0; e < 8; ++e) { const int n = n0 + e; const float cr = Cr[d * 1024 + p * 64 + n], ci = Ci[d * 1024 + p * 64 + n], er = E2r[q4 * 128 + d * 64 + n], ei = E2i[q4 * 128 + d * 64 + n];
                const float v = part == 0 ? (cr * er - ci * ei) : -(cr * ei + ci * er); if (e < 4) o0[e] = v; else o1[e - 4] = v; }
            *(u32x4*)(WCAT + ((size_t)g * 512 + t * SP + p) * KCAT + 512 + kk8 * 8) = pack8(o0, o1);
        }
        for (int idx = tid; idx < 256 * 8; idx += 512) {
            const int c8 = idx & 7, j = idx >> 3, q4 = c8 >> 1, q0 = (c8 & 1) * 8, d = j >> 7, part = (j >> 6) & 1, n = j & 63, s = 4 * oc + q4;
            const float er = E3r[q4 * 128 + d * 64 + n], ei = E3i[q4 * 128 + d * 64 + n];
            f32x4 o0, o1;
#pragma unroll
            for (int e = 0; e < 8; ++e) { const float Br = kBr[d * 1024 + n * 16 + q0 + e], Bi = kBi[d * 1024 + n * 16 + q0 + e];
                const float v = part == 0 ? (er * Br - ei * Bi) : (er * Bi + ei * Br); if (e < 4) o0[e] = v; else o1[e - 4] = v; }
            *(u32x4*)(WST + ((size_t)g * 256 + j) * 512 + s * SP + q0) = pack8(o0, o1);
        }
    }
    __syncthreads();
}

__device__ __forceinline__ void ssm_carry(const Args& a, int l, int vb, int tid) {
    const int idx = vb * 512 + tid, n = idx & 63, d = (idx >> 6) & 1, g = (idx >> 7) & 31, b = idx >> 12;
    const size_t o = (((size_t)l * 2 + d) * SG + g) * SN + n;
    const float are = a.in[I_ARE][o], aim = a.in[I_AIM][o], dt = expf(a.in[I_LDT][((size_t)l * 2 + d) * SG + g]);
    const float mg = expf((float)ST * are * dt), ph = (float)ST * aim * dt, pr = mg * cosf(ph), pi = mg * sinf(ph);
    const float* SX = (const float*)(a.ws + WS_SX) + (size_t)g * NCOLP * 256 + d * 128 + n;
    bf16_t* UC = (bf16_t*)(a.ws + WS_UCAT) + (size_t)g * NCOLP * KCAT + 512 + d * 128 + n;
    float hr = 0.f, hi = 0.f;
#pragma unroll 1
    for (int st0 = 0; st0 < NCH; st0 += 34) {
        float xr[34], xi[34];
#pragma unroll
        for (int k = 0; k < 34; ++k) { const int st = st0 + k; int c;
            if (d == 0) c = st < 8 ? NCHL + st : st - 8; else c = st < 8 ? NCHL + 7 - st : NCHL - 1 - (st - 8);
            const int col = c * 8 + b; xr[k] = SX[(size_t)col * 256]; xi[k] = SX[(size_t)col * 256 + 64]; }
#pragma unroll
        for (int k = 0; k < 34; ++k) { const int st = st0 + k; int c;
            if (d == 0) c = st < 8 ? NCHL + st : st - 8; else c = st < 8 ? NCHL + 7 - st : NCHL - 1 - (st - 8);
            const int col = c * 8 + b;
            UC[(size_t)col * KCAT] = (bf16_t)f2bf(hr); UC[(size_t)col * KCAT + 64] = (bf16_t)f2bf(hi);
            const float nr = pr * hr - pi * hi + xr[k], ni = pr * hi + pi * hr + xi[k]; hr = nr; hi = ni; }
    }
}

#define DPPX(v, ctrl) __builtin_bit_cast(float, __builtin_amdgcn_update_dpp(0, __builtin_bit_cast(int, (v)), (ctrl), 0xf, 0xf, false))
__device__ __forceinline__ void qk_head_rows(bf16_t* p, const float* gain, const float* rope, int lpos  , int lane, const float osc) {
    const int sub = lane & 7;
    u32x4 w0 = *(const u32x4*)p, w1 = *(const u32x4*)(p + 8);
    float x[16]; { f32x4 a0, a1, b0, b1; unpack8(w0, a0, a1); unpack8(w1, b0, b1);
#pragma unroll
        for (int i = 0; i < 4; ++i) { x[i] = a0[i]; x[4 + i] = a1[i]; x[8 + i] = b0[i]; x[12 + i] = b1[i]; } }
    float ss = 0.f;
#pragma unroll
    for (int i = 0; i < 16; ++i) ss += x[i] * x[i];
    ss += DPPX(ss, 0xB1);
    ss += DPPX(ss, 0x4E);
    ss += DPPX(ss, 0x141);
    const float rstd = osc * __builtin_amdgcn_rsqf(ss * (1.0f / HD) + EPS);
    const f32x4* g4 = (const f32x4*)(gain + sub * 16);
#pragma unroll
    for (int j = 0; j < 4; ++j) { const f32x4 gg = g4[j];
#pragma unroll
        for (int i = 0; i < 4; ++i) x[4 * j + i] = x[4 * j + i] * rstd * gg[i]; }
    float y[16];
    if (lpos >= 0) {
        const int axis = sub >> 2, posi = axis == 0 ? (lpos >> 6) : (lpos & 63), f0 = (sub & 1) * 16;
        const float sgn = (sub & 2) ? 1.0f : -1.0f;
        const f32x4* c4 = (const f32x4*)(rope + posi * 32 + f0); const f32x4* s4 = (const f32x4*)(rope + 2048 + posi * 32 + f0);
#pragma unroll
        for (int j = 0; j < 4; ++j) { const f32x4 cs = c4[j], sn = s4[j];
#pragma unroll
            for (int i = 0; i < 4; ++i) { const float other = DPPX(x[4 * j + i], 0x4E);
                y[4 * j + i] = x[4 * j + i] * cs[i] + sgn * other * sn[i]; } }
    } else {
#pragma unroll
        for (int i = 0; i < 16; ++i) y[i] = x[i];
    }
    f32x4 o0 = {y[0], y[1], y[2], y[3]}, o1 = {y[4], y[5], y[6], y[7]}, o2 = {y[8], y[9], y[10], y[11]}, o3 = {y[12], y[13], y[14], y[15]};
    *(u32x4*)p = pack8(o0, o1); *(u32x4*)(p + 8) = pack8(o2, o3);
}
__device__ __forceinline__ void qk_pass(const Args& a, int l, int gw, int NGW, int lane) {
    bf16_t* Q = (bf16_t*)(a.ws + WS_Q); bf16_t* KB = (bf16_t*)(a.ws + WS_KB); const float* rope = (const float*)(a.ws + WS_ROPE);
    const float* qg = a.in[I_QNG] + (size_t)l * HD; const float* kg = a.in[I_KNG] + (size_t)l * HD;
    (void)Q; (void)qg;
    for (int it = gw; it < NTOK / 4; it += NGW) { const int r = it * 4 + (lane >> 4);
        qk_head_rows(KB + (size_t)kvrow_of(r) * KVW + (lane & 15) * 16, kg, rope, r < NLAT ? (r & 4095) : -1, lane, 1.0f); }
}

__host__ __device__ constexpr int cand_off(int i) { int o = 0; for (int k = 0; k < i; ++k) o += 16 / (k + 1); return o; }
__device__ __forceinline__ void gather_token(const Args& a, int l, int tok, const LAS unsigned* sid, const LAS float* sw, int lane, const bool dry);
__device__ __forceinline__ void peer_topk(const Args& a, int l, LAS unsigned char* lds, int gw, int NGW, int tid, int nrows, const bool dry) {
    const int wave = tid >> 6;
    const bf16_t* keys = (const bf16_t*)(a.ws + WS_KEYS) + (size_t)l * 2 * PKEYS * 128;
    const bf16_t* PQ = (const bf16_t*)(a.ws + WS_GA);
    __syncthreads();
    for (int c = tid; c < 4096; c += 512) { const int p = c >> 11, key = (c >> 4) & 127, cc = c & 15;
        *(LAS u32x4*)(lds + p * 32768 + KSWZ(key, cc * 16)) = *(const u32x4*)(keys + ((size_t)p * PKEYS + key) * 128 + cc * 8); }
    __syncthreads();
    LAS unsigned* xs = (LAS unsigned*)(lds + 65536 + wave * 2048);
    LAS unsigned* sid = (LAS unsigned*)(lds + 81920 + wave * 4096);
    LAS float* sw = (LAS float*)(lds + 81920 + wave * 4096 + 2048);
    const int T = (nrows + NGW - 1) / NGW, tbeg = gw * T, tend = (tbeg + T < nrows) ? tbeg + T : nrows;
#pragma unroll 1
    for (int t0 = tbeg; t0 < tend; t0 += 4) {
        const int ntb = (tend - t0 < 4) ? tend - t0 : 4;
        int lane_ = tid & 63; asm volatile("" : "+v"(lane_));
        const int lane = lane_, r32 = lane & 31, hi = lane >> 5;
        const int rv = (r32 >> 3) < ntb ? r32 : (ntb * 8 - 1);
        const size_t R = (size_t)t0 * 8 + rv;
        float a12[2][16];
#pragma unroll
        for (int p = 0; p < 2; ++p) {
            bf16x8 qv[8];
#pragma unroll
            for (int ds = 0; ds < 8; ++ds) qv[ds] = *(const bf16x8*)(PQ + R * 256 + p * 128 + ds * 16 + hi * 8);
            f32x16 acc[4];
#pragma unroll
            for (int kb = 0; kb < 4; ++kb) acc[kb] = f32x16{};
#pragma unroll
            for (int ds = 0; ds < 8; ++ds)
#pragma unroll
                for (int kb = 0; kb < 4; ++kb) { const bf16x8 ka = *(const LAS bf16x8*)(lds + p * 32768 + KSWZ(kb * 32 + r32, ds * 32 + hi * 16));
                    acc[kb] = __builtin_amdgcn_mfma_f32_32x32x16_bf16(ka, qv[ds], acc[kb], 0, 0, 0); }
            __builtin_amdgcn_sched_barrier(0);
            float top[16]; peer::top16_of_acc(acc, hi, top);
            __builtin_amdgcn_sched_barrier(0);
#pragma unroll
            for (int j = 0; j < 16; ++j) a12[p][j] = peer::vmax(top[j], shflx(top[15 - j], 32, lane));
            peer::bmerge16(a12[p]);
            __builtin_amdgcn_sched_barrier(0);
        }
        float cd[64];
#pragma unroll
        for (int i = 0; i < 16; ++i)
#pragma unroll
            for (int j = 0; j < 16; ++j) if ((i + 1) * (j + 1) <= 16) cd[cand_off(i) + j] = peer::setlow(a12[0][i] + a12[1][j], 0xFFu, (unsigned)(i * 16 + j));
#pragma unroll
        for (int n = 50; n < 64; ++n) cd[n] = -3.0e38f;
        __builtin_amdgcn_sched_barrier(0);
        float best[16], t[16];
#pragma unroll
        for (int blk = 0; blk < 4; ++blk) {
#pragma unroll
            for (int r = 0; r < 16; ++r) { if (blk == 0) best[r] = cd[r]; else t[r] = cd[blk * 16 + r]; }
            if (blk == 0) {   }
            else if (blk < 3) { peer::sort16(t); peer::merge_top16(best, t); }
            else { peer::sort16(t);
#pragma unroll
                for (int i = 0; i < 16; ++i) best[i] = peer::vmax(best[i], t[15 - i]); }
            __builtin_amdgcn_sched_barrier(0);
        }
#pragma unroll
        for (int p = 0; p < 2; ++p)
#pragma unroll
            for (int q = 0; q < 4; ++q) { unsigned w = 0;
#pragma unroll
                for (int e = 0; e < 4; ++e) w |= (__float_as_uint(a12[p][4 * q + e]) & 0x7Fu) << (8 * e);
                xs[(p * 4 + q) * 64 + lane] = w; }
        const float mx = cd[0]; float ex[16], sum = 0.f;
#pragma unroll
        for (int k = 0; k < 16; ++k) { ex[k] = __expf(best[k] - mx); sum += ex[k]; }
        const float inv = __builtin_amdgcn_rcpf(sum);
        unsigned ids[8]; float wts[8]; const unsigned him = 0u - (unsigned)hi;
#pragma unroll
        for (int k = 0; k < 8; ++k) { const float bsel = __uint_as_float((__float_as_uint(best[8 + k]) & him) | (__float_as_uint(best[k]) & ~him)); const float esel = __uint_as_float((__float_as_uint(ex[8 + k]) & him) | (__float_as_uint(ex[k]) & ~him));
            const unsigned code = __float_as_uint(bsel) & 0xFFu, ii = code >> 4, jj = code & 15u;
            const unsigned w1 = xs[(ii >> 2) * 64 + lane], w2 = xs[(4 + (jj >> 2)) * 64 + lane];
            const unsigned i1 = (w1 >> (8 * (ii & 3))) & 0x7Fu, i2 = (w2 >> (8 * (jj & 3))) & 0x7Fu;
            ids[k] = i1 * PKEYS + i2; wts[k] = esel * inv; }
        LAS unsigned* di = sid + r32 * 16 + hi * 8; LAS float* dw = sw + r32 * 16 + hi * 8;
        *(LAS u32x4*)di = (u32x4){ids[0], ids[1], ids[2], ids[3]}; *(LAS u32x4*)(di + 4) = (u32x4){ids[4], ids[5], ids[6], ids[7]};
        *(LAS f32x4*)dw = (f32x4){wts[0], wts[1], wts[2], wts[3]}; *(LAS f32x4*)(dw + 4) = (f32x4){wts[4], wts[5], wts[6], wts[7]};
        asm volatile("s_waitcnt lgkmcnt(0)" ::: "memory");
#pragma unroll 1
        for (int t4 = 0; t4 < ntb; ++t4) gather_token(a, l, t0 + t4, sid + t4 * 128, sw + t4 * 128, lane, dry);
    }
    __syncthreads();
}

typedef float f32x2v __attribute__((ext_vector_type(2)));
typedef float v32f __attribute__((ext_vector_type(32)));
typedef int v6i __attribute__((ext_vector_type(6)));
typedef unsigned u32x3 __attribute__((ext_vector_type(3)));
__device__ __forceinline__ float dpp_sum63(float v) {
#define DPP_ADD(ctrl, rmask) v += __builtin_bit_cast(float, __builtin_amdgcn_update_dpp(0, __builtin_bit_cast(int, v), ctrl, rmask, 0xf, false))
    DPP_ADD(0x111, 0xf); DPP_ADD(0x112, 0xf); DPP_ADD(0x114, 0xf); DPP_ADD(0x118, 0xf);
    DPP_ADD(0x142, 0xa); DPP_ADD(0x143, 0xc);
#undef DPP_ADD
    return v;
}
__device__ __forceinline__ void fp8x16(const u32x4 w, float (&f)[16]) {
#pragma unroll
    for (int j = 0; j < 4; ++j) { const f32x2v lo = __builtin_amdgcn_cvt_pk_f32_fp8((int)w[j], false), hi = __builtin_amdgcn_cvt_pk_f32_fp8((int)w[j], true);
        f[4 * j] = lo[0]; f[4 * j + 1] = lo[1]; f[4 * j + 2] = hi[0]; f[4 * j + 3] = hi[1]; }
}
__device__ __forceinline__ float reduce8(const float (&d)[8], int lane) {
    const bool b0 = lane & 1, b1 = lane & 2, b2 = lane & 4;
    float r1[4], r2[2];
#pragma unroll
    for (int p = 0; p < 4; ++p) { const float t = b0 ? d[2 * p + 1] : d[2 * p], u = b0 ? d[2 * p] : d[2 * p + 1]; r1[p] = t + DPPX(u, 0xB1); }
#pragma unroll
    for (int p = 0; p < 2; ++p) { const float t = b1 ? r1[2 * p + 1] : r1[2 * p], u = b1 ? r1[2 * p] : r1[2 * p + 1]; r2[p] = t + DPPX(u, 0x4E); }
    float r;
    { const float t = b2 ? r2[1] : r2[0], u = b2 ? r2[0] : r2[1];
      int x = __builtin_amdgcn_update_dpp(0, __builtin_bit_cast(int, u), 0x104, 0xf, 0x5, false);
      x = __builtin_amdgcn_update_dpp(x, __builtin_bit_cast(int, u), 0x114, 0xf, 0xa, false);
      r = t + __builtin_bit_cast(float, x); }
    r += DPPX(r, 0x128);
    r += __builtin_bit_cast(float, __builtin_amdgcn_ds_swizzle(__builtin_bit_cast(int, r), 0x401F));
    { auto rr = __builtin_amdgcn_permlane32_swap(__float_as_uint(r), __float_as_uint(r), false, false); r = __uint_as_float(rr[0]) + __uint_as_float(rr[1]); }
    return r;
}
__device__ __forceinline__ void gather_token(const Args& a, int l, int tok, const LAS unsigned* sid, const LAS float* sw, int lane, const bool dry) {
    const bf16_t* XN2 = (const bf16_t*)(a.ws + WS_XN2);
    const unsigned char* PU = a.ws + WS_PU + (size_t)l * PEXP * PROW; const unsigned char* PV = a.ws + WS_PV + (size_t)l * PEXP * PROW;
    const float* SU = (const float*)(a.ws + WS_PSU) + (size_t)l * PEXP; const float* SV = (const float*)(a.ws + WS_PSV) + (size_t)l * PEXP;
    const float* mod = (const float*)(a.ws + WS_MOD) + (size_t)l * 9 * MODW;
    float* hctx = (float*)(a.ws + WS_HCTX);
    {
        float x[16];
        { const u32x4 x0 = *(const u32x4*)(XN2 + (size_t)tok * DM + lane * 16), x1 = *(const u32x4*)(XN2 + (size_t)tok * DM + lane * 16 + 8);
#pragma unroll
          for (int i = 0; i < 4; ++i) { x[2 * i] = bflo(x0[i]); x[2 * i + 1] = bfhi(x0[i]); x[8 + 2 * i] = bflo(x1[i]); x[8 + 2 * i + 1] = bfhi(x1[i]); } }
        float out[16];
#pragma unroll
        for (int i = 0; i < 16; ++i) out[i] = 0.f;
#pragma unroll 1
        for (int half = 0; half < 2; ++half) {
            const unsigned id = sid[half * 64 + lane]; const float w = sw[half * 64 + lane];
            const float su = SU[id], sv = SV[id];
            float dotv = 0.f;
#if PEER_FP4
            typedef unsigned u32x2 __attribute__((ext_vector_type(2)));
            u32x2 b0[8], b1[8];
            const unsigned lo8 = (unsigned)lane * 8u;
#define PG_LOAD(dst, TAB, e0) _Pragma("unroll") for (int q = 0; q < 8; ++q) { const unsigned idq = (unsigned)__builtin_amdgcn_readlane((int)id, (e0) + q); dst[q] = *(const u32x2*)(TAB + (idq * 512u + lo8)); }
#define PG_CVT(src, q) const f32x2 f[8] = {__builtin_amdgcn_cvt_scalef32_pk_f32_fp4(src[q][0], 1.0f, 0), __builtin_amdgcn_cvt_scalef32_pk_f32_fp4(src[q][0], 1.0f, 1), __builtin_amdgcn_cvt_scalef32_pk_f32_fp4(src[q][0], 1.0f, 2), __builtin_amdgcn_cvt_scalef32_pk_f32_fp4(src[q][0], 1.0f, 3), \
                __builtin_amdgcn_cvt_scalef32_pk_f32_fp4(src[q][1], 1.0f, 0), __builtin_amdgcn_cvt_scalef32_pk_f32_fp4(src[q][1], 1.0f, 1), __builtin_amdgcn_cvt_scalef32_pk_f32_fp4(src[q][1], 1.0f, 2), __builtin_amdgcn_cvt_scalef32_pk_f32_fp4(src[q][1], 1.0f, 3)};
#define PG_DOT(src, e0) { float d8[8]; _Pragma("unroll") for (int q = 0; q < 8; ++q) { PG_CVT(src, q) f32x2 a0 = {0.f, 0.f}; \
                _Pragma("unroll") for (int i = 0; i < 8; ++i) { const f32x2 xx = {x[2 * i], x[2 * i + 1]}; a0 += f[i] * xx; } d8[q] = a0[0] + a0[1]; } \
                const float tot = reduce8(d8, lane); dotv = ((lane >> 3) == ((e0) >> 3)) ? tot : dotv; }
#define PG_ACC(src, e0) _Pragma("unroll") for (int q = 0; q < 8; ++q) { PG_CVT(src, q) \
                const float c0 = __builtin_bit_cast(float, __builtin_amdgcn_readlane(__builtin_bit_cast(int, coef), (e0) + q)); const f32x2 cc0 = {c0, c0}; \
                _Pragma("unroll") for (int i = 0; i < 8; ++i) { f32x2 o2 = {out[2 * i], out[2 * i + 1]}; o2 += cc0 * f[i]; out[2 * i] = o2[0]; out[2 * i + 1] = o2[1]; } }
#else
            u32x3 b0[8], b1[8];
            const unsigned lo12 = (unsigned)lane * 12u;
#define PG_LOAD(dst, TAB, e0) _Pragma("unroll") for (int q = 0; q < 8; ++q) { const unsigned idq = (unsigned)__builtin_amdgcn_readlane((int)id, (e0) + q); dst[q] = *(const u32x3*)(TAB + (idq * 768u + lo12)); }
#define PG_CVT(src, q) const v6i pk_ = {(int)src[q][0], (int)src[q][1], (int)src[q][2], (int)src[(q) + 1][0], (int)src[(q) + 1][1], (int)src[(q) + 1][2]}; const v32f f = __builtin_amdgcn_cvt_scalef32_pk32_f32_fp6(pk_, 1.0f);
#define F2(i) ((f32x2){f[2 * (i)], f[2 * (i) + 1]})
#define PG_DOT(src, e0) { float d8[8]; _Pragma("unroll") for (int q = 0; q < 8; q += 2) { PG_CVT(src, q) f32x2 a0 = {0.f, 0.f}, a1 = {0.f, 0.f}; \
                _Pragma("unroll") for (int i = 0; i < 8; ++i) { const f32x2 xx = {x[2 * i], x[2 * i + 1]}; a0 += F2(i) * xx; a1 += F2(8 + i) * xx; } d8[q] = a0[0] + a0[1]; d8[q + 1] = a1[0] + a1[1]; } \
                const float tot = reduce8(d8, lane); dotv = ((lane >> 3) == ((e0) >> 3)) ? tot : dotv; }
#define PG_ACC(src, e0) _Pragma("unroll") for (int q = 0; q < 8; q += 2) { PG_CVT(src, q) \
                const float c0 = __builtin_bit_cast(float, __builtin_amdgcn_readlane(__builtin_bit_cast(int, coef), (e0) + q)), c1 = __builtin_bit_cast(float, __builtin_amdgcn_readlane(__builtin_bit_cast(int, coef), (e0) + q + 1)); \
                const f32x2 cc0 = {c0, c0}, cc1 = {c1, c1}; \
                _Pragma("unroll") for (int i = 0; i < 8; ++i) { f32x2 o2 = {out[2 * i], out[2 * i + 1]}; o2 += cc0 * F2(i); o2 += cc1 * F2(8 + i); out[2 * i] = o2[0]; out[2 * i + 1] = o2[1]; } }
#endif
#if PEER_FP4
            u32x2 b2[8];
#else
            u32x3 b2[8];
#endif
#define PG_STEPA(cur, nxt, kb) { const int kl_ = (kb) + 2; if (kl_ < 8) { PG_LOAD(nxt, PU, kl_ * 8) } else { PG_LOAD(nxt, PV, (kl_ - 8) * 8) } PG_DOT(cur, (kb) * 8) }
#define PG_STEPB(cur, nxt, kb) { const int kl_ = (kb) + 2; if (kl_ < 8) { PG_LOAD(nxt, PV, kl_ * 8) } PG_ACC(cur, (kb) * 8) }
            PG_LOAD(b0, PU, 0) PG_LOAD(b1, PU, 8)
#pragma unroll 1
            for (int kb = 0; kb < 6; kb += 3) { PG_STEPA(b0, b2, kb) PG_STEPA(b1, b0, kb + 1) PG_STEPA(b2, b1, kb + 2) }
            PG_STEPA(b0, b2, 6) PG_STEPA(b1, b0, 7)
            const float coef = w * gelu_tanh(dotv * su) * sv;
#pragma unroll 1
            for (int kb = 0; kb < 6; kb += 3) { PG_STEPB(b2, b1, kb) PG_STEPB(b0, b2, kb + 1) PG_STEPB(b1, b0, kb + 2) }
            PG_STEPB(b2, b1, 6) PG_STEPB(b0, b2, 7)
#undef PG_STEPA
#undef PG_STEPB
#undef PG_LOAD
#undef PG_CVT
#undef PG_DOT
#undef PG_ACC
        }
        if (dry) { float sink = 0.f;
#pragma unroll
            for (int i = 0; i < 16; ++i) sink += out[i];
            asm volatile("" :: "v"(sink)); return; }
        float* hr = hrow_m(a.out, hctx, tok) + lane * 16;
        const float* gt = mod + (size_t)modrow_of(tok) * MODW + 5 * DM + lane * 16;
        f32x4 hv[4]; float ss = 0.f;
#pragma unroll
        for (int j = 0; j < 4; ++j) { hv[j] = *(const f32x4*)(hr + 4 * j); const f32x4 g4 = *(const f32x4*)(gt + 4 * j);
#pragma unroll
            for (int i = 0; i < 4; ++i) hv[j][i] += g4[i] * out[4 * j + i];
            *(f32x4*)(hr + 4 * j) = hv[j];
            ss += (hv[j][0] * hv[j][0] + hv[j][1] * hv[j][1]) + (hv[j][2] * hv[j][2] + hv[j][3] * hv[j][3]); }
        if (l + 1 < DEPTH) {
            ss = wave_sum(ss, lane);
            const float rstd = __builtin_amdgcn_rsqf(ss * (1.0f / DM) + EPS);
            const float* g = a.in[I_NMG] + (size_t)(l + 1) * DM + lane * 16; const float* mr = mod + 9 * MODW + (size_t)modrow_of(tok) * MODW + lane * 16;
            bf16_t* orow = (bf16_t*)(a.ws + WS_XN) + (size_t)tok * DM + lane * 16;
            f32x4 o[4];
#pragma unroll
            for (int j = 0; j < 4; ++j) { const f32x4 gg = *(const f32x4*)(g + 4 * j), s1 = *(const f32x4*)(mr + DM + 4 * j), s0 = *(const f32x4*)(mr + 4 * j);
                o[j] = hv[j] * rstd * gg * (1.0f + s1) + s0; }
            *(u32x4*)orow = pack8(o[0], o[1]); *(u32x4*)(orow + 8) = pack8(o[2], o[3]);
        }
    }
}

constexpr int NPH_LAYER = 10, NPHASE = 2 + NPH_LAYER * DEPTH;
__global__ void __launch_bounds__(512, 2) mega_fwd(Args a_in) {
    extern __shared__ __attribute__((aligned(16))) unsigned char lds_[];
    LAS unsigned char* lds = (LAS unsigned char*)lds_;
    const int bx = blockIdx.x, G = gridDim.x, NGW = G * 8;
#define PHASE_IDS const int lane = lane_id_now(), wave = wave_s, tid = wave_s * 64 + lane, gw = bx * 8 + wave; (void)lane; (void)gw; (void)tid; \
    const __attribute__((address_space(4))) Args* ap_ = (const __attribute__((address_space(4))) Args*)__builtin_amdgcn_kernarg_segment_ptr(); asm volatile("" : "+s"(ap_)); const Args& a = *(const Args*)ap_; \
    unsigned char* ws = a.ws; (void)ws;
    const int wave_s = __builtin_amdgcn_readfirstlane(threadIdx.x >> 6);
    volatile LAS unsigned* MISC = (volatile LAS unsigned*)(lds + MISC_OFF);
    if (threadIdx.x < 32) MISC[threadIdx.x] = 0u;
    __syncthreads();
    unsigned* ctl = (unsigned*)(a_in.ws + WS_CTL);
    XcdBarrier bar; bar.bar = ctl + CW_BAR; bar.x = 0; bar.st = MISC + 8;
    if (!MK_MULTI) bar = xcd_barrier_post(ctl + CW_BAR, MISC + 8);
    int lo = a_in.ph_lo, hi = a_in.ph_hi;
#define IN(k) (lo <= (k) && (k) < hi)
#define SEAM(k) do { if (!MK_MULTI && IN(k) && IN((k) + 1)) xcd_barrier(bar, wave_s == 0 && lane_id_now() == 0); } while (0)
#define XN ((bf16_t*)(ws + WS_XN))
#define XN2 ((bf16_t*)(ws + WS_XN2))
#define Qb ((bf16_t*)(ws + WS_Q))
#define KB ((bf16_t*)(ws + WS_KB))
#define VB ((bf16_t*)(ws + WS_VB))
#define UCAT ((bf16_t*)(ws + WS_UCAT))
#define GA ((bf16_t*)(ws + WS_GA))
#define GBb ((bf16_t*)(ws + WS_GB))
#define YG ((bf16_t*)(ws + WS_YG))
#define SSMO ((bf16_t*)(ws + WS_SSMO))
#define Y XN
#define PQ GA
#define hctx ((float*)(ws + WS_HCTX))
#define wl (ws + WS_WT + (size_t)l * WT_LAYER)
#define mod ((const float*)(ws + WS_MOD) + (size_t)l * 9 * MODW)

    if (DG(0) && IN(0)) REPS(0) { PHASE_IDS p0a(a, lds, bx, G, tid); }
    SEAM(0);
    if (DG(1) && IN(1)) { PHASE_IDS norm_pass(a, 0, 0, XN, gw, NGW, lane, NTOK, a.in[I_X]); }
    SEAM(1);

    for (int l = 0; l < DEPTH; ++l) {
        const int pb = 2 + NPH_LAYER * l;
        asm volatile("" : "+s"(lo), "+s"(hi));
        const int MR = (l + 1 < DEPTH) ? NTOK : NLAT;
        if (DG(2) && IN(pb + 0)) REPS(2) { PHASE_IDS
            ssm_tables(a, l, lds, bx, G, tid);
            pg8::Gemm g{XN, (const bf16_t*)(wl + WT_IN)}; pg8::SplitOrder S; S.init(NTOK, INW, G, bx);
            pg8::EpiIn E{ws};
            pg8::gemm_phase<DM, DM, DM, 0, 0>(lds, g, S, E, tid);
        }
        SEAM(pb + 0);
        if (DG(3) && IN(pb + 1)) REPS(3) { PHASE_IDS
            qk_pass(a, l, gw, NGW, lane);
            __syncthreads();
            pg8::Gemm g{UCAT, (const bf16_t*)(ws + WS_WSTATE)}; pg8::BatchOrder S; S.init(NCOLP / 256, 1, SG, G, (G % 8 == 0) ? (bx % 8) * (G / 8) + bx / 8 : bx);
            pg8::EpiSX E{(float*)(ws + WS_SX)};
            pg8::gemm_phase<512, KCAT, 512, (size_t)NCOLP * KCAT * 2, (size_t)256 * 512 * 2>(lds, g, S, E, tid);
        }
        SEAM(pb + 1);
        if (DG(4) && IN(pb + 2)) REPS(4) { PHASE_IDS
            float nm0;
            { float gq = fmaxf(fabsf(a.in[I_QNG][(size_t)l * HD + lane]), fabsf(a.in[I_QNG][(size_t)l * HD + 64 + lane])), gk = fmaxf(fabsf(a.in[I_KNG][(size_t)l * HD + lane]), fabsf(a.in[I_KNG][(size_t)l * HD + 64 + lane]));
#pragma unroll
              for (int o = 1; o < 64; o <<= 1) { gq = fmaxf(gq, shflx(gq, o, lane)); gk = fmaxf(gk, shflx(gk, o, lane)); }
              nm0 = -(float)HD * gq * gk * att::SCALE * 1.4426950408889634f * 1.01f; }
            for (int vb = G - 1 - bx; vb < 64; vb += G) ssm_carry(a, l, vb, tid);
            __syncthreads();
            const int x8 = bx & 7, j32 = bx >> 3;
            const int nlat = (G == 256) ? 4 : (bx < NB * NQH * 16 ? (NB * NQH * 16 - 1 - bx) / G + 1 : 0);
            const int nctx = (l + 1 < DEPTH && bx < NB * NQH) ? (NB * NQH - 1 - bx) / G + 1 : 0;
#pragma unroll 1
            for (int i = 0; i < nlat + nctx; ++i) {
                size_t qoff, koff; int seq, lpos0;
                if (i < nlat) {
                    int b, h, qb;
                    if (G == 256) { const int combo = x8 + 8 * (i >> 1), un = (i & 1) * 32 + j32; b = combo >> 1; h = (combo & 1) * 4 + (un >> 4); qb = un & 15; }
                    else { const int u = bx + i * G; b = u >> 7; h = (u >> 4) & 7; qb = u & 15; }
                    qoff = ((size_t)b * SEQ + qb * 256) * DM + h * HD; koff = (size_t)b * KVLEN * KVW + (h >> 2) * HD; seq = KVLEN; lpos0 = qb * 256;
                } else {
                    const int u = bx + (i - nlat) * G, b = u >> 3, h = u & 7;
                    qoff = ((size_t)NLAT + b * CTXL) * DM + h * HD; koff = ((size_t)b * KVLEN + SEQ) * KVW + (h >> 2) * HD; seq = CTXL; lpos0 = -1;
                }
                att::attn_dense_body_dma(Qb + qoff, KB + koff, seq, (char*)lds_, lds, wave_s * 64 + lane_id_now(), (PROBE_PHASE == 4 && rep_ + 1 < PROBE_REPS) ? (long)WS_YG - (long)WS_Q : 0L, nm0,
                                         a.in[I_QNG] + (size_t)l * HD, (const float*)(ws + WS_ROPE), lpos0);
            }
        }
        SEAM(pb + 2);
        if (DG(5) && IN(pb + 3)) REPS(5) { PHASE_IDS
            pg8::Gemm g{UCAT, (const bf16_t*)(ws + WS_WCAT)}; pg8::BatchOrder S; S.init(l + 1 < DEPTH ? NCOLP / 256 : NCOLP / 256 - 1, 2, SG, G, (G % 8 == 0) ? (bx % 8) * (G / 8) + bx / 8 : bx, l + 1 < DEPTH ? NCOLP / 256 - 1 : -1);
            pg8::EpiS3 E{UCAT, a.in[I_SD] + (size_t)l * SSMW, YG};
            pg8::gemm_phase<KCAT, KCAT, KCAT, (size_t)NCOLP * KCAT * 2, (size_t)512 * KCAT * 2>(lds, g, S, E, tid);
        }
        SEAM(pb + 3);
        if (DG(6) && IN(pb + 4)) REPS(6) { PHASE_IDS
            pg8::Gemm g{YG, (const bf16_t*)(wl + WT_GLU)}; pg8::SplitOrder S; S.init(MR, SSMW, G, bx);
            pg8::EpiGlu E{YG, a.in[I_BGLU] + (size_t)l * SSMW, SSMO};
            pg8::gemm_phase<SSMW, SSMW, SSMW, 0, 0>(lds, g, S, E, tid);
        }
        SEAM(pb + 4);
        if (DG(7) && IN(pb + 5)) REPS(7) { PHASE_IDS
            pg8::SplitOrder S; S.init(MR, DM, G, bx);
            { pg8::Gemm g{Qb, (const bf16_t*)(wl + WT_BA)}; pg8::EpiMerge<false> E{GA, Y}; pg8::gemm_phase<DM, DM, DM, 0, 0>(lds, g, S, E, tid); }
            { pg8::Gemm g{SSMO, (const bf16_t*)(wl + WT_BS)}; pg8::EpiMerge<true> E{GBb, Y}; pg8::gemm_phase<SSMW, SSMW, SSMW, 0, 0>(lds, g, S, E, tid); }
        }
        SEAM(pb + 5);
        if (DG(8) && IN(pb + 6)) REPS(8) { PHASE_IDS
            pg8::Gemm g{Y, (const bf16_t*)(wl + WT_O)}; pg8::SplitOrder S; S.init(MR, DM, G, bx);
            pg8::EpiWo E{l == 0 ? a.in[I_X] : (const float*)a.out, a.out, hctx, mod + 2 * DM};
            pg8::gemm_phase<DM, DM, DM, 0, 0>(lds, g, S, E, tid);
        }
        SEAM(pb + 6);
        if (DG(9) && IN(pb + 7)) REPS(9) { PHASE_IDS norm_pass(a, l, 1, XN2, gw, NGW, lane, MR, a.out); }
        SEAM(pb + 7);
        if (DG(10) && IN(pb + 8)) REPS(10) { PHASE_IDS
            pg8::Gemm g{XN2, (const bf16_t*)(wl + WT_Q)}; pg8::SplitOrder S; S.init(MR, PQW, G, bx);
            pg8::EpiBf16 E{PQ, PQW};
            pg8::gemm_phase<DM, DM, DM, 0, 0>(lds, g, S, E, tid);
        }
        SEAM(pb + 8);
        if (DG(11) && IN(pb + 9)) REPS(11) { PHASE_IDS peer_topk(a, l, lds, gw, NGW, tid, MR, PROBE_PHASE == 11 && rep_ + 1 < PROBE_REPS); }
        SEAM(pb + 9);
    }
#undef IN
#undef SEAM
}

extern "C" void kernel_launch(void* const* d_in, const int* in_sizes, int n_in, void* d_out, int out_size, void* d_ws, size_t ws_size, hipStream_t stream) {
    static int grid = 0;
    if (grid == 0) {
        if (n_in != 28 || out_size != NLAT * DM || ws_size < WS_END) { fprintf(stderr, "kernel_launch: unexpected shapes (n_in %d out %d ws %zu, need ws >= %zu)\n", n_in, out_size, ws_size, (size_t)WS_END); grid = -1; return; }
        int dev = 0, cus = 0;
        if (hipGetDevice(&dev) != hipSuccess || hipDeviceGetAttribute(&cus, hipDeviceAttributeMultiprocessorCount, dev) != hipSuccess) { grid = -1; return; }
        if (hipFuncSetAttribute((const void*)mega_fwd, hipFuncAttributeMaxDynamicSharedMemorySize, LDS_BYTES) != hipSuccess) { fprintf(stderr, "kernel_launch: hipFuncSetAttribute failed\n"); grid = -1; return; }
        int per_cu = 0;
        if (hipOccupancyMaxActiveBlocksPerMultiprocessor(&per_cu, (const void*)mega_fwd, 512, LDS_BYTES) != hipSuccess || per_cu < 1) fprintf(stderr, "kernel_launch: occupancy query reports %d\n", per_cu);
        (void)hipGetLastError();
        grid = cus;
    }
    if (grid < 0) return;
    (void)hipMemsetAsync((char*)d_ws + WS_CTL, 0, CTL_ZERO_BYTES, stream);
    Args a{};
    for (int i = 0; i < 28; ++i) a.in[i] = (const float*)d_in[i];
    a.out = (float*)d_out; a.ws = (unsigned char*)d_ws;
#if MK_MULTI
    for (int p = 0; p < NPHASE; ++p) { a.ph_lo = p; a.ph_hi = p + 1; hipLaunchKernelGGL(mega_fwd, dim3(grid), dim3(512), LDS_BYTES, stream, a); }
#else
    a.ph_lo = 0; a.ph_hi = NPHASE;
    hipLaunchKernelGGL(mega_fwd, dim3(grid), dim3(512), LDS_BYTES, stream, a);
#endif
    const hipError_t le = hipPeekAtLastError();
    if (le != hipSuccess) fprintf(stderr, "kernel_launch: launch failed: %s\n", hipGetErrorName(le));
}
```

```cpp
#include <hip/hip_runtime.h>
#include <cstdio>
#include <cstdint>

#define GAS __attribute__((address_space(1)))
#define LAS __attribute__((address_space(3)))
typedef unsigned short bf16_t;
typedef short bf16x8 __attribute__((ext_vector_type(8)));
typedef short s16x4 __attribute__((ext_vector_type(4)));
typedef float f32x2 __attribute__((ext_vector_type(2)));
typedef float f32x4 __attribute__((ext_vector_type(4)));
typedef float f32x16 __attribute__((ext_vector_type(16)));
typedef unsigned u32x2 __attribute__((ext_vector_type(2)));
typedef unsigned u32x4 __attribute__((ext_vector_type(4)));

#ifndef MK_MULTI
#define MK_MULTI 0
#endif
#ifndef DIAG_MASK
#define DIAG_MASK 0xFFFF
#endif
#define DG(k) ((DIAG_MASK >> (k)) & 1)
#ifndef PEER_FP4
#define PEER_FP4 1
#endif
#ifndef PROBE_PHASE
#define PROBE_PHASE -1
#endif
#ifndef PROBE_REPS
#define PROBE_REPS 1
#endif
#define REPS(k) _Pragma("unroll 1") for (int rep_ = 0; rep_ < ((PROBE_PHASE == (k)) ? PROBE_REPS : 1); ++rep_)
#ifndef EN_ATTN
#define EN_ATTN 1
#endif
#ifndef EN_SSM
#define EN_SSM 1
#endif
#ifndef EN_PEER
#define EN_PEER 1
#endif

constexpr int DM = 1024, NB = 8, SEQ = 4096, DEPTH = 4, CTXL = 256;
constexpr int NLAT = NB * SEQ, NCTX = NB * CTXL, NTOK = NLAT + NCTX;
constexpr int HD = 128, NQH = 8, NKVH = 2, KVW = NKVH * HD, KVLEN = SEQ + CTXL;
constexpr int SSMW = 512, SG = 32, SP = 16, SN = 64, ST = 32;
constexpr int NCH = KVLEN / ST, NCHL = SEQ / ST, NCOL = NB * NCH, NCOLP = 1280, KCAT = 768;
constexpr int INW = 4096, NMOD = 6, MODW = NMOD * DM;
constexpr int PH = 8, PKEYS = 128, PEXP = PKEYS * PKEYS, PQW = 2048, PTOPK = 16;
constexpr float EPS = 1e-6f;

constexpr size_t MiB = 1u << 20;
constexpr size_t WS_CTL = 0, CTL_ZERO_BYTES = 64 * 1024;
constexpr size_t WS_MOD = 1 * MiB;
constexpr size_t WS_ROPE = 2 * MiB;
constexpr size_t WS_KEYS = 3 * MiB;
constexpr size_t WS_HCTX = 4 * MiB;
constexpr size_t WS_WT = 12 * MiB;
constexpr size_t WT_IN = 0, WT_BA = 8 * MiB, WT_BS = 10 * MiB, WT_O = 11 * MiB, WT_GLU = 13 * MiB, WT_Q = 13 * MiB + 512 * 1024, WT_LAYER = 17 * MiB + 512 * 1024;
constexpr size_t WS_WCAT = 82 * MiB;
constexpr size_t WS_WSTATE = 106 * MiB;
constexpr size_t WS_UCAT = 114 * MiB;
constexpr size_t WS_SX = 174 * MiB;
constexpr size_t WS_XN = 214 * MiB;
constexpr size_t WS_XN2 = 282 * MiB;
constexpr size_t WS_Q = 350 * MiB;
constexpr size_t WS_KB = 418 * MiB, WS_VB = 435 * MiB;
constexpr size_t WS_GA = 452 * MiB, WS_GB = 520 * MiB;
constexpr size_t WS_YG = 588 * MiB, WS_SSMO = 622 * MiB;
constexpr size_t WS_SSP = 656 * MiB;
constexpr size_t WS_PQB = 660 * MiB;
constexpr size_t WS_PU = 690 * MiB, WS_PV = 754 * MiB;
constexpr int PROW = PEER_FP4 ? 512 : 768;
constexpr float QMAX = PEER_FP4 ? 6.0f : 7.5f;
constexpr size_t WS_PSU = 818 * MiB, WS_PSV = 819 * MiB;
constexpr size_t WS_END = 820 * MiB;
constexpr int CW_BAR = 1024;

constexpr int RING_BYTES = 131072;
constexpr int MISC_OFF = RING_BYTES;
constexpr int LDS_BYTES = 147456;

__device__ __forceinline__ unsigned f2bf(float f) { unsigned u = __builtin_bit_cast(unsigned, f); return (u + 0x7fffu + ((u >> 16) & 1u)) >> 16; }
__device__ __forceinline__ unsigned pk2(float lo, float hi) { return f2bf(lo) | (f2bf(hi) << 16); }
__device__ __forceinline__ unsigned cvt_pk_bf16(float lo, float hi) { unsigned r; asm volatile("v_cvt_pk_bf16_f32 %0, %1, %2" : "=v"(r) : "v"(lo), "v"(hi)); return r; }
__device__ __forceinline__ float bflo(unsigned w) { return __builtin_bit_cast(float, w << 16); }
__device__ __forceinline__ float bfhi(unsigned w) { return __builtin_bit_cast(float, w & 0xffff0000u); }
__device__ __forceinline__ int lane_id_now() { int l_; asm volatile("v_mbcnt_lo_u32_b32 %0, -1, 0\n\tv_mbcnt_hi_u32_b32 %0, -1, %0" : "=v"(l_)); return l_; }
__device__ __forceinline__ float shflx(float v, int o, int lane) { return __builtin_bit_cast(float, __builtin_amdgcn_ds_bpermute((lane ^ o) << 2, __builtin_bit_cast(int, v))); }
__device__ __forceinline__ float wave_sum(float v, int lane) {
#pragma unroll
    for (int o = 1; o < 64; o <<= 1) v += shflx(v, o, lane);
    return v;
}
__device__ __forceinline__ float sigmoidf_(float x) { return __builtin_amdgcn_rcpf(1.0f + __builtin_amdgcn_exp2f(-1.4426950408889634f * x)); }
__device__ __forceinline__ float gelu_tanh(float x) {
    const float z = 0.7978845608028654f * (x + 0.044715f * x * x * x);
    const float t = 1.0f - 2.0f * __builtin_amdgcn_rcpf(__builtin_amdgcn_exp2f(2.0f * 1.4426950408889634f * z) + 1.0f);
    return 0.5f * x * (1.0f + t);
}
__device__ __forceinline__ u32x4 pack8(const f32x4 a, const f32x4 b) {
    u32x4 w; w.x = cvt_pk_bf16(a[0], a[1]); w.y = cvt_pk_bf16(a[2], a[3]); w.z = cvt_pk_bf16(b[0], b[1]); w.w = cvt_pk_bf16(b[2], b[3]); return w;
}
__device__ __forceinline__ void unpack8(const u32x4 w, f32x4& a, f32x4& b) {
    a[0] = bflo(w.x); a[1] = bfhi(w.x); a[2] = bflo(w.y); a[3] = bfhi(w.y); b[0] = bflo(w.z); b[1] = bfhi(w.z); b[2] = bflo(w.w); b[3] = bfhi(w.w);
}
__device__ __forceinline__ int modrow_of(int r) { return r < NLAT ? (r >> 12) : NB; }
__device__ __forceinline__ int kvrow_of(int r) { if (r < NLAT) return (r >> 12) * KVLEN + (r & 4095); const int q = r - NLAT; return (q >> 8) * KVLEN + SEQ + (q & 255); }

#define XB_TMO      128
#define XB_XCNT(j)  (256  + 64 * (j))
#define XB_XSUB(j)  (1280 + 64 * (j))
#define XB_XGEN(j)  (2304 + 64 * (j))
#define XB_TOP      3328
#define XB_TOPGEN   3392
#define XCD_BAR_WORDS 3456
#define XB_SPIN_CAP (1u << 18)
__device__ __forceinline__ unsigned xb_ld(unsigned* p)              { return __hip_atomic_load(p, __ATOMIC_RELAXED, __HIP_MEMORY_SCOPE_AGENT); }
__device__ __forceinline__ unsigned xb_add(unsigned* p, unsigned v) { return __hip_atomic_fetch_add(p, v, __ATOMIC_RELAXED, __HIP_MEMORY_SCOPE_AGENT); }
__device__ __forceinline__ unsigned xb_xcc_id() { return (unsigned)__builtin_amdgcn_s_getreg((3 << 11) | 20) & 0xFu; }
#define XB_SPIN(cond, bar) do { unsigned _sp = 0; while (cond) { __builtin_amdgcn_s_sleep(1); \
    if ((++_sp & 255u) == 0u) { if (xb_ld(&(bar)[XB_TMO])) break; if (_sp > XB_SPIN_CAP) { atomicAdd(&(bar)[XB_TMO], 1u); break; } } } } while (0)
struct XcdBarrier { unsigned* bar; unsigned x; volatile LAS unsigned* st; };
__device__ __forceinline__ XcdBarrier xcd_barrier_post(unsigned* bar, volatile LAS unsigned* st) {
    XcdBarrier b; b.bar = bar; b.x = xb_xcc_id(); b.st = st;
    if (threadIdx.x == 0) (void)xb_add(&bar[XB_XCNT(b.x)], 1u);
    return b;
}
__device__ __forceinline__ void xcd_barrier_complete(unsigned* bar, unsigned x, unsigned& nloc, unsigned& nx) {
    const unsigned G = gridDim.x * gridDim.y * gridDim.z;
    unsigned sum, cnt, mine, sp = 0u;
    for (;;) {
        sum = 0u; cnt = 0u; mine = 0u;
#pragma unroll
        for (unsigned j = 0; j < 16; ++j) { const unsigned c = xb_ld(&bar[XB_XCNT(j)]); sum += c; cnt += (c > 0u) ? 1u : 0u; mine = (j == x) ? c : mine; }
        if (sum == G) break;
        __builtin_amdgcn_s_sleep(1);
        if ((++sp & 255u) == 0u) { if (xb_ld(&bar[XB_TMO])) break; if (sp > XB_SPIN_CAP) { atomicAdd(&bar[XB_TMO], 1u); break; } }
    }
    nloc = mine > 0u ? mine : 1u; nx = cnt > 0u ? cnt : 1u;
}
__device__ __forceinline__ void xcd_barrier(const XcdBarrier& b, const bool t0  ) {
    asm volatile("s_waitcnt vmcnt(0)" ::: "memory");
    __syncthreads();
    if (t0) {
        unsigned* bar = b.bar;
        __builtin_amdgcn_s_waitcnt(0);
        unsigned nloc = b.st[0], nx = b.st[1];
        if (nloc == 0u) { unsigned x_ = b.x; asm volatile("" : "+s"(x_));
            xcd_barrier_complete(bar, x_, nloc, nx); b.st[0] = nloc; b.st[1] = nx; }
        const unsigned old = xb_add(&bar[XB_XSUB(b.x)], 1u);
        const unsigned gen = old / nloc;
        if (old + 1u == (gen + 1u) * nloc) {
            __builtin_amdgcn_fence(__ATOMIC_RELEASE, "agent");
            asm volatile("s_waitcnt vmcnt(0)" ::: "memory");
            const unsigned og = xb_add(&bar[XB_TOP], 1u);
            const unsigned tg = og / nx;
            if (og + 1u == (tg + 1u) * nx) xb_add(&bar[XB_TOPGEN], 1u);
            else XB_SPIN(xb_ld(&bar[XB_TOPGEN]) == tg, bar);
            __builtin_amdgcn_fence(__ATOMIC_ACQUIRE, "agent");
            xb_add(&bar[XB_XGEN(b.x)], 1u);
            asm volatile("s_waitcnt vmcnt(0)" ::: "memory");
        } else {
            XB_SPIN(xb_ld(&bar[XB_XGEN(b.x)]) == gen, bar);
            __builtin_amdgcn_fence(__ATOMIC_ACQUIRE, "agent");
            asm volatile("s_waitcnt vmcnt(0)" ::: "memory");
        }
    }
    __syncthreads();
}

namespace pg8 {
constexpr int BM = 256, BK = 64, HALF = 128, HTB = HALF * BK * 2, STAGE_BYTES = 8 * HTB, NXCD = 8, WGM = 8;
__host__ __device__ __forceinline__ int lds_byte(int r, int c) { const int st = (r >> 4) * 2 + (c >> 5), rr = r & 15, cc = c & 31, ob = rr * 64 + cc * 2; return st * 1024 + (ob ^ (((ob >> 9) & 1) << 5)); }
__host__ __device__ __forceinline__ void stage_rc(int b, int& R, int& C) { const int st = b / 1024, sb = b % 1024, swz = sb ^ (((sb >> 9) & 1) << 5); R = (st >> 1) * 16 + swz / 64; C = (st & 1) * 32 + (swz % 64) / 2; }
__host__ __device__ __forceinline__ int perm32(int rho) { const int n = rho >> 4, i = rho & 15; return 8 * (i >> 2) + 4 * n + (i & 3); }

struct Unit { int pm, pn, pb, hm; };
struct Gemm { const bf16_t* A; const bf16_t* Bt; };

struct StaticOrder {
    int nM, nN, nwg, G, c;
    __device__ void init(int M, int N, int G_, int c_) { nM = M / BM; nN = N / BM; nwg = nM * nN; G = G_; c = c_; }
    __device__ void map(int wgid, int& pm, int& pn) const {
        { const int q = nwg / NXCD, r = nwg % NXCD, xcd = wgid % NXCD, off = wgid / NXCD; wgid = (xcd < r ? xcd * (q + 1) : r * (q + 1) + (xcd - r) * q) + off; }
        const int nig = WGM * nN, gid = wgid / nig, fm = gid * WGM, gsz = (nM - fm) < WGM ? (nM - fm) : WGM;
        pm = fm + ((wgid % nig) % gsz); pn = (wgid % nig) / gsz;
    }
    __device__ bool next(int i, Unit& u) const {
        const long L = (long)i * G + c; if (L >= nwg) return false;
        int pm, pn; map((int)L, pm, pn); u.pm = pm; u.pn = pn; u.pb = 0; u.hm = -1; return true;
    }
};
struct SplitOrder {
    StaticOrder lat; int nN, nLat, nH, G, c;
    __device__ void init(int M, int N, int G_, int c_) { lat.init(NLAT, N, G_, c_); nN = N / BM; nLat = lat.nwg; nH = M > NLAT ? ((M - NLAT) / HALF) * nN : 0; G = G_; c = c_; }
    __device__ bool next(int i, Unit& u) const {
        const long L = (long)i * G + c; if (L >= (long)nLat + nH) return false;
        const bool isl = L < nLat;
        int pmL, pnL; lat.map(isl ? (int)L : 0, pmL, pnL);
        const int h = isl ? 0 : (int)(L - nLat);
        const int per = 2 * nN, hu = (nH % NXCD == 0) ? (h % NXCD) * (nH / NXCD) + h / NXCD : h, t = hu / per, j = hu - t * per;
        u.pm = isl ? pmL : NLAT / BM + t; u.pn = isl ? pnL : (j >> 1); u.pb = 0; u.hm = isl ? -1 : (j & 1); return true;
    }
};
struct BatchOrder {
    int nM, nN, nb, G, c, tailM;
    __device__ void init(int nM_, int nN_, int nb_, int G_, int c_, int tailM_ = -1) { nM = nM_; nN = nN_; nb = nb_; G = G_; c = c_; tailM = tailM_; }
    __device__ bool next(int i, Unit& u) const {
        const long L = (long)i * G + c; if (L >= (long)nM * nN * nb) return false;
        const int nMf = tailM >= 0 ? nM - 1 : nM, per = nMf * nN, nfull = per * nb, l = (int)L; const bool full = l < nfull;
        const int lf = full ? l : 0, pbF = lf / per, rF = lf - pbF * per, pnF = rF / nMf, pmF = rF - pnF * nMf;
        const int rT = full ? 0 : l - nfull, pbT = rT / nN, pnT = rT - pbT * nN;
        u.pb = full ? pbF : pbT; u.pn = full ? pnF : pnT; u.pm = full ? pmF : tailM; u.hm = full ? -1 : 0; return true;
    }
};

template <int K, int LDA, int LDB, size_t SA, size_t SB, class Epi, class Sched>
__device__ __forceinline__ void gemm_phase(LAS unsigned char* lds, const Gemm g, const Sched& S, const Epi& E, const int tid) {
    static_assert(Epi::PERM, "all epilogues here use the permuted column map");
    const int wid = __builtin_amdgcn_readfirstlane(tid >> 6), lane = tid & 63, wr = wid >> 2, wc = wid & 3, fr = lane & 15, fq = lane >> 4;
    constexpr int nt = K / BK;
    unsigned voffA[2], voffB[2];
#pragma unroll
    for (int i = 0; i < 2; ++i) { int R, C; stage_rc(tid * 16 + i * 8192, R, C); const int Rb = (R & ~31) + perm32(R & 31);
        voffA[i] = (unsigned)(R * LDA + C) * 2u; voffB[i] = (unsigned)(Rb * LDB + C) * 2u; }
    constexpr size_t kstep = (size_t)(BK * 2);
    constexpr size_t hstepA = (size_t)HALF * LDA * 2, hstepB = (size_t)HALF * LDB * 2;
    constexpr size_t tstepA = 2 * hstepA, tstepB = 2 * hstepB;
    const unsigned ldsw = (unsigned)wid * 1024u;
    const int aoff = lds_byte(wr * 64 + fr, fq * 8), boff = lds_byte(wc * 32 + fr, fq * 8);
#define PG8_SA(b, h) (((b) * 2 + (h)) * HTB)
#define PG8_SB(b, h) ((4 + (b) * 2 + (h)) * HTB)
#define PG8_STAGE(bufoff, gbase, voff) do { _Pragma("unroll") for (int _i = 0; _i < 2; ++_i) \
        __builtin_amdgcn_global_load_lds((const unsigned*)((const char*)(gbase) + (voff)[_i]), (LAS unsigned*)(lds + (bufoff) + ldsw + _i * 8192), 16, 0, 0); } while (0)
#define PG8_LDA(dst, b, h) do { _Pragma("unroll") for (int m = 0; m < 4; ++m) _Pragma("unroll") for (int k = 0; k < 2; ++k) dst[m][k] = *(const LAS bf16x8*)(lds + PG8_SA(b, h) + aoff + m * 2048 + k * 1024); } while (0)
#define PG8_LDB(dst, b, h) do { _Pragma("unroll") for (int n = 0; n < 2; ++n) _Pragma("unroll") for (int k = 0; k < 2; ++k) dst[n][k] = *(const LAS bf16x8*)(lds + PG8_SB(b, h) + boff + n * 2048 + k * 1024); } while (0)
#define PG8_MMA(ai, bj, At, Bt) do { __builtin_amdgcn_s_setprio(1); _Pragma("unroll") for (int m = 0; m < 4; ++m) _Pragma("unroll") for (int n = 0; n < 2; ++n) _Pragma("unroll") for (int k = 0; k < 2; ++k) \
        acc[ai][bj][m][n] = __builtin_amdgcn_mfma_f32_16x16x32_bf16(Bt[n][k], At[m][k], acc[ai][bj][m][n], 0, 0, 0); __builtin_amdgcn_s_setprio(0); } while (0)
#define PG8_WAIT_V(n) asm volatile("s_waitcnt vmcnt(" #n ")" ::: "memory")
#define PG8_WAIT_L(n) asm volatile("s_waitcnt lgkmcnt(" #n ")" ::: "memory")
#define PG8_BAR __builtin_amdgcn_s_barrier()
#define PG8_SCHED __builtin_amdgcn_sched_barrier(0)
    Unit cur, nxt; int ui = 0;
    if (!S.next(0, cur)) return;
    f32x4 acc[2][2][4][2];
#pragma unroll
    for (int a = 0; a < 2; ++a)
#pragma unroll
        for (int b = 0; b < 2; ++b)
#pragma unroll
            for (int m = 0; m < 4; ++m)
#pragma unroll
                for (int n = 0; n < 2; ++n) acc[a][b][m][n] = (f32x4){0.f, 0.f, 0.f, 0.f};
    bf16x8 At[4][2], B0[2][2], B1[2][2];
    const char* cA = (const char*)g.A + (size_t)cur.pb * SA + (size_t)cur.pm * tstepA + (cur.hm > 0 ? hstepA : (size_t)0); const char* cB = (const char*)g.Bt + (size_t)cur.pb * SB + (size_t)cur.pn * tstepB;
    unsigned cH = cur.hm < 0 ? (unsigned)hstepA : 0u;
    PG8_STAGE(PG8_SB(0, 0), cB, voffB); PG8_STAGE(PG8_SB(0, 1), cB + hstepB, voffB); PG8_STAGE(PG8_SA(0, 0), cA, voffA); PG8_STAGE(PG8_SA(0, 1), cA + cH, voffA);
    if (wr == 1) PG8_BAR;
    PG8_WAIT_V(2); PG8_BAR;
    PG8_STAGE(PG8_SB(1, 0), cB + kstep, voffB); PG8_STAGE(PG8_SA(1, 0), cA + kstep, voffA); PG8_STAGE(PG8_SB(1, 1), cB + hstepB + kstep, voffB);
    PG8_WAIT_V(6); PG8_BAR;
    for (;;) {
        const bool has_next = S.next(ui + 1, nxt);
        const char* nA = has_next ? (const char*)g.A + (size_t)nxt.pb * SA + (size_t)nxt.pm * tstepA + (nxt.hm > 0 ? hstepA : (size_t)0) : cA; const char* nB = has_next ? (const char*)g.Bt + (size_t)nxt.pb * SB + (size_t)nxt.pn * tstepB : cB;
        const unsigned nH = has_next ? (nxt.hm < 0 ? (unsigned)hstepA : 0u) : cH;
        const bool whole = cur.hm < 0;
        for (int t = 0; t < nt; t += 2) {
            const bool last = (t == nt - 2);
            const char* a1 = cA + (size_t)(t + 1) * kstep;
            const char* a2 = last ? nA : cA + (size_t)(t + 2) * kstep; const char* b2 = last ? nB : cB + (size_t)(t + 2) * kstep; const unsigned h2 = last ? nH : cH;
            const char* a3 = a2 + kstep; const char* b3 = b2 + kstep;
            PG8_LDB(B0, 0, 0); PG8_LDB(B1, 0, 1); PG8_SCHED; PG8_LDA(At, 0, 0); PG8_STAGE(PG8_SA(1, 1), a1 + cH, voffA);
            PG8_WAIT_V(8); PG8_WAIT_L(0); PG8_BAR; PG8_MMA(0, 0, At, B0); PG8_MMA(0, 1, At, B1); PG8_BAR; PG8_SCHED;
            PG8_LDA(At, 0, 1); PG8_STAGE(PG8_SB(0, 0), b2, voffB); PG8_STAGE(PG8_SB(0, 1), b2 + hstepB, voffB); PG8_STAGE(PG8_SA(0, 0), a2, voffA);
            PG8_WAIT_V(8); PG8_WAIT_L(0); PG8_BAR; if (whole) { PG8_MMA(1, 0, At, B0); PG8_MMA(1, 1, At, B1); } PG8_BAR; PG8_SCHED;
            PG8_LDB(B0, 1, 0); PG8_LDB(B1, 1, 1); PG8_SCHED; PG8_LDA(At, 1, 0); PG8_STAGE(PG8_SA(0, 1), a2 + h2, voffA);
            PG8_WAIT_V(8); PG8_WAIT_L(0); PG8_BAR; PG8_MMA(0, 0, At, B0); PG8_MMA(0, 1, At, B1); PG8_BAR; PG8_SCHED;
            PG8_LDA(At, 1, 1); PG8_STAGE(PG8_SB(1, 0), b3, voffB); PG8_STAGE(PG8_SB(1, 1), b3 + hstepB, voffB); PG8_STAGE(PG8_SA(1, 0), a3, voffA);
            PG8_WAIT_V(8); PG8_WAIT_L(0); PG8_BAR; if (whole) { PG8_MMA(1, 0, At, B0); PG8_MMA(1, 1, At, B1); } PG8_BAR; PG8_SCHED;
        }
        if (wr == 0) PG8_BAR;
        E(acc, cur, wr, wc, fr, fq);
        if (!has_next) break;
#pragma unroll
        for (int a = 0; a < 2; ++a)
#pragma unroll
            for (int b = 0; b < 2; ++b)
#pragma unroll
                for (int m = 0; m < 4; ++m)
#pragma unroll
                    for (int n = 0; n < 2; ++n) acc[a][b][m][n] = (f32x4){0.f, 0.f, 0.f, 0.f};
        cur = nxt; cA = nA; cB = nB; cH = nH; ++ui;
        if (wr == 1) PG8_BAR;
    }
    PG8_WAIT_V(0);
    PG8_BAR;
#undef PG8_SA
#undef PG8_SB
#undef PG8_STAGE
#undef PG8_LDA
#undef PG8_LDB
#undef PG8_MMA
#undef PG8_WAIT_V
#undef PG8_WAIT_L
#undef PG8_BAR
#undef PG8_SCHED
}

#define EPI_ON (uhm_ < 0 || ai == uhm_)
#define EPI_ACC(k_) ((ai == 1 && uhm_ >= 0) ? acc[0][bj][m][k_] : acc[ai][bj][m][k_])
#define EPI_FOR _Pragma("unroll") for (int ai = 0; ai < 2; ++ai) if (EPI_ON) _Pragma("unroll") for (int m = 0; m < 4; ++m) _Pragma("unroll") for (int bj = 0; bj < 2; ++bj)
#define EPI_COORDS const int ln_ = lane_id_now(), wr = wr_, wc = wc_, fr = ln_ & 15, fq = ln_ >> 4, uhm_ = u.hm;
#define EPI_V const f32x4 v0 = EPI_ACC(0), v1 = EPI_ACC(1);

struct EpiIn {
    static constexpr bool PERM = true;
    unsigned char* ws;
    __device__ __forceinline__ void operator()(const f32x4 (&acc)[2][2][4][2], const Unit& u, int wr_, int wc_, int fr_, int fq_) const {
        EPI_COORDS
        const int pn = u.pn, r0 = u.pm * BM, rl = wr * 64 + fr, cl0 = wc * 32 + 8 * fq;
        size_t boff; long sA, sM1, sM0, sB;
        if (pn == 4 || pn == 5) {
            int kv0; if (r0 < NLAT) kv0 = (r0 >> 12) * KVLEN + (r0 & 4095); else kv0 = ((r0 - NLAT) >> 8) * KVLEN + SEQ;
            boff = WS_KB + (size_t)(pn - 4) * (WS_VB - WS_KB) + ((size_t)(kv0 + rl) * KVW + cl0) * 2; sA = 128 * KVW; sM1 = 32 * KVW; sM0 = 16 * KVW; sB = 128;
        } else if (pn == 6 || pn == 7) {
            int col0; if (r0 < NLAT) col0 = ((r0 & 4095) >> 5) * 8 + (r0 >> 12); else col0 = NCHL * 8 + ((r0 - NLAT) >> 8);
            boff = WS_UCAT + ((size_t)(((pn - 6) * 16 + wc * 2 + (fq >> 1)) * NCOLP + col0 + wr * 16) * KCAT + fr * SP + (fq & 1) * 8) * 2;
            sA = (long)32 * KCAT; sM1 = (long)8 * KCAT; sM0 = 16 * SP; sB = (long)8 * NCOLP * KCAT;
        } else {
            const int grp = pn < 4 ? 0 : (pn < 12 ? 1 : 2), pc = pn - (grp == 0 ? 0 : (grp == 1 ? 8 : 12));
            const size_t tb = WS_Q + (size_t)grp * (WS_GA - WS_Q) - (grp == 2 ? (size_t)((WS_GA - WS_Q) - (WS_GB - WS_GA)) : 0);
            boff = tb + ((size_t)(r0 + rl) * DM + pc * 256 + cl0) * 2; sA = 128 * DM; sM1 = 32 * DM; sM0 = 16 * DM; sB = 128;
        }
        bf16_t* base = (bf16_t*)(ws + boff);
        EPI_FOR { EPI_V *(u32x4*)(base + ai * sA + (m >> 1) * sM1 + (m & 1) * sM0 + bj * sB) = pack8(v0, v1); }
    }
};
struct EpiBf16 {
    static constexpr bool PERM = true;
    bf16_t* O; int ldc;
    __device__ __forceinline__ void operator()(const f32x4 (&acc)[2][2][4][2], const Unit& u, int wr_, int wc_, int fr_, int fq_) const {
        EPI_COORDS
        bf16_t* base = O + (size_t)(u.pm * BM + wr * 64 + fr) * ldc + u.pn * BM + wc * 32 + 8 * fq; const long sR = (long)16 * ldc;
        EPI_FOR { EPI_V *(u32x4*)(base + (ai * 8 + m) * sR + bj * 128) = pack8(v0, v1); }
    }
};
struct EpiSX {
    static constexpr bool PERM = true;
    float* SX;
    __device__ __forceinline__ void operator()(const f32x4 (&acc)[2][2][4][2], const Unit& u, int wr_, int wc_, int fr_, int fq_) const {
        EPI_COORDS
        float* base = SX + ((size_t)(u.pb * NCOLP + u.pm * BM + wr * 64 + fr) * 256 + wc * 32 + 8 * fq);
        const bool tail = (u.pm == 4);
        EPI_FOR { EPI_V if (!tail || (ai == 0 && wr == 0)) { float* d = base + (ai * 8 + m) * (16 * 256) + bj * 128; *(f32x4*)d = v0; *(f32x4*)(d + 4) = v1; } }
    }
};
#define EPI_GROUPS _Pragma("unroll") for (int ai = 0; ai < 2; ++ai) if (EPI_ON) _Pragma("unroll") for (int mh = 0; mh < 2; ++mh)
#define EPI_IN_GROUP _Pragma("unroll") for (int e_ = 0; e_ < 4; ++e_)
#define EPI_GIDX const int m = 2 * mh + (e_ >> 1), bj = e_ & 1; (void)m; (void)bj;
struct EpiS3 {
    static constexpr bool PERM = true;
    const bf16_t* UCAT; const float* dsk; bf16_t* YG;
    __device__ __forceinline__ void operator()(const f32x4 (&acc)[2][2][4][2], const Unit& u, int wr_, int wc_, int fr_, int fq_) const {
        EPI_COORDS
        const int gg = u.pb, b = fr & 7, p0 = (fq & 1) * 8, tl = u.pn * 16 + wc * 2 + (fq >> 1);
        const bool tail = (u.pm == 4);
        const int tok0 = tail ? NLAT + b * CTXL + (fr >> 3) * ST + tl : b * SEQ + (u.pm * 32 + wr * 8 + (fr >> 3)) * ST + tl;
        const bf16_t* ub = UCAT + ((size_t)(gg * NCOLP + u.pm * BM + wr * 64 + fr) * KCAT + tl * SP + p0);
        bf16_t* yb = YG + (size_t)tok0 * SSMW + gg * SP + p0;
        const f32x4 d0 = *(const f32x4*)(dsk + gg * SP + p0), d1 = *(const f32x4*)(dsk + gg * SP + p0 + 4);
        EPI_GROUPS { if (!tail || (ai == 0 && wr == 0)) {
            u32x4 uw[4];
            EPI_IN_GROUP { EPI_GIDX uw[e_] = *(const u32x4*)(ub + (size_t)(ai * 128 + m * 16) * KCAT + bj * 8 * SP); }
            EPI_IN_GROUP { EPI_GIDX const f32x4 v0 = EPI_ACC(0), v1 = EPI_ACC(1);
                f32x4 u0, u1; unpack8(uw[e_], u0, u1);
                f32x4 y0 = v0 + d0 * u0, y1 = v1 + d1 * u1;
#pragma unroll
                for (int i = 0; i < 4; ++i) { y0[i] = gelu_tanh(y0[i]); y1[i] = gelu_tanh(y1[i]); }
                *(u32x4*)(yb + (size_t)((ai * 16 + m * 2) * ST + bj * 8) * SSMW) = pack8(y0, y1); } } }
    }
};
struct EpiGlu {
    static constexpr bool PERM = true;
    const bf16_t* YG; const float* bias; bf16_t* O;
    __device__ __forceinline__ void operator()(const f32x4 (&acc)[2][2][4][2], const Unit& u, int wr_, int wc_, int fr_, int fq_) const {
        EPI_COORDS
        const int c0 = u.pn * BM + wc * 32 + 8 * fq; const size_t off = (size_t)(u.pm * BM + wr * 64 + fr) * SSMW + c0;
        f32x4 bb[2][2];
#pragma unroll
        for (int bj = 0; bj < 2; ++bj) { bb[bj][0] = *(const f32x4*)(bias + c0 + bj * 128); bb[bj][1] = *(const f32x4*)(bias + c0 + bj * 128 + 4); }
        EPI_GROUPS {
            u32x4 yw[4];
            EPI_IN_GROUP { EPI_GIDX yw[e_] = *(const u32x4*)(YG + off + (size_t)(ai * 128 + m * 16) * SSMW + bj * 128); }
            EPI_IN_GROUP { EPI_GIDX const f32x4 v0 = EPI_ACC(0), v1 = EPI_ACC(1);
                f32x4 y0, y1; unpack8(yw[e_], y0, y1);
                f32x4 o0, o1;
#pragma unroll
                for (int i = 0; i < 4; ++i) { o0[i] = y0[i] * sigmoidf_(v0[i] + bb[bj][0][i]); o1[i] = y1[i] * sigmoidf_(v1[i] + bb[bj][1][i]); }
                *(u32x4*)(O + off + (size_t)(ai * 128 + m * 16) * SSMW + bj * 128) = pack8(o0, o1); } }
    }
};
template <bool ADD> struct EpiMerge {
    static constexpr bool PERM = true;
    const bf16_t* G; bf16_t* Y;
    __device__ __forceinline__ void operator()(const f32x4 (&acc)[2][2][4][2], const Unit& u, int wr_, int wc_, int fr_, int fq_) const {
        EPI_COORDS
        const size_t off = (size_t)(u.pm * BM + wr * 64 + fr) * DM + u.pn * BM + wc * 32 + 8 * fq;
        EPI_GROUPS {
            u32x4 gw[4], yw[4];
            EPI_IN_GROUP { EPI_GIDX const size_t o = off + (size_t)(ai * 128 + m * 16) * DM + bj * 128; gw[e_] = *(const u32x4*)(G + o); if (ADD) yw[e_] = *(const u32x4*)(Y + o); }
            EPI_IN_GROUP { EPI_GIDX const size_t o = off + (size_t)(ai * 128 + m * 16) * DM + bj * 128; const f32x4 v0 = EPI_ACC(0), v1 = EPI_ACC(1);
                f32x4 g0, g1; unpack8(gw[e_], g0, g1);
                f32x4 o0, o1;
#pragma unroll
                for (int i = 0; i < 4; ++i) { o0[i] = sigmoidf_(g0[i]) * v0[i]; o1[i] = sigmoidf_(g1[i]) * v1[i]; }
                if (ADD) { f32x4 y0, y1; unpack8(yw[e_], y0, y1); o0 += y0; o1 += y1; }
                *(u32x4*)(Y + o) = pack8(o0, o1); } }
    }
};
struct EpiWo {
    static constexpr bool PERM = true;
    const float* hsrc; float* hlat; float* hctx; const float* modl; const float* g2; bf16_t* HB; float* SSP; LAS float* P;
    __device__ __forceinline__ void operator()(const f32x4 (&acc)[2][2][4][2], const Unit& u, int wr_, int wc_, int fr_, int fq_) const {
        EPI_COORDS
        const int r0 = u.pm * BM, c0 = u.pn * BM + wc * 32 + 8 * fq;
        const size_t roff = (size_t)(wr * 64 + fr) * DM + c0;
        const float* sb = (r0 < NLAT ? hsrc + (size_t)r0 * DM : hctx + (size_t)(r0 - NLAT) * DM) + roff;
        float* hb = (r0 < NLAT ? hlat + (size_t)r0 * DM : hctx + (size_t)(r0 - NLAT) * DM) + roff;
        bf16_t* bb = HB + (size_t)r0 * DM + roff;
        const float* mr = modl + (size_t)(r0 < NLAT ? (r0 >> 12) : NB) * MODW + c0;
        f32x4 gg[2][2], gs[2][2];
#pragma unroll
        for (int bj = 0; bj < 2; ++bj)
#pragma unroll
            for (int k = 0; k < 2; ++k) { gg[bj][k] = *(const f32x4*)(mr + 2 * DM + bj * 128 + 4 * k);
                gs[bj][k] = *(const f32x4*)(g2 + c0 + bj * 128 + 4 * k) * (1.0f + *(const f32x4*)(mr + 4 * DM + bj * 128 + 4 * k)); }
        float ssq[2][4];
#pragma unroll
        for (int ai = 0; ai < 2; ++ai)
#pragma unroll
            for (int m = 0; m < 4; ++m) ssq[ai][m] = 0.f;
        EPI_GROUPS {
            f32x4 h0[4], h1[4];
            EPI_IN_GROUP { EPI_GIDX const size_t o = (size_t)(ai * 128 + m * 16) * DM + bj * 128; h0[e_] = *(const f32x4*)(sb + o); h1[e_] = *(const f32x4*)(sb + o + 4); }
            EPI_IN_GROUP { EPI_GIDX const size_t o = (size_t)(ai * 128 + m * 16) * DM + bj * 128; const f32x4 v0 = EPI_ACC(0), v1 = EPI_ACC(1);
                const f32x4 n0 = h0[e_] + gg[bj][0] * v0, n1 = h1[e_] + gg[bj][1] * v1;
                *(f32x4*)(hb + o) = n0; *(f32x4*)(hb + o + 4) = n1;
                *(u32x4*)(bb + o) = pack8(n0 * gs[bj][0], n1 * gs[bj][1]);
                ssq[ai][m] += ((n0[0] * n0[0] + n0[1] * n0[1]) + (n0[2] * n0[2] + n0[3] * n0[3])) + ((n1[0] * n1[0] + n1[1] * n1[1]) + (n1[2] * n1[2] + n1[3] * n1[3])); } }
#pragma unroll
        for (int ai = 0; ai < 2; ++ai)
#pragma unroll
            for (int m = 0; m < 4; ++m) { float t = ssq[ai][m];
                t += __builtin_bit_cast(float, __builtin_amdgcn_ds_swizzle(__builtin_bit_cast(int, t), 0x401F));
                { auto rr = __builtin_amdgcn_permlane32_swap(__float_as_uint(t), __float_as_uint(t), false, false); t = __uint_as_float(rr[0]) + __uint_as_float(rr[1]); }
                if (fq == 0) P[(ai * 128 + wr * 64 + m * 16 + fr) * 4 + wc] = t; }
        asm volatile("s_waitcnt lgkmcnt(0)" ::: "memory"); __builtin_amdgcn_s_barrier(); asm volatile("" ::: "memory");
        { const int t_ = wr * 256 + wc * 64 + ln_; if (t_ < 256 && (uhm_ < 0 || (t_ >> 7) == uhm_)) { const f32x4 q = *(const LAS f32x4*)(P + t_ * 4); SSP[(size_t)(r0 + t_) * 4 + u.pn] = (q[0] + q[1]) + (q[2] + q[3]); } }
    }
};
struct EpiPQ {
    static constexpr bool PERM = true;
    bf16_t* O; const float* SSP; const float* bias;
    __device__ __forceinline__ void operator()(const f32x4 (&acc)[2][2][4][2], const Unit& u, int wr_, int wc_, int fr_, int fq_) const {
        EPI_COORDS
        const int r0 = u.pm * BM, c0 = u.pn * BM + wc * 32 + 8 * fq;
        const float* br = bias + (size_t)(r0 < NLAT ? (r0 >> 12) : NB) * PQW + c0;
        f32x4 bb[2][2];
#pragma unroll
        for (int bj = 0; bj < 2; ++bj) { bb[bj][0] = *(const f32x4*)(br + bj * 128); bb[bj][1] = *(const f32x4*)(br + bj * 128 + 4); }
        float rinv[2][4];
        const float* sp = SSP + (size_t)(r0 + wr * 64 + fr) * 4;
#pragma unroll
        for (int ai = 0; ai < 2; ++ai)
#pragma unroll
            for (int m = 0; m < 4; ++m) { rinv[ai][m] = 0.f; if (EPI_ON) { const f32x4 t = *(const f32x4*)(sp + (size_t)(ai * 128 + m * 16) * 4);
                rinv[ai][m] = __builtin_amdgcn_rsqf(((t[0] + t[1]) + (t[2] + t[3])) * (1.0f / DM) + EPS); } }
        bf16_t* base = O + (size_t)(r0 + wr * 64 + fr) * PQW + c0;
        EPI_FOR { EPI_V *(u32x4*)(base + (size_t)(ai * 128 + m * 16) * PQW + bj * 128) = pack8(v0 * rinv[ai][m] + bb[bj][0], v1 * rinv[ai][m] + bb[bj][1]); }
    }
};
#undef EPI_GROUPS
#undef EPI_IN_GROUP
#undef EPI_GIDX
}

namespace att {
constexpr int D = 128, NW = 8, QBLK = 32, KVBLK = 64;
constexpr float SCALE = 0.088388347648318440f;
constexpr float THR = 8.f;
#ifndef ATT_SDEPTH
#define ATT_SDEPTH 1
#endif
constexpr int SDEPTH = ATT_SDEPTH;
constexpr int LDQ = DM, LDK = KVW, LDO = DM;
constexpr size_t SHM_V = KVBLK * D * 2, SHM_K = KVBLK * D * 2, SHM_ATTN = 2 * SHM_V + 2 * SHM_K + NW * 64 * 4;
#define KSWZ(row, colB) ((row) * 256 + ((colB) ^ (((row) & 7) << 4)))
#define SBAR() __builtin_amdgcn_sched_barrier(0)
__device__ __forceinline__ int crow(int r, int hi) { return (r & 3) + 8 * (r >> 2) + 4 * hi; }
__device__ __forceinline__ unsigned cvtpk(float lo, float hi) { unsigned r; asm volatile("v_cvt_pk_bf16_f32 %0, %1, %2" : "=v"(r) : "v"(lo), "v"(hi)); return r; }
__device__ __forceinline__ void partialSM(f32x16& p0) {
  for (int r = 0; r < 16; ++r) p0[r] = __builtin_amdgcn_exp2f(p0[r]);
}
__device__ __forceinline__ void finishSM(f32x16& p0, f32x16& p1, float& l_reg, bf16x8& pa0, bf16x8& pa1, bf16x8& pa2, bf16x8& pa3) {
  for (int r = 0; r < 16; ++r) p1[r] = __builtin_amdgcn_exp2f(p1[r]);
  float ps = 0; for (int r = 0; r < 16; ++r) ps += p0[r]; for (int r = 0; r < 16; ++r) ps += p1[r];
  l_reg += ps;
#define PK4(P, BASE, OUT) do { unsigned a0 = cvtpk(P[BASE + 0], P[BASE + 1]), a1 = cvtpk(P[BASE + 2], P[BASE + 3]);   \
    unsigned b0 = cvtpk(P[BASE + 4], P[BASE + 5]), b1 = cvtpk(P[BASE + 6], P[BASE + 7]);                              \
    auto r0 = __builtin_amdgcn_permlane32_swap(a0, b0, false, false); auto r1 = __builtin_amdgcn_permlane32_swap(a1, b1, false, false); \
    u32x4 w = {r0[0], r1[0], r0[1], r1[1]}; OUT = *reinterpret_cast<bf16x8*>(&w); } while (0)
  PK4(p0, 0, pa0); PK4(p0, 8, pa1); PK4(p1, 0, pa2); PK4(p1, 8, pa3);
#undef PK4
}
__device__ __forceinline__ void qkt(f32x16& p0, f32x16& p1, const bf16_t* Ks, const bf16x8* qr, int r32, int hi, float nm0) {
#pragma unroll
  for (int r = 0; r < 16; ++r) { p0[r] = nm0; p1[r] = nm0; }
  const char* kb0 = (const char*)Ks + r32 * 256; const char* kb1 = kb0 + 32 * 256; const int swz = (r32 & 7) << 4;
#define KFRAG(base, d0) (*reinterpret_cast<const bf16x8*>((base) + ((((d0) * 32) + hi * 16) ^ swz)))
  bf16x8 fa0 = KFRAG(kb0, 0), fa1 = KFRAG(kb1, 0), fb0 = KFRAG(kb0, 1), fb1 = KFRAG(kb1, 1);
#pragma unroll
  for (int d0 = 0; d0 < 8; d0 += 2) {
    bf16x8 na0 = fa0, na1 = fa1, nb0 = fb0, nb1 = fb1;
    if (d0 + 2 < 8) { na0 = KFRAG(kb0, d0 + 2); na1 = KFRAG(kb1, d0 + 2); }
    p0 = __builtin_amdgcn_mfma_f32_32x32x16_bf16(fa0, qr[d0], p0, 0, 0, 0);
    p1 = __builtin_amdgcn_mfma_f32_32x32x16_bf16(fa1, qr[d0], p1, 0, 0, 0);
    __builtin_amdgcn_sched_group_barrier(0x100, 2, 0); __builtin_amdgcn_sched_group_barrier(0x008, 2, 0);
    if (d0 + 3 < 8) { nb0 = KFRAG(kb0, d0 + 3); nb1 = KFRAG(kb1, d0 + 3); }
    p0 = __builtin_amdgcn_mfma_f32_32x32x16_bf16(fb0, qr[d0 + 1], p0, 0, 0, 0);
    p1 = __builtin_amdgcn_mfma_f32_32x32x16_bf16(fb1, qr[d0 + 1], p1, 0, 0, 0);
    __builtin_amdgcn_sched_group_barrier(0x100, 2, 0); __builtin_amdgcn_sched_group_barrier(0x008, 2, 0);
    fa0 = na0; fa1 = na1; fb0 = nb0; fb1 = nb1;
  }
#undef KFRAG
}
__device__ __forceinline__ int v_st(int k, int c) { const int kk = (k & ~0xC) | ((k & 4) << 1) | ((k & 8) >> 1); return ((kk >> 3) * 4 + (c >> 5)) * 512 + ((kk & 7) * 32 + (c & 31)) * 2; }
__device__ __forceinline__ int v_rd_base(int lane) { return ((lane & 3) << 3) | (((lane >> 2) & 3) << 6) | (((lane >> 4) & 1) << 5) | (((lane >> 5) & 1) << 8); }
constexpr int v_rd_off(int d0, int ks, int half) { return d0 * 512 + ks * 4096 + half * 2048; }
template <int OFF> __device__ __forceinline__ s16x4 tr_read(int vb) {
  s16x4 r; asm volatile("ds_read_b64_tr_b16 %0, %1 offset:%2" : "=&v"(r) : "v"(vb), "i"(OFF) : "memory"); return r;
}
template <int D0> __device__ __forceinline__ void pv_one(f32x16& od, int vb, bf16x8 pa0, bf16x8 pa1, bf16x8 pa2, bf16x8 pa3) {
  const s16x4 l0 = tr_read<v_rd_off(D0, 0, 0)>(vb), h0 = tr_read<v_rd_off(D0, 0, 1)>(vb), l1 = tr_read<v_rd_off(D0, 1, 0)>(vb), h1 = tr_read<v_rd_off(D0, 1, 1)>(vb);
  const s16x4 l2 = tr_read<v_rd_off(D0, 2, 0)>(vb), h2 = tr_read<v_rd_off(D0, 2, 1)>(vb), l3 = tr_read<v_rd_off(D0, 3, 0)>(vb), h3 = tr_read<v_rd_off(D0, 3, 1)>(vb);
  asm volatile("s_waitcnt lgkmcnt(0)" ::: "memory"); SBAR();
#define PK(L, H) (bf16x8){L[0], L[1], L[2], L[3], H[0], H[1], H[2], H[3]}
  od = __builtin_amdgcn_mfma_f32_32x32x16_bf16(pa0, PK(l0, h0), od, 0, 0, 0);
  od = __builtin_amdgcn_mfma_f32_32x32x16_bf16(pa1, PK(l1, h1), od, 0, 0, 0);
  od = __builtin_amdgcn_mfma_f32_32x32x16_bf16(pa2, PK(l2, h2), od, 0, 0, 0);
  od = __builtin_amdgcn_mfma_f32_32x32x16_bf16(pa3, PK(l3, h3), od, 0, 0, 0);
#undef PK
}
__device__ __forceinline__ void pv_d0(f32x16* o, int vb, bf16x8 pa0, bf16x8 pa1, bf16x8 pa2, bf16x8 pa3) {
  pv_one<0>(o[0], vb, pa0, pa1, pa2, pa3); pv_one<1>(o[1], vb, pa0, pa1, pa2, pa3); pv_one<2>(o[2], vb, pa0, pa1, pa2, pa3); pv_one<3>(o[3], vb, pa0, pa1, pa2, pa3);
}
__device__ __forceinline__ void attn_dense_body(bf16_t* Qb, const bf16_t* Kh, int seq, char* lds, const int tid, const long odelta, const float nm0) {
  const bf16_t* Vh = (const bf16_t*)((const char*)Kh + (WS_VB - WS_KB)); bf16_t* Ob = (bf16_t*)((char*)Qb + odelta);
  const int wid = tid >> 6, lane = tid & 63, r32 = lane & 31, hi = lane >> 5;
  bf16_t* V_lds = (bf16_t*)lds; bf16_t* K_lds = (bf16_t*)(lds + 2 * SHM_V);
  float* ws = (float*)(lds + 2 * SHM_V + 2 * SHM_K) + wid * 64; float* li_l = ws;
  float l_reg = 0; f32x16 o[4] = {}; bf16x8 qr[8];
  const bf16_t* Qw = Qb + (long)(wid * QBLK + r32) * LDQ + hi * 8;
#pragma unroll
  for (int d0 = 0; d0 < 8; ++d0) qr[d0] = *reinterpret_cast<const bf16x8*>(Qw + d0 * 16);
  const int sr = tid >> 4, sc = (tid & 15) * 8, vst0 = v_st(sr, sc), vst1 = v_st(32 + sr, sc);
  const int vb0 = (int)(uintptr_t)V_lds + v_rd_base(lane);
  struct { bf16x8 vs0, vs1, ks0, ks1; } sr_[SDEPTH];
#define LD8(p) (*reinterpret_cast<const bf16x8*>(p))
#define SLOAD(i, k0) do { sr_[i].vs0 = LD8(&Vh[(long)((k0) + sr) * LDK + sc]); sr_[i].vs1 = LD8(&Vh[(long)((k0) + 32 + sr) * LDK + sc]); \
    sr_[i].ks0 = LD8(&Kh[(long)((k0) + sr) * LDK + sc]); sr_[i].ks1 = LD8(&Kh[(long)((k0) + 32 + sr) * LDK + sc]); } while (0)
#define SWRITE(b, i) do { *(bf16x8*)((char*)V_lds + (b) * SHM_V + vst0) = sr_[i].vs0;          \
    *(bf16x8*)((char*)V_lds + (b) * SHM_V + vst1) = sr_[i].vs1; int kc = sc * 2;               \
    *(bf16x8*)((char*)K_lds + (b) * SHM_K + KSWZ(sr, kc)) = sr_[i].ks0;                       \
    *(bf16x8*)((char*)K_lds + (b) * SHM_K + KSWZ(32 + sr, kc)) = sr_[i].ks1; } while (0)
#define SWAIT() do { if constexpr (SDEPTH == 2) asm volatile("s_waitcnt vmcnt(4)" ::: "memory"); else asm volatile("s_waitcnt vmcnt(0)" ::: "memory"); } while (0)
  f32x16 pA0, pA1, pB0, pB1; bf16x8 pa0, pa1, pa2, pa3; const int NT = seq / KVBLK;
  constexpr int SE = 0, SO = SDEPTH - 1;
  SLOAD(SE, 0); asm volatile("s_waitcnt vmcnt(0)" ::: "memory"); SWRITE(0, SE); __syncthreads();
  qkt(pA0, pA1, K_lds, qr, r32, hi, nm0); partialSM(pA0);
  SLOAD(SO, KVBLK); if constexpr (SDEPTH == 2) { if (2 < NT) SLOAD(SE, 2 * KVBLK); }
  SWAIT(); SWRITE(1, SO); __syncthreads();
  for (int j = 1; j + 1 < NT; j += 2) {
    SBAR(); qkt(pB0, pB1, (bf16_t*)((char*)K_lds + SHM_K), qr, r32, hi, nm0);
    finishSM(pA0, pA1, l_reg, pa0, pa1, pa2, pa3); SBAR();
    SLOAD(SO, (j + SDEPTH) * KVBLK); SBAR();
    pv_d0(o, vb0, pa0, pa1, pa2, pa3); partialSM(pB0);
    __syncthreads(); SWAIT(); SWRITE(0, SE);
    __syncthreads();
    SBAR(); qkt(pA0, pA1, K_lds, qr, r32, hi, nm0);
    finishSM(pB0, pB1, l_reg, pa0, pa1, pa2, pa3); SBAR();
    if (SDEPTH == 1 || j + 3 < NT) SLOAD(SE, (j + 1 + SDEPTH) * KVBLK); SBAR();
    pv_d0(o, vb0 + (int)SHM_V, pa0, pa1, pa2, pa3); partialSM(pA0);
    __syncthreads(); SWAIT(); SWRITE(1, SO);
    __syncthreads();
  }
  SBAR(); qkt(pB0, pB1, (bf16_t*)((char*)K_lds + SHM_K), qr, r32, hi, nm0);
  finishSM(pA0, pA1, l_reg, pa0, pa1, pa2, pa3); SBAR();
  pv_d0(o, vb0, pa0, pa1, pa2, pa3); partialSM(pB0);
  __syncthreads();
  finishSM(pB0, pB1, l_reg, pa0, pa1, pa2, pa3); SBAR();
  pv_d0(o, vb0 + (int)SHM_V, pa0, pa1, pa2, pa3);
  { auto rr = __builtin_amdgcn_permlane32_swap(__float_as_uint(l_reg), __float_as_uint(l_reg), false, false); l_reg = __uint_as_float(rr[0]) + __uint_as_float(rr[1]); }
  if (hi == 0) li_l[r32] = l_reg; asm volatile("s_waitcnt lgkmcnt(0)" ::: "memory");
  float rli[16];
#pragma unroll
  for (int r = 0; r < 16; ++r) rli[r] = __builtin_amdgcn_rcpf(li_l[crow(r, hi)]);
  bf16_t* Ow = Ob + (long)(wid * QBLK) * LDO;
#pragma unroll
  for (int r = 0; r < 16; ++r) { int orow = crow(r, hi);
    for (int d0 = 0; d0 < 4; ++d0) Ow[(long)orow * LDO + d0 * 32 + r32] = (bf16_t)f2bf(o[d0][r] * rli[r]); }
  __syncthreads();
#undef LD8
#undef SLOAD
#undef SWRITE
#undef SWAIT
}
constexpr int SLOT = 32768;
__device__ __forceinline__ void attn_dense_body_dma(bf16_t* Qb, const bf16_t* Kh, int seq, char* lds, LAS unsigned char* ldsl, const int tid, const long odelta, const float nm0,
                                                    const float* qgain, const float* rope, const int lpos0) {
  const bf16_t* Vh = (const bf16_t*)((const char*)Kh + (WS_VB - WS_KB)); bf16_t* Ob = (bf16_t*)((char*)Qb + odelta);
  const int wid = __builtin_amdgcn_readfirstlane(tid >> 6), lane = tid & 63, r32 = lane & 31, hi = lane >> 5;
  float* li_l = (float*)(lds + 3 * SLOT) + wid * 64;
  float l_reg = 0; f32x16 o[4] = {}; bf16x8 qr[8];
  const bf16_t* Qw = Qb + (long)(wid * QBLK + r32) * LDQ + hi * 8;
#pragma unroll
  for (int d0 = 0; d0 < 8; ++d0) qr[d0] = *reinterpret_cast<const bf16x8*>(Qw + d0 * 16);
  { f32x4 x[8][2]; float ss = 0.f;
#pragma unroll
    for (int d0 = 0; d0 < 8; ++d0) { unpack8(*reinterpret_cast<const u32x4*>(&qr[d0]), x[d0][0], x[d0][1]);
#pragma unroll
        for (int i = 0; i < 4; ++i) ss += x[d0][0][i] * x[d0][0][i] + x[d0][1][i] * x[d0][1][i]; }
    { auto rr = __builtin_amdgcn_permlane32_swap(__float_as_uint(ss), __float_as_uint(ss), false, false); ss = __uint_as_float(rr[0]) + __uint_as_float(rr[1]); }
    const float rstd = (SCALE * 1.4426950408889634f) * __builtin_amdgcn_rsqf(ss * (1.0f / D) + EPS);
#pragma unroll
    for (int d0 = 0; d0 < 8; ++d0) { const f32x4 g0 = *(const f32x4*)(qgain + d0 * 16 + hi * 8), g1 = *(const f32x4*)(qgain + d0 * 16 + hi * 8 + 4); x[d0][0] = x[d0][0] * rstd * g0; x[d0][1] = x[d0][1] * rstd * g1; }
    if (lpos0 >= 0) { const int lpos = lpos0 + wid * QBLK + r32;
#pragma unroll
      for (int ax = 0; ax < 2; ++ax) { const int posi = ax == 0 ? (lpos >> 6) : (lpos & 63);
#pragma unroll
        for (int dd = 0; dd < 2; ++dd) { const float* cp = rope + posi * 32 + dd * 16 + hi * 8; const int d1 = ax * 4 + dd, d2 = d1 + 2;
#pragma unroll
          for (int hf = 0; hf < 2; ++hf) { const f32x4 cs = *(const f32x4*)(cp + 4 * hf), sn = *(const f32x4*)(cp + 2048 + 4 * hf); const f32x4 x1 = x[d1][hf], x2 = x[d2][hf];
              x[d1][hf] = x1 * cs - x2 * sn; x[d2][hf] = x1 * sn + x2 * cs; } } } }
#pragma unroll
    for (int d0 = 0; d0 < 8; ++d0) { const u32x4 w = pack8(x[d0][0], x[d0][1]); qr[d0] = *reinterpret_cast<const bf16x8*>(&w); } }
  unsigned ksrc[2], vsrc[2];
#pragma unroll
  for (int q = 0; q < 2; ++q) { const int b = q * 8192 + wid * 1024 + lane * 16;
      const int row = b >> 8, cb = (b & 255) ^ ((row & 7) << 4); ksrc[q] = (unsigned)(row * (LDK * 2) + cb);
      const int sub = b >> 9, w = (b & 511) >> 1, kk = (sub >> 2) * 8 + (w >> 5), c = (sub & 3) * 32 + (w & 31), k = (kk & ~0xC) | ((kk & 4) << 1) | ((kk & 8) >> 1);
      vsrc[q] = (unsigned)(k * (LDK * 2) + c * 2); }
#define ADMA(tile, s) do { const char* kb_ = (const char*)Kh + (size_t)(tile) * (KVBLK * LDK * 2); const char* vb_ = (const char*)Vh + (size_t)(tile) * (KVBLK * LDK * 2); \
    _Pragma("unroll") for (int q = 0; q < 2; ++q) __builtin_amdgcn_global_load_lds((const unsigned*)(kb_ + ksrc[q]), (LAS unsigned*)(ldsl + (s) * SLOT + q * 8192 + wid * 1024), 16, 0, 0); \
    _Pragma("unroll") for (int q = 0; q < 2; ++q) __builtin_amdgcn_global_load_lds((const unsigned*)(vb_ + vsrc[q]), (LAS unsigned*)(ldsl + (s) * SLOT + 16384 + q * 8192 + wid * 1024), 16, 0, 0); } while (0)
#define KSLOT(s) ((const bf16_t*)(lds + (s) * SLOT))
#define VBASE(s) (vbl + (s) * SLOT)
#define NEXT3(s) ((s) == 2 ? 0 : (s) + 1)
  const int vbl = (int)(uintptr_t)(lds + 16384) + v_rd_base(lane);
  f32x16 pA0, pA1, pB0, pB1; bf16x8 pa0, pa1, pa2, pa3; const int NT = seq / KVBLK;
  ADMA(0, 0);
  __syncthreads(); ADMA(1, 1);
  qkt(pA0, pA1, KSLOT(0), qr, r32, hi, nm0); partialSM(pA0);
  int sj = 1;
  for (int j = 1; j + 1 < NT; j += 2) {
    { const int sp = sj == 0 ? 2 : sj - 1, sn = NEXT3(sj);
      __syncthreads(); ADMA(j + 1, sn);
      SBAR(); qkt(pB0, pB1, KSLOT(sj), qr, r32, hi, nm0);
      finishSM(pA0, pA1, l_reg, pa0, pa1, pa2, pa3); SBAR();
      pv_d0(o, VBASE(sp), pa0, pa1, pa2, pa3); partialSM(pB0);
      sj = sn; }
    { const int sp = sj == 0 ? 2 : sj - 1, sn = NEXT3(sj);
      __syncthreads(); if (j + 2 < NT) ADMA(j + 2, sn);
      SBAR(); qkt(pA0, pA1, KSLOT(sj), qr, r32, hi, nm0);
      finishSM(pB0, pB1, l_reg, pa0, pa1, pa2, pa3); SBAR();
      pv_d0(o, VBASE(sp), pa0, pa1, pa2, pa3); partialSM(pA0);
      sj = sn; }
  }
  { const int sp = sj == 0 ? 2 : sj - 1;
    __syncthreads();
    SBAR(); qkt(pB0, pB1, KSLOT(sj), qr, r32, hi, nm0);
    finishSM(pA0, pA1, l_reg, pa0, pa1, pa2, pa3); SBAR();
    pv_d0(o, VBASE(sp), pa0, pa1, pa2, pa3); partialSM(pB0);
    finishSM(pB0, pB1, l_reg, pa0, pa1, pa2, pa3); SBAR();
    pv_d0(o, VBASE(sj), pa0, pa1, pa2, pa3); }
  { auto rr = __builtin_amdgcn_permlane32_swap(__float_as_uint(l_reg), __float_as_uint(l_reg), false, false); l_reg = __uint_as_float(rr[0]) + __uint_as_float(rr[1]); }
  if (hi == 0) li_l[r32] = l_reg; asm volatile("s_waitcnt lgkmcnt(0)" ::: "memory");
  float rli[16];
#pragma unroll
  for (int r = 0; r < 16; ++r) rli[r] = __builtin_amdgcn_rcpf(li_l[crow(r, hi)]);
  bf16_t* Ow = Ob + (long)(wid * QBLK) * LDO;
#pragma unroll
  for (int r = 0; r < 16; ++r) { int orow = crow(r, hi);
    for (int d0 = 0; d0 < 4; ++d0) Ow[(long)orow * LDO + d0 * 32 + r32] = (bf16_t)f2bf(o[d0][r] * rli[r]); }
  __syncthreads();
#undef ADMA
#undef KSLOT
#undef VBASE
#undef NEXT3
}
}

namespace peer {
__device__ __forceinline__ float vmax(float a, float b) { float r; asm("v_max_f32 %0, %1, %2" : "=v"(r) : "v"(a), "v"(b)); return r; }
__device__ __forceinline__ float vmin(float a, float b) { float r; asm("v_min_f32 %0, %1, %2" : "=v"(r) : "v"(a), "v"(b)); return r; }
__device__ __forceinline__ void cswap(float& hi_, float& lo_) { const float mx = vmax(hi_, lo_), mn = vmin(hi_, lo_); hi_ = mx; lo_ = mn; }
__device__ __forceinline__ void sort16(float (&v)[16]) {
    constexpr int NET[63][2] = {{0,1},{2,3},{0,2},{1,3},{1,2},{4,5},{6,7},{4,6},{5,7},{5,6},{0,4},{2,6},{2,4},{1,5},{3,7},{3,5},{1,2},{3,4},{5,6},{8,9},{10,11},{8,10},{9,11},{9,10},{12,13},{14,15},{12,14},{13,15},{13,14},
        {8,12},{10,14},{10,12},{9,13},{11,15},{11,13},{9,10},{11,12},{13,14},{0,8},{4,12},{4,8},{2,10},{6,14},{6,10},{2,4},{6,8},{10,12},{1,9},{5,13},{5,9},{3,11},{7,15},{7,11},{3,5},{7,9},{11,13},{1,2},{3,4},{5,6},{7,8},{9,10},{11,12},{13,14}};
#pragma unroll
    for (int k = 0; k < 63; ++k) cswap(v[NET[k][0]], v[NET[k][1]]);
}
__device__ __forceinline__ void bmerge16(float (&v)[16]) {
#pragma unroll
    for (int j = 8; j > 0; j >>= 1)
#pragma unroll
        for (int i = 0; i < 16; ++i) { const int l = i ^ j; if (l > i) cswap(v[i], v[l]); }
}
__device__ __forceinline__ void merge_top16(float (&a)[16], const float (&b)[16]) {
#pragma unroll
    for (int i = 0; i < 16; ++i) a[i] = vmax(a[i], b[15 - i]);
    bmerge16(a);
}
__device__ __forceinline__ float setlow(float v, unsigned mask, unsigned bits) { return __uint_as_float((__float_as_uint(v) & ~mask) | bits); }
__device__ __forceinline__ void top16_of_acc(const f32x16 (&acc)[4], int hi, float (&out)[16]) {
    float t[16];
#pragma unroll
    for (int blk = 0; blk < 4; ++blk) {
#pragma unroll
        for (int r = 0; r < 16; ++r) { const unsigned key = (unsigned)(32 * blk + (r & 3) + 8 * (r >> 2)) | ((unsigned)hi << 2); if (blk == 0) out[r] = setlow(acc[blk][r], 0x7Fu, key); else t[r] = setlow(acc[blk][r], 0x7Fu, key); }
        if (blk == 0) sort16(out); else { sort16(t); merge_top16(out, t); }
    }
}
}

struct Args { const float* in[28]; float* out; unsigned char* ws; int ph_lo, ph_hi; };
enum { I_X = 0, I_C, I_CTX, I_CCTX, I_WMOD, I_BMOD, I_NMG, I_WIN, I_QNG, I_KNG, I_ARE, I_AIM, I_LDT, I_BRE, I_BIM, I_CRE, I_CIM, I_SD, I_WGLU, I_BGLU, I_WBA, I_WBS, I_WO, I_NFG, I_PWQ, I_PKEYS, I_PU, I_PV };

__device__ __forceinline__ void transpose_item(const float* W, int K, int N, bf16_t* WT, LAS float* scr, int item, int lane) {
    const int nblk = N / 32, kb = item / nblk, nb = item % nblk, k0 = 64 * kb, n0 = 32 * nb;
    { f32x4 t[8]; const int kr = lane >> 3, nq = (lane & 7) * 4;
#pragma unroll
      for (int i = 0; i < 8; ++i) t[i] = *(const f32x4*)(W + (size_t)(k0 + 8 * i + kr) * N + n0 + nq);
#pragma unroll
      for (int i = 0; i < 8; ++i) { LAS float* d = scr + (8 * i + kr) * 33 + nq; d[0] = t[i][0]; d[1] = t[i][1]; d[2] = t[i][2]; d[3] = t[i][3]; } }
    asm volatile("s_waitcnt lgkmcnt(0)" ::: "memory");
    const int c = lane & 7;
#pragma unroll
    for (int j = 0; j < 4; ++j) { const int n = (lane >> 3) + 8 * j; const LAS float* s = scr + (8 * c) * 33 + n;
        u32x4 o; o.x = pk2(s[0 * 33], s[1 * 33]); o.y = pk2(s[2 * 33], s[3 * 33]); o.z = pk2(s[4 * 33], s[5 * 33]); o.w = pk2(s[6 * 33], s[7 * 33]);
        *(u32x4*)(WT + (size_t)(n0 + n) * K + k0 + 8 * c) = o; }
    asm volatile("s_waitcnt lgkmcnt(0)" ::: "memory");
}

__device__ __forceinline__ void norm_mod_row(const float* hr, const float* g, const float* sh, const float* sc, bf16_t* orow, int lane) {
    f32x4 v[4]; float ss = 0.f;
#pragma unroll
    for (int j = 0; j < 4; ++j) { v[j] = *(const f32x4*)(hr + (j >> 1) * 512 + lane * 8 + (j & 1) * 4); ss += (v[j][0] * v[j][0] + v[j][1] * v[j][1]) + (v[j][2] * v[j][2] + v[j][3] * v[j][3]); }
    ss = wave_sum(ss, lane);
    const float rstd = __builtin_amdgcn_rsqf(ss * (1.0f / DM) + EPS);
#pragma unroll
    for (int hh = 0; hh < 2; ++hh) {
        const int c0 = hh * 512 + lane * 8; f32x4 o[2];
#pragma unroll
        for (int j = 0; j < 2; ++j) { const f32x4 gg = *(const f32x4*)(g + c0 + 4 * j), s1 = *(const f32x4*)(sc + c0 + 4 * j), s0 = *(const f32x4*)(sh + c0 + 4 * j);
            o[j] = v[hh * 2 + j] * rstd * gg * (1.0f + s1) + s0; }
        *(u32x4*)(orow + c0) = pack8(o[0], o[1]);
    }
}
__device__ __forceinline__ const float* hrow_c(const float* hlat, const float* hctx, int r) { return r < NLAT ? hlat + (size_t)r * DM : hctx + (size_t)(r - NLAT) * DM; }
__device__ __forceinline__ float* hrow_m(float* hlat, float* hctx, int r) { return r < NLAT ? hlat + (size_t)r * DM : hctx + (size_t)(r - NLAT) * DM; }

__device__ __forceinline__ void p0a(const Args& a, LAS unsigned char* lds, int bx, int G, int tid) {
    const int lane = tid & 63, wave = tid >> 6, gw = bx * 8 + wave, NGW = G * 8;
    unsigned char* ws = a.ws;
    { LAS float* scr = (LAS float*)(lds + wave * 16384);
      constexpr int I_IN = 16 * 128, I_BA = 16 * 32, I_BS = 8 * 32, I_OO = 16 * 32, I_GL = 8 * 16, I_QQ = 16 * 64, PER = I_IN + I_BA + I_BS + I_OO + I_GL + I_QQ;
      for (int it = gw; it < PER * DEPTH; it += NGW) {
          const int l = it / PER; int r = it - l * PER; bf16_t* base = (bf16_t*)(ws + WS_WT + (size_t)l * WT_LAYER);
          if (r < I_IN) { transpose_item(a.in[I_WIN] + (size_t)l * DM * INW, DM, INW, (bf16_t*)((char*)base + WT_IN), scr, r, lane); continue; } r -= I_IN;
          if (r < I_BA) { transpose_item(a.in[I_WBA] + (size_t)l * DM * DM, DM, DM, (bf16_t*)((char*)base + WT_BA), scr, r, lane); continue; } r -= I_BA;
          if (r < I_BS) { transpose_item(a.in[I_WBS] + (size_t)l * SSMW * DM, SSMW, DM, (bf16_t*)((char*)base + WT_BS), scr, r, lane); continue; } r -= I_BS;
          if (r < I_OO) { transpose_item(a.in[I_WO] + (size_t)l * DM * DM, DM, DM, (bf16_t*)((char*)base + WT_O), scr, r, lane); continue; } r -= I_OO;
          if (r < I_GL) { transpose_item(a.in[I_WGLU] + (size_t)l * SSMW * SSMW, SSMW, SSMW, (bf16_t*)((char*)base + WT_GLU), scr, r, lane); continue; } r -= I_GL;
          transpose_item(a.in[I_PWQ] + (size_t)l * DM * PQW, DM, PQW, (bf16_t*)((char*)base + WT_Q), scr, r, lane);
      } }
    { const size_t gt = (size_t)bx * 512 + tid, GT = (size_t)G * 512;
      { typedef float v16f_ __attribute__((ext_vector_type(16))); typedef int v6i_ __attribute__((ext_vector_type(6)));
        constexpr int NROWS = 2 * DEPTH * PEXP;
        f32x4 cur[2][4];
#define P0A_TLOAD(dst, r0_) do { _Pragma("unroll") for (int rr = 0; rr < 2; ++rr) { const int row = ((r0_) + rr * NGW < NROWS) ? (r0_) + rr * NGW : (r0_); const bool isU = row < DEPTH * PEXP; const int idx = isU ? row : row - DEPTH * PEXP; \
            const float* src = (isU ? a.in[I_PU] : a.in[I_PV]) + (size_t)idx * DM + lane * 16; _Pragma("unroll") for (int j = 0; j < 4; ++j) dst[rr][j] = *(const f32x4*)(src + 4 * j); } } while (0)
        if (gw < NROWS) P0A_TLOAD(cur, gw);
        for (int row0 = gw; row0 < NROWS; row0 += 2 * NGW) {
          f32x4 nx[2][4];
          if (row0 + 2 * NGW < NROWS) P0A_TLOAD(nx, row0 + 2 * NGW);
          float v[2][16]; float sc[2], inv[2];
#pragma unroll
          for (int rr = 0; rr < 2; ++rr)
#pragma unroll
              for (int j = 0; j < 4; ++j) { v[rr][4 * j] = cur[rr][j][0]; v[rr][4 * j + 1] = cur[rr][j][1]; v[rr][4 * j + 2] = cur[rr][j][2]; v[rr][4 * j + 3] = cur[rr][j][3]; }
#pragma unroll
          for (int rr = 0; rr < 2; ++rr) { float mx = 0.f;
#pragma unroll
              for (int j = 0; j < 16; ++j) mx = fmaxf(mx, fabsf(v[rr][j]));
#pragma unroll
              for (int o = 1; o < 64; o <<= 1) mx = fmaxf(mx, shflx(mx, o, lane));
              sc[rr] = mx > 0.f ? QMAX / mx : 1.0f; inv[rr] = mx > 0.f ? mx * (1.0f / QMAX) : 1.0f; }
#if PEER_FP4
#pragma unroll
          for (int rr = 0; rr < 2; ++rr) { const int row = row0 + rr * NGW; if (row < NROWS) { const bool isU = row < DEPTH * PEXP; const int idx = isU ? row : row - DEPTH * PEXP;
              unsigned w0 = 0u, w1 = 0u;
#define P0A_PK(b) w0 = __builtin_amdgcn_cvt_scalef32_pk_fp4_f32(w0, v[rr][2 * b] * sc[rr], v[rr][2 * b + 1] * sc[rr], 1.0f, b); w1 = __builtin_amdgcn_cvt_scalef32_pk_fp4_f32(w1, v[rr][8 + 2 * b] * sc[rr], v[rr][8 + 2 * b + 1] * sc[rr], 1.0f, b);
              P0A_PK(0) P0A_PK(1) P0A_PK(2) P0A_PK(3)
#undef P0A_PK
              unsigned* dst = (unsigned*)(ws + (isU ? WS_PU : WS_PV) + (size_t)idx * PROW + lane * 8);
              dst[0] = w0; dst[1] = w1;
              if (lane == 0) ((float*)(ws + (isU ? WS_PSU : WS_PSV)))[idx] = inv[rr]; } }
#else
          v16f_ ga, gb;
#pragma unroll
          for (int j = 0; j < 8; ++j) { ga[j] = v[0][2 * j] * sc[0]; gb[j] = v[0][2 * j + 1] * sc[0]; ga[8 + j] = v[1][2 * j] * sc[1]; gb[8 + j] = v[1][2 * j + 1] * sc[1]; }
          const v6i_ pk = __builtin_amdgcn_cvt_scalef32_2xpk16_fp6_f32(ga, gb, 1.0f);
#pragma unroll
          for (int rr = 0; rr < 2; ++rr) { const int row = row0 + rr * NGW; if (row < NROWS) { const bool isU = row < DEPTH * PEXP; const int idx = isU ? row : row - DEPTH * PEXP;
              unsigned* dst = (unsigned*)(ws + (isU ? WS_PU : WS_PV) + (size_t)idx * 768 + lane * 12);
              dst[0] = (unsigned)pk[3 * rr]; dst[1] = (unsigned)pk[3 * rr + 1]; dst[2] = (unsigned)pk[3 * rr + 2];
              if (lane == 0) ((float*)(ws + (isU ? WS_PSU : WS_PSV)))[idx] = inv[rr]; } }
#endif
#pragma unroll
          for (int rr = 0; rr < 2; ++rr)
#pragma unroll
              for (int j = 0; j < 4; ++j) cur[rr][j] = nx[rr][j];
        } }
#undef P0A_TLOAD
      const size_t k8 = (size_t)DEPTH * 2 * PKEYS * 128 / 8;
      for (size_t i = gt; i < k8; i += GT) { const float* src = a.in[I_PKEYS] + i * 8; const f32x4 x0 = *(const f32x4*)src, x1 = *(const f32x4*)(src + 4);
          u32x4 o; o.x = pk2(x0[0], x0[1]); o.y = pk2(x0[2], x0[3]); o.z = pk2(x1[0], x1[1]); o.w = pk2(x1[2], x1[3]);
          *(u32x4*)((bf16_t*)(ws + WS_KEYS) + i * 8) = o; }
      const size_t nc4 = (size_t)NCTX * DM / 4;
      for (size_t i = gt; i < nc4; i += GT) ((f32x4*)(ws + WS_HCTX))[i] = ((const f32x4*)a.in[I_CTX])[i];
      if (bx == 0) { float* ct = (float*)(ws + WS_ROPE); for (int i = tid; i < 64 * 32; i += 512) { const int pos = i >> 5, f = i & 31;
          const float invf = (float)pow(10000.0, -(double)f / 32.0); const float ang = (float)pos * invf; ct[i] = (float)cos((double)ang); ct[2048 + i] = (float)sin((double)ang); } }
    }
    { __syncthreads();
      LAS float* sv = (LAS float*)lds;
      LAS float* part = (LAS float*)(lds + 9 * 1024 * 4);
      for (int i = tid; i < 9 * DM; i += 512) { const int m = i >> 10, k = i & 1023; const float c = m < NB ? a.in[I_C][m * DM + k] : a.in[I_CCTX][k]; sv[i] = c / (1.0f + __expf(-c)); }
      __syncthreads();
      for (int it = bx; it < DEPTH * (MODW / 32); it += G) {
          const int l = it / (MODW / 32), jb = it % (MODW / 32), kh = lane >> 5, j = jb * 32 + (lane & 31), kb = wave * 128 + kh * 64;
          const float* w = a.in[I_WMOD] + ((size_t)l * DM + kb) * MODW + j;
          float acc[9];
#pragma unroll
          for (int m = 0; m < 9; ++m) acc[m] = 0.f;
#pragma unroll 1
          for (int k0 = 0; k0 < 64; k0 += 16) { float wv[16];
#pragma unroll
              for (int i = 0; i < 16; ++i) wv[i] = w[(size_t)(k0 + i) * MODW];
#pragma unroll
              for (int i = 0; i < 16; ++i)
#pragma unroll
                  for (int m = 0; m < 9; ++m) acc[m] += sv[m * DM + kb + k0 + i] * wv[i]; }
#pragma unroll
          for (int m = 0; m < 9; ++m) part[(wave * 9 + m) * 64 + lane] = acc[m];
          __syncthreads();
          for (int i = tid; i < 9 * 32; i += 512) { const int m = i >> 5, jj = i & 31; float s = 0.f;
#pragma unroll
              for (int w8 = 0; w8 < 8; ++w8) s += part[(w8 * 9 + m) * 64 + jj] + part[(w8 * 9 + m) * 64 + 32 + jj];
              ((float*)(ws + WS_MOD))[((size_t)l * 9 + m) * MODW + jb * 32 + jj] = s + a.in[I_BMOD][(size_t)l * MODW + jb * 32 + jj]; }
          __syncthreads();
      }
    }
}

__device__ __forceinline__ void pq_bias(const Args& a, LAS unsigned char* lds, int bx, int G, int tid) {
    const int lane = tid & 63, wave = tid >> 6;
    LAS float* sv = (LAS float*)lds;
    LAS float* part = (LAS float*)(lds + 9 * 1024 * 4);
    for (int it = bx; it < DEPTH * (PQW / 32); it += G) {
        const int l = it / (PQW / 32), jb = it % (PQW / 32), kh = lane >> 5, kb = wave * 128 + kh * 64;
        __syncthreads();
        for (int i = tid; i < 9 * DM; i += 512) { const int m = i >> 10, k = i & 1023; sv[i] = ((const float*)(a.ws + WS_MOD))[((size_t)l * 9 + m) * MODW + 3 * DM + k]; }
        __syncthreads();
        const float* w = a.in[I_PWQ] + ((size_t)l * DM + kb) * PQW + jb * 32 + (lane & 31);
        float acc[9];
#pragma unroll
        for (int m = 0; m < 9; ++m) acc[m] = 0.f;
#pragma unroll 1
        for (int k0 = 0; k0 < 64; k0 += 16) { float wv[16];
#pragma unroll
            for (int i = 0; i < 16; ++i) wv[i] = w[(size_t)(k0 + i) * PQW];
#pragma unroll
            for (int i = 0; i < 16; ++i)
#pragma unroll
                for (int m = 0; m < 9; ++m) acc[m] += sv[m * DM + kb + k0 + i] * wv[i]; }
#pragma unroll
        for (int m = 0; m < 9; ++m) part[(wave * 9 + m) * 64 + lane] = acc[m];
        __syncthreads();
        for (int i = tid; i < 9 * 32; i += 512) { const int m = i >> 5, jj = i & 31; float s_ = 0.f;
#pragma unroll
            for (int w8 = 0; w8 < 8; ++w8) s_ += part[(w8 * 9 + m) * 64 + jj] + part[(w8 * 9 + m) * 64 + 32 + jj];
            ((float*)(a.ws + WS_PQB))[((size_t)l * 9 + m) * PQW + jb * 32 + jj] = s_; }
    }
    __syncthreads();
}

__device__ __forceinline__ void norm_pass(const Args& a, int l, int sel, bf16_t* dst, int gw, int NGW, int lane, int nrows, const float* hlat) {
    const float* mod = (const float*)(a.ws + WS_MOD) + (size_t)l * 9 * MODW;
    const float* g = a.in[sel ? I_NFG : I_NMG] + (size_t)l * DM;
    const float* hctx = (const float*)(a.ws + WS_HCTX);
    for (int r = gw; r < nrows; r += NGW) { const float* mr = mod + (size_t)modrow_of(r) * MODW + sel * 3 * DM;
        norm_mod_row(hrow_c(hlat, hctx, r), g, mr, mr + DM, dst + (size_t)r * DM, lane); }
}

__device__ __forceinline__ void ssm_tables(const Args& a, int l, LAS unsigned char* lds, int bx, int G, int tid) {
    LAS float* ErT = (LAS float*)lds;
    LAS float* EiT = ErT + 1024;
    LAS float* kr = EiT + 1024;
    LAS float* ki = kr + 128;
    LAS float* red = ki + 128;
    LAS float* E2r = red + 2048;
    LAS float* E2i = E2r + 512;
    LAS float* E3r = E2i + 512;
    LAS float* E3i = E3r + 512;
    LAS float* Cr = E3i + 512;
    LAS float* Ci = Cr + 2048;
    LAS float* kBr = Ci + 2048;
    LAS float* kBi = kBr + 2048;
    bf16_t* WCAT = (bf16_t*)(a.ws + WS_WCAT); bf16_t* WST = (bf16_t*)(a.ws + WS_WSTATE);
    for (int unit = bx; unit < SG * 8; unit += G) {
        const int g = unit >> 3, oc = unit & 7;
        __syncthreads();
        { const int d = tid >> 8, v = tid & 255; const size_t o4 = (((size_t)l * 2 + d) * SG + g) * (SP * SN) + v * 4;
          *(LAS f32x4*)(Cr + tid * 4) = *(const f32x4*)(a.in[I_CRE] + o4); *(LAS f32x4*)(Ci + tid * 4) = *(const f32x4*)(a.in[I_CIM] + o4);
          *(LAS f32x4*)(kBr + tid * 4) = *(const f32x4*)(a.in[I_BRE] + o4); *(LAS f32x4*)(kBi + tid * 4) = *(const f32x4*)(a.in[I_BIM] + o4); }
        {   const int dn = tid & 127, d = dn >> 6, n = dn & 63; const size_t o = (((size_t)l * 2 + d) * SG + g) * SN + n;
            const float are = a.in[I_ARE][o], aim = a.in[I_AIM][o], dt = expf(a.in[I_LDT][((size_t)l * 2 + d) * SG + g]);
            const float th = aim * dt;
            if (tid < 128) { const float mag = expf(are * dt), abr = mag * cosf(th), abi = mag * sinf(th);
                const float den = are * are + aim * aim, nr = abr - 1.0f, ni = abi;
                kr[tid] = (nr * are + ni * aim) / den; ki[tid] = (ni * are - nr * aim) / den; }
#pragma unroll
            for (int ii = 0; ii < 2; ++ii) { const int i = (tid >> 7) + 4 * ii, dl = -31 + 8 * oc + i; const int e = dl < 0 ? -dl : dl;
                const bool on = (dl == 0) || (dl > 0 && d == 0) || (dl < 0 && d == 1);
                const float mg = expf((float)e * are * dt), ph = (float)e * th;
                ErT[dn * 8 + i] = (on && dl <= 31) ? mg * cosf(ph) : 0.f; EiT[dn * 8 + i] = (on && dl <= 31) ? mg * sinf(ph) : 0.f; }
        }
        {
            const int q4 = tid >> 7, d = (tid >> 6) & 1, n = tid & 63; const size_t o = (((size_t)l * 2 + d) * SG + g) * SN + n;
            const float are = a.in[I_ARE][o], aim = a.in[I_AIM][o], dt = expf(a.in[I_LDT][((size_t)l * 2 + d) * SG + g]);
            const int t = 4 * oc + q4;
            const int e2 = d == 0 ? t + 1 : ST - t;
            const int e3 = d == 0 ? ST - 1 - t : t;
            const float m2 = expf((float)e2 * are * dt), p2 = (float)e2 * aim * dt, m3 = expf((float)e3 * are * dt), p3 = (float)e3 * aim * dt;
            E2r[tid] = m2 * cosf(p2); E2i[tid] = m2 * sinf(p2); E3r[tid] = m3 * cosf(p3); E3i[tid] = m3 * sinf(p3);
        }
        __syncthreads();
        { const int dn = tid >> 2; const float k_r = kr[dn], k_i = ki[dn];
          const f32x4 br = *(LAS f32x4*)(kBr + tid * 4), bi = *(LAS f32x4*)(kBi + tid * 4);
          *(LAS f32x4*)(kBr + tid * 4) = k_r * br - k_i * bi; *(LAS f32x4*)(kBi + tid * 4) = k_r * bi + k_i * br; }
        __syncthreads();
        {
            const int pq = tid & 255, p = pq >> 4, q = pq & 15, nh = tid >> 8;
            float acc[8];
#pragma unroll
            for (int i = 0; i < 8; ++i) acc[i] = 0.f;
            for (int d = 0; d < 2; ++d) {
#pragma unroll 4
                for (int n = nh * 32; n < nh * 32 + 32; ++n) {
                    const float cr = Cr[d * 1024 + p * 64 + n], ci = Ci[d * 1024 + p * 64 + n], Br = kBr[d * 1024 + n * 16 + q], Bi = kBi[d * 1024 + n * 16 + q];
                    const float xr = cr * Br - ci * Bi, xi = cr * Bi + ci * Br;
                    const f32x4 e0 = *(LAS f32x4*)(ErT + (d * 64 + n) * 8), e1 = *(LAS f32x4*)(ErT + (d * 64 + n) * 8 + 4), f0 = *(LAS f32x4*)(EiT + (d * 64 + n) * 8), f1 = *(LAS f32x4*)(EiT + (d * 64 + n) * 8 + 4);
#pragma unroll
                    for (int i = 0; i < 4; ++i) { acc[i] += xr * e0[i] - xi * f0[i]; acc[4 + i] += xr * e1[i] - xi * f1[i]; }
                }
            }
            if (nh == 1) {
#pragma unroll
                for (int i = 0; i < 8; ++i) red[i * 256 + pq] = acc[i]; }
            __syncthreads();
            if (nh == 0) {
#pragma unroll
                for (int i = 0; i < 8; ++i) red[i * 256 + pq] += acc[i]; }
            __syncthreads();
            for (int idx = tid; idx < 8 * 32 * 32; idx += 512) {
                const int i = idx >> 10, j = (idx >> 5) & 31, p2 = (idx >> 1) & 15, qh = idx & 1, dl = -31 + 8 * oc + i;
                if (dl > 31) continue;
                const int ad = dl < 0 ? -dl : dl; if (j >= ST - ad) continue;
                const int t = (dl > 0 ? dl : 0) + j, s = t - dl;
                const f32x4 v0 = *(LAS f32x4*)(red + i * 256 + p2 * 16 + qh * 8), v1 = *(LAS f32x4*)(red + i * 256 + p2 * 16 + qh * 8 + 4);
                *(u32x4*)(WCAT + ((size_t)g * 512 + t * SP + p2) * KCAT + s * SP + qh * 8) = pack8(v0, v1);
            }
        }
        for (int idx = tid; idx < 4 * 16 * 32; idx += 512) {
            const int kk8 = idx & 31, rp = idx >> 5, q4 = rp >> 4, p = rp & 15, d = kk8 >> 4, part = (kk8 >> 3) & 1, n0 = (kk8 & 7) * 8, t = 4 * oc + q4;
            f32x4 o0, o1;
#pragma unroll
            for (int e = 0; e < 8; ++e) { const int n = n0 + e; const float cr = Cr[d * 1024 + p * 64 + n], ci = Ci[d * 1024 + p * 64 + n], er = E2r[q4 * 128 + d * 64 + n], ei = E2i[q4 * 128 + d * 64 + n];
                const float v = part == 0 ? (cr * er - ci * ei) : -(cr * ei + ci * er); if (e < 4) o0[e] = v; else o1[e - 4] = v; }
            *(u32x4*)(WCAT + ((size_t)g * 512 + t * SP + p) * KCAT + 512 + kk8 * 8) = pack8(o0, o1);
        }
        for (int idx = tid; idx < 256 * 8; idx += 512) {
            const int c8 = idx & 7, j = idx >> 3, q4 = c8 >> 1, q0 = (c8 & 1) * 8, d = j >> 7, part = (j >> 6) & 1, n = j & 63, s = 4 * oc + q4;
            const float er = E3r[q4 * 128 + d * 64 + n], ei = E3i[q4 * 128 + d * 64 + n];
            f32x4 o0, o1;
#pragma unroll
            for (int e = 0; e < 8; ++e) { const float Br = kBr[d * 1024 + n * 16 + q0 + e], Bi = kBi[d * 1024 + n * 16 + q0 + e];
                const float v = part == 0 ? (er * Br - ei * Bi) : (er * Bi + ei * Br); if (e < 4) o0[e] = v; else o1[e - 4] = v; }
            *(u32x4*)(WST + ((size_t)g * 256 + j) * 512 + s * SP + q0) = pack8(o0, o1);
        }
    }
    __syncthreads();
}

__device__ __forceinline__ void ssm_carry(const Args& a, int l, int vb, int tid) {
    const int idx = vb * 512 + tid, n = idx & 63, d = (idx >> 6) & 1, g = (idx >> 7) & 31, b = idx >> 12;
    const size_t o = (((size_t)l * 2 + d) * SG + g) * SN + n;
    const float are = a.in[I_ARE][o], aim = a.in[I_AIM][o], dt = expf(a.in[I_LDT][((size_t)l * 2 + d) * SG + g]);
    const float mg = expf((float)ST * are * dt), ph = (float)ST * aim * dt, pr = mg * cosf(ph), pi = mg * sinf(ph);
    const float* SX = (const float*)(a.ws + WS_SX) + (size_t)g * NCOLP * 256 + d * 128 + n;
    bf16_t* UC = (bf16_t*)(a.ws + WS_UCAT) + (size_t)g * NCOLP * KCAT + 512 + d * 128 + n;
    float hr = 0.f, hi = 0.f;
#pragma unroll 1
    for (int st0 = 0; st0 < NCH; st0 += 34) {
        float xr[34], xi[34];
#pragma unroll
        for (int k = 0; k < 34; ++k) { const int st = st0 + k; int c;
            if (d == 0) c = st < 8 ? NCHL + st : st - 8; else c = st < 8 ? NCHL + 7 - st : NCHL - 1 - (st - 8);
            const int col = c * 8 + b; xr[k] = SX[(size_t)col * 256]; xi[k] = SX[(size_t)col * 256 + 64]; }
#pragma unroll
        for (int k = 0; k < 34; ++k) { const int st = st0 + k; int c;
            if (d == 0) c = st < 8 ? NCHL + st : st - 8; else c = st < 8 ? NCHL + 7 - st : NCHL - 1 - (st - 8);
            const int col = c * 8 + b;
            UC[(size_t)col * KCAT] = (bf16_t)f2bf(hr); UC[(size_t)col * KCAT + 64] = (bf16_t)f2bf(hi);
            const float nr = pr * hr - pi * hi + xr[k], ni = pr * hi + pi * hr + xi[k]; hr = nr; hi = ni; }
    }
}

#define DPPX(v, ctrl) __builtin_bit_cast(float, __builtin_amdgcn_update_dpp(0, __builtin_bit_cast(int, (v)), (ctrl), 0xf, 0xf, false))
__device__ __forceinline__ void qk_head_rows(bf16_t* p, const float* gain, const float* rope, int lpos  , int lane, const float osc) {
    const int sub = lane & 7;
    u32x4 w0 = *(const u32x4*)p, w1 = *(const u32x4*)(p + 8);
    float x[16]; { f32x4 a0, a1, b0, b1; unpack8(w0, a0, a1); unpack8(w1, b0, b1);
#pragma unroll
        for (int i = 0; i < 4; ++i) { x[i] = a0[i]; x[4 + i] = a1[i]; x[8 + i] = b0[i]; x[12 + i] = b1[i]; } }
    float ss = 0.f;
#pragma unroll
    for (int i = 0; i < 16; ++i) ss += x[i] * x[i];
    ss += DPPX(ss, 0xB1);
    ss += DPPX(ss, 0x4E);
    ss += DPPX(ss, 0x141);
    const float rstd = osc * __builtin_amdgcn_rsqf(ss * (1.0f / HD) + EPS);
    const f32x4* g4 = (const f32x4*)(gain + sub * 16);
#pragma unroll
    for (int j = 0; j < 4; ++j) { const f32x4 gg = g4[j];
#pragma unroll
        for (int i = 0; i < 4; ++i) x[4 * j + i] = x[4 * j + i] * rstd * gg[i]; }
    float y[16];
    if (lpos >= 0) {
        const int axis = sub >> 2, posi = axis == 0 ? (lpos >> 6) : (lpos & 63), f0 = (sub & 1) * 16;
        const float sgn = (sub & 2) ? 1.0f : -1.0f;
        const f32x4* c4 = (const f32x4*)(rope + posi * 32 + f0); const f32x4* s4 = (const f32x4*)(rope + 2048 + posi * 32 + f0);
#pragma unroll
        for (int j = 0; j < 4; ++j) { const f32x4 cs = c4[j], sn = s4[j];
#pragma unroll
            for (int i = 0; i < 4; ++i) { const float other = DPPX(x[4 * j + i], 0x4E);
                y[4 * j + i] = x[4 * j + i] * cs[i] + sgn * other * sn[i]; } }
    } else {
#pragma unroll
        for (int i = 0; i < 16; ++i) y[i] = x[i];
    }
    f32x4 o0 = {y[0], y[1], y[2], y[3]}, o1 = {y[4], y[5], y[6], y[7]}, o2 = {y[8], y[9], y[10], y[11]}, o3 = {y[12], y[13], y[14], y[15]};
    *(u32x4*)p = pack8(o0, o1); *(u32x4*)(p + 8) = pack8(o2, o3);
}
__device__ __forceinline__ void qk_pass(const Args& a, int l, int gw, int NGW, int lane) {
    bf16_t* Q = (bf16_t*)(a.ws + WS_Q); bf16_t* KB = (bf16_t*)(a.ws + WS_KB); const float* rope = (const float*)(a.ws + WS_ROPE);
    const float* qg = a.in[I_QNG] + (size_t)l * HD; const float* kg = a.in[I_KNG] + (size_t)l * HD;
    (void)Q; (void)qg;
    for (int it = gw; it < NTOK / 4; it += NGW) { const int r = it * 4 + (lane >> 4);
        qk_head_rows(KB + (size_t)kvrow_of(r) * KVW + (lane & 15) * 16, kg, rope, r < NLAT ? (r & 4095) : -1, lane, 1.0f); }
}

__host__ __device__ constexpr int cand_off(int i) { int o = 0; for (int k = 0; k < i; ++k) o += 16 / (k + 1); return o; }
__device__ __forceinline__ void gather_token(const Args& a, int l, int tok, const LAS unsigned* sid, const LAS float* sw, int lane, const bool dry);
__device__ __forceinline__ void peer_topk(const Args& a, int l, LAS unsigned char* lds, int gw, int NGW, int tid, int nrows, const bool dry) {
    const int wave = tid >> 6;
    const bf16_t* keys = (const bf16_t*)(a.ws + WS_KEYS) + (size_t)l * 2 * PKEYS * 128;
    const bf16_t* PQ = (const bf16_t*)(a.ws + WS_GA);
    __syncthreads();
    for (int c = tid; c < 4096; c += 512) { const int p = c >> 11, key = (c >> 4) & 127, cc = c & 15;
        *(LAS u32x4*)(lds + p * 32768 + KSWZ(key, cc * 16)) = *(const u32x4*)(keys + ((size_t)p * PKEYS + key) * 128 + cc * 8); }
    __syncthreads();
    LAS unsigned* xs = (LAS unsigned*)(lds + 65536 + wave * 2048);
    LAS unsigned* sid = (LAS unsigned*)(lds + 81920 + wave * 4096);
    LAS float* sw = (LAS float*)(lds + 81920 + wave * 4096 + 2048);
    const int T = (nrows + NGW - 1) / NGW, tbeg = gw * T, tend = (tbeg + T < nrows) ? tbeg + T : nrows;
#pragma unroll 1
    for (int t0 = tbeg; t0 < tend; t0 += 4) {
        const int ntb = (tend - t0 < 4) ? tend - t0 : 4;
        int lane_ = tid & 63; asm volatile("" : "+v"(lane_));
        const int lane = lane_, r32 = lane & 31, hi = lane >> 5;
        const int rv = (r32 >> 3) < ntb ? r32 : (ntb * 8 - 1);
        const size_t R = (size_t)t0 * 8 + rv;
        float a12[2][16];
#pragma unroll
        for (int p = 0; p < 2; ++p) {
            bf16x8 qv[8];
#pragma unroll
            for (int ds = 0; ds < 8; ++ds) qv[ds] = *(const bf16x8*)(PQ + R * 256 + p * 128 + ds * 16 + hi * 8);
            f32x16 acc[4];
#pragma unroll
            for (int kb = 0; kb < 4; ++kb) acc[kb] = f32x16{};
#pragma unroll
            for (int ds = 0; ds < 8; ++ds)
#pragma unroll
                for (int kb = 0; kb < 4; ++kb) { const bf16x8 ka = *(const LAS bf16x8*)(lds + p * 32768 + KSWZ(kb * 32 + r32, ds * 32 + hi * 16));
                    acc[kb] = __builtin_amdgcn_mfma_f32_32x32x16_bf16(ka, qv[ds], acc[kb], 0, 0, 0); }
            __builtin_amdgcn_sched_barrier(0);
            float top[16]; peer::top16_of_acc(acc, hi, top);
            __builtin_amdgcn_sched_barrier(0);
#pragma unroll
            for (int j = 0; j < 16; ++j) a12[p][j] = peer::vmax(top[j], shflx(top[15 - j], 32, lane));
            peer::bmerge16(a12[p]);
            __builtin_amdgcn_sched_barrier(0);
        }
        float cd[64];
#pragma unroll
        for (int i = 0; i < 16; ++i)
#pragma unroll
            for (int j = 0; j < 16; ++j) if ((i + 1) * (j + 1) <= 16) cd[cand_off(i) + j] = peer::setlow(a12[0][i] + a12[1][j], 0xFFu, (unsigned)(i * 16 + j));
#pragma unroll
        for (int n = 50; n < 64; ++n) cd[n] = -3.0e38f;
        __builtin_amdgcn_sched_barrier(0);
        float best[16], t[16];
#pragma unroll
        for (int blk = 0; blk < 4; ++blk) {
#pragma unroll
            for (int r = 0; r < 16; ++r) { if (blk == 0) best[r] = cd[r]; else t[r] = cd[blk * 16 + r]; }
            if (blk == 0) {   }
            else if (blk < 3) { peer::sort16(t); peer::merge_top16(best, t); }
            else { peer::sort16(t);
#pragma unroll
                for (int i = 0; i < 16; ++i) best[i] = peer::vmax(best[i], t[15 - i]); }
            __builtin_amdgcn_sched_barrier(0);
        }
#pragma unroll
        for (int p = 0; p < 2; ++p)
#pragma unroll
            for (int q = 0; q < 4; ++q) { unsigned w = 0;
#pragma unroll
                for (int e = 0; e < 4; ++e) w |= (__float_as_uint(a12[p][4 * q + e]) & 0x7Fu) << (8 * e);
                xs[(p * 4 + q) * 64 + lane] = w; }
        const float mx = cd[0]; float ex[16], sum = 0.f;
#pragma unroll
        for (int k = 0; k < 16; ++k) { ex[k] = __expf(best[k] - mx); sum += ex[k]; }
        const float inv = __builtin_amdgcn_rcpf(sum);
        unsigned ids[8]; float wts[8]; const unsigned him = 0u - (unsigned)hi;
#pragma unroll
        for (int k = 0; k < 8; ++k) { const float bsel = __uint_as_float((__float_as_uint(best[8 + k]) & him) | (__float_as_uint(best[k]) & ~him)); const float esel = __uint_as_float((__float_as_uint(ex[8 + k]) & him) | (__float_as_uint(ex[k]) & ~him));
            const unsigned code = __float_as_uint(bsel) & 0xFFu, ii = code >> 4, jj = code & 15u;
            const unsigned w1 = xs[(ii >> 2) * 64 + lane], w2 = xs[(4 + (jj >> 2)) * 64 + lane];
            const unsigned i1 = (w1 >> (8 * (ii & 3))) & 0x7Fu, i2 = (w2 >> (8 * (jj & 3))) & 0x7Fu;
            ids[k] = i1 * PKEYS + i2; wts[k] = esel * inv; }
        LAS unsigned* di = sid + r32 * 16 + hi * 8; LAS float* dw = sw + r32 * 16 + hi * 8;
        *(LAS u32x4*)di = (u32x4){ids[0], ids[1], ids[2], ids[3]}; *(LAS u32x4*)(di + 4) = (u32x4){ids[4], ids[5], ids[6], ids[7]};
        *(LAS f32x4*)dw = (f32x4){wts[0], wts[1], wts[2], wts[3]}; *(LAS f32x4*)(dw + 4) = (f32x4){wts[4], wts[5], wts[6], wts[7]};
        asm volatile("s_waitcnt lgkmcnt(0)" ::: "memory");
#pragma unroll 1
        for (int t4 = 0; t4 < ntb; ++t4) gather_token(a, l, t0 + t4, sid + t4 * 128, sw + t4 * 128, lane, dry);
    }
    __syncthreads();
}

typedef float f32x2v __attribute__((ext_vector_type(2)));
typedef float v32f __attribute__((ext_vector_type(32)));
typedef int v6i __attribute__((ext_vector_type(6)));
typedef unsigned u32x3 __attribute__((ext_vector_type(3)));
__device__ __forceinline__ float dpp_sum63(float v) {
#define DPP_ADD(ctrl, rmask) v += __builtin_bit_cast(float, __builtin_amdgcn_update_dpp(0, __builtin_bit_cast(int, v), ctrl, rmask, 0xf, false))
    DPP_ADD(0x111, 0xf); DPP_ADD(0x112, 0xf); DPP_ADD(0x114, 0xf); DPP_ADD(0x118, 0xf);
    DPP_ADD(0x142, 0xa); DPP_ADD(0x143, 0xc);
#undef DPP_ADD
    return v;
}
__device__ __forceinline__ void fp8x16(const u32x4 w, float (&f)[16]) {
#pragma unroll
    for (int j = 0; j < 4; ++j) { const f32x2v lo = __builtin_amdgcn_cvt_pk_f32_fp8((int)w[j], false), hi = __builtin_amdgcn_cvt_pk_f32_fp8((int)w[j], true);
        f[4 * j] = lo[0]; f[4 * j + 1] = lo[1]; f[4 * j + 2] = hi[0]; f[4 * j + 3] = hi[1]; }
}
__device__ __forceinline__ float reduce8(const float (&d)[8], int lane) {
    const bool b0 = lane & 1, b1 = lane & 2, b2 = lane & 4;
    float r1[4], r2[2];
#pragma unroll
    for (int p = 0; p < 4; ++p) { const float t = b0 ? d[2 * p + 1] : d[2 * p], u = b0 ? d[2 * p] : d[2 * p + 1]; r1[p] = t + DPPX(u, 0xB1); }
#pragma unroll
    for (int p = 0; p < 2; ++p) { const float t = b1 ? r1[2 * p + 1] : r1[2 * p], u = b1 ? r1[2 * p] : r1[2 * p + 1]; r2[p] = t + DPPX(u, 0x4E); }
    float r;
    { const float t = b2 ? r2[1] : r2[0], u = b2 ? r2[0] : r2[1];
      int x = __builtin_amdgcn_update_dpp(0, __builtin_bit_cast(int, u), 0x104, 0xf, 0x5, false);
      x = __builtin_amdgcn_update_dpp(x, __builtin_bit_cast(int, u), 0x114, 0xf, 0xa, false);
      r = t + __builtin_bit_cast(float, x); }
    r += DPPX(r, 0x128);
    r += __builtin_bit_cast(float, __builtin_amdgcn_ds_swizzle(__builtin_bit_cast(int, r), 0x401F));
    { auto rr = __builtin_amdgcn_permlane32_swap(__float_as_uint(r), __float_as_uint(r), false, false); r = __uint_as_float(rr[0]) + __uint_as_float(rr[1]); }
    return r;
}
__device__ __forceinline__ void gather_token(const Args& a, int l, int tok, const LAS unsigned* sid, const LAS float* sw, int lane, const bool dry) {
    const bf16_t* XN2 = (const bf16_t*)(a.ws + WS_XN2);
    const unsigned char* PU = a.ws + WS_PU + (size_t)l * PEXP * PROW; const unsigned char* PV = a.ws + WS_PV + (size_t)l * PEXP * PROW;
    const float* SU = (const float*)(a.ws + WS_PSU) + (size_t)l * PEXP; const float* SV = (const float*)(a.ws + WS_PSV) + (size_t)l * PEXP;
    const float* mod = (const float*)(a.ws + WS_MOD) + (size_t)l * 9 * MODW;
    float* hctx = (float*)(a.ws + WS_HCTX);
    {
        float x[16];
        { const u32x4 x0 = *(const u32x4*)(XN2 + (size_t)tok * DM + lane * 16), x1 = *(const u32x4*)(XN2 + (size_t)tok * DM + lane * 16 + 8);
          const f32x4 t4 = *(const f32x4*)((const float*)(a.ws + WS_SSP) + (size_t)tok * 4);
          const float rstd = __builtin_amdgcn_rsqf(((t4[0] + t4[1]) + (t4[2] + t4[3])) * (1.0f / DM) + EPS);
          const float* sh = mod + (size_t)modrow_of(tok) * MODW + 3 * DM + lane * 16;
#pragma unroll
          for (int i = 0; i < 4; ++i) { x[2 * i] = bflo(x0[i]); x[2 * i + 1] = bfhi(x0[i]); x[8 + 2 * i] = bflo(x1[i]); x[8 + 2 * i + 1] = bfhi(x1[i]); }
#pragma unroll
          for (int j = 0; j < 4; ++j) { const f32x4 s4 = *(const f32x4*)(sh + 4 * j);
#pragma unroll
              for (int i = 0; i < 4; ++i) x[4 * j + i] = x[4 * j + i] * rstd + s4[i]; } }
        float out[16];
#pragma unroll
        for (int i = 0; i < 16; ++i) out[i] = 0.f;
#pragma unroll 1
        for (int half = 0; half < 2; ++half) {
            const unsigned id = sid[half * 64 + lane]; const float w = sw[half * 64 + lane];
            const float su = SU[id], sv = SV[id];
            float dotv = 0.f;
#if PEER_FP4
            typedef unsigned u32x2 __attribute__((ext_vector_type(2)));
            u32x2 b0[8], b1[8];
            const unsigned lo8 = (unsigned)lane * 8u;
#define PG_LOAD(dst, TAB, e0) _Pragma("unroll") for (int q = 0; q < 8; ++q) { const unsigned idq = (unsigned)__builtin_amdgcn_readlane((int)id, (e0) + q); dst[q] = *(const u32x2*)(TAB + (idq * 512u + lo8)); }
#define PG_CVT(src, q) const f32x2 f[8] = {__builtin_amdgcn_cvt_scalef32_pk_f32_fp4(src[q][0], 1.0f, 0), __builtin_amdgcn_cvt_scalef32_pk_f32_fp4(src[q][0], 1.0f, 1), __builtin_amdgcn_cvt_scalef32_pk_f32_fp4(src[q][0], 1.0f, 2), __builtin_amdgcn_cvt_scalef32_pk_f32_fp4(src[q][0], 1.0f, 3), \
                __builtin_amdgcn_cvt_scalef32_pk_f32_fp4(src[q][1], 1.0f, 0), __builtin_amdgcn_cvt_scalef32_pk_f32_fp4(src[q][1], 1.0f, 1), __builtin_amdgcn_cvt_scalef32_pk_f32_fp4(src[q][1], 1.0f, 2), __builtin_amdgcn_cvt_scalef32_pk_f32_fp4(src[q][1], 1.0f, 3)};
#define PG_DOT(src, e0) { float d8[8]; _Pragma("unroll") for (int q = 0; q < 8; ++q) { PG_CVT(src, q) f32x2 a0 = {0.f, 0.f}; \
                _Pragma("unroll") for (int i = 0; i < 8; ++i) { const f32x2 xx = {x[2 * i], x[2 * i + 1]}; a0 += f[i] * xx; } d8[q] = a0[0] + a0[1]; } \
                const float tot = reduce8(d8, lane); dotv = ((lane >> 3) == ((e0) >> 3)) ? tot : dotv; }
#define PG_ACC(src, e0) _Pragma("unroll") for (int q = 0; q < 8; ++q) { PG_CVT(src, q) \
                const float c0 = __builtin_bit_cast(float, __builtin_amdgcn_readlane(__builtin_bit_cast(int, coef), (e0) + q)); const f32x2 cc0 = {c0, c0}; \
                _Pragma("unroll") for (int i = 0; i < 8; ++i) { f32x2 o2 = {out[2 * i], out[2 * i + 1]}; o2 += cc0 * f[i]; out[2 * i] = o2[0]; out[2 * i + 1] = o2[1]; } }
#else
            u32x3 b0[8], b1[8];
            const unsigned lo12 = (unsigned)lane * 12u;
#define PG_LOAD(dst, TAB, e0) _Pragma("unroll") for (int q = 0; q < 8; ++q) { const unsigned idq = (unsigned)__builtin_amdgcn_readlane((int)id, (e0) + q); dst[q] = *(const u32x3*)(TAB + (idq * 768u + lo12)); }
#define PG_CVT(src, q) const v6i pk_ = {(int)src[q][0], (int)src[q][1], (int)src[q][2], (int)src[(q) + 1][0], (int)src[(q) + 1][1], (int)src[(q) + 1][2]}; const v32f f = __builtin_amdgcn_cvt_scalef32_pk32_f32_fp6(pk_, 1.0f);
#define F2(i) ((f32x2){f[2 * (i)], f[2 * (i) + 1]})
#define PG_DOT(src, e0) { float d8[8]; _Pragma("unroll") for (int q = 0; q < 8; q += 2) { PG_CVT(src, q) f32x2 a0 = {0.f, 0.f}, a1 = {0.f, 0.f}; \
                _Pragma("unroll") for (int i = 0; i < 8; ++i) { const f32x2 xx = {x[2 * i], x[2 * i + 1]}; a0 += F2(i) * xx; a1 += F2(8 + i) * xx; } d8[q] = a0[0] + a0[1]; d8[q + 1] = a1[0] + a1[1]; } \
                const float tot = reduce8(d8, lane); dotv = ((lane >> 3) == ((e0) >> 3)) ? tot : dotv; }
#define PG_ACC(src, e0) _Pragma("unroll") for (int q = 0; q < 8; q += 2) { PG_CVT(src, q) \
                const float c0 = __builtin_bit_cast(float, __builtin_amdgcn_readlane(__builtin_bit_cast(int, coef), (e0) + q)), c1 = __builtin_bit_cast(float, __builtin_amdgcn_readlane(__builtin_bit_cast(int, coef), (e0) + q + 1)); \
                const f32x2 cc0 = {c0, c0}, cc1 = {c1, c1}; \
                _Pragma("unroll") for (int i = 0; i < 8; ++i) { f32x2 o2 = {out[2 * i], out[2 * i + 1]}; o2 += cc0 * F2(i); o2 += cc1 * F2(8 + i); out[2 * i] = o2[0]; out[2 * i + 1] = o2[1]; } }
#endif
#if PEER_FP4
            u32x2 b2[8];
#else
            u32x3 b2[8];
#endif
#define PG_STEPA(cur, nxt, kb) { const int kl_ = (kb) + 2; if (kl_ < 8) { PG_LOAD(nxt, PU, kl_ * 8) } else { PG_LOAD(nxt, PV, (kl_ - 8) * 8) } PG_DOT(cur, (kb) * 8) }
#define PG_STEPB(cur, nxt, kb) { const int kl_ = (kb) + 2; if (kl_ < 8) { PG_LOAD(nxt, PV, kl_ * 8) } PG_ACC(cur, (kb) * 8) }
            PG_LOAD(b0, PU, 0) PG_LOAD(b1, PU, 8)
#pragma unroll 1
            for (int kb = 0; kb < 6; kb += 3) { PG_STEPA(b0, b2, kb) PG_STEPA(b1, b0, kb + 1) PG_STEPA(b2, b1, kb + 2) }
            PG_STEPA(b0, b2, 6) PG_STEPA(b1, b0, 7)
            const float coef = w * gelu_tanh(dotv * su) * sv;
#pragma unroll 1
            for (int kb = 0; kb < 6; kb += 3) { PG_STEPB(b2, b1, kb) PG_STEPB(b0, b2, kb + 1) PG_STEPB(b1, b0, kb + 2) }
            PG_STEPB(b2, b1, 6) PG_STEPB(b0, b2, 7)
#undef PG_STEPA
#undef PG_STEPB
#undef PG_LOAD
#undef PG_CVT
#undef PG_DOT
#undef PG_ACC
        }
        if (dry) { float sink = 0.f;
#pragma unroll
            for (int i = 0; i < 16; ++i) sink += out[i];
            asm volatile("" :: "v"(sink)); return; }
        float* hr = hrow_m(a.out, hctx, tok) + lane * 16;
        const float* gt = mod + (size_t)modrow_of(tok) * MODW + 5 * DM + lane * 16;
        f32x4 hv[4]; float ss = 0.f;
#pragma unroll
        for (int j = 0; j < 4; ++j) { hv[j] = *(const f32x4*)(hr + 4 * j); const f32x4 g4 = *(const f32x4*)(gt + 4 * j);
#pragma unroll
            for (int i = 0; i < 4; ++i) hv[j][i] += g4[i] * out[4 * j + i];
            *(f32x4*)(hr + 4 * j) = hv[j];
            ss += (hv[j][0] * hv[j][0] + hv[j][1] * hv[j][1]) + (hv[j][2] * hv[j][2] + hv[j][3] * hv[j][3]); }
        if (l + 1 < DEPTH) {
            ss = wave_sum(ss, lane);
            const float rstd = __builtin_amdgcn_rsqf(ss * (1.0f / DM) + EPS);
            const float* g = a.in[I_NMG] + (size_t)(l + 1) * DM + lane * 16; const float* mr = mod + 9 * MODW + (size_t)modrow_of(tok) * MODW + lane * 16;
            bf16_t* orow = (bf16_t*)(a.ws + WS_XN) + (size_t)tok * DM + lane * 16;
            f32x4 o[4];
#pragma unroll
            for (int j = 0; j < 4; ++j) { const f32x4 gg = *(const f32x4*)(g + 4 * j), s1 = *(const f32x4*)(mr + DM + 4 * j), s0 = *(const f32x4*)(mr + 4 * j);
                o[j] = hv[j] * rstd * gg * (1.0f + s1) + s0; }
            *(u32x4*)orow = pack8(o[0], o[1]); *(u32x4*)(orow + 8) = pack8(o[2], o[3]);
        }
    }
}

constexpr int NPH_LAYER = 10, NPHASE = 2 + NPH_LAYER * DEPTH;
__global__ void __launch_bounds__(512, 2) mega_fwd(Args a_in) {
    extern __shared__ __attribute__((aligned(16))) unsigned char lds_[];
    LAS unsigned char* lds = (LAS unsigned char*)lds_;
    const int bx = blockIdx.x, G = gridDim.x, NGW = G * 8;
#define PHASE_IDS const int lane = lane_id_now(), wave = wave_s, tid = wave_s * 64 + lane, gw = bx * 8 + wave; (void)lane; (void)gw; (void)tid; \
    const __attribute__((address_space(4))) Args* ap_ = (const __attribute__((address_space(4))) Args*)__builtin_amdgcn_kernarg_segment_ptr(); asm volatile("" : "+s"(ap_)); const Args& a = *(const Args*)ap_; \
    unsigned char* ws = a.ws; (void)ws;
    const int wave_s = __builtin_amdgcn_readfirstlane(threadIdx.x >> 6);
    volatile LAS unsigned* MISC = (volatile LAS unsigned*)(lds + MISC_OFF);
    if (threadIdx.x < 32) MISC[threadIdx.x] = 0u;
    __syncthreads();
    unsigned* ctl = (unsigned*)(a_in.ws + WS_CTL);
    XcdBarrier bar; bar.bar = ctl + CW_BAR; bar.x = 0; bar.st = MISC + 8;
    if (!MK_MULTI) bar = xcd_barrier_post(ctl + CW_BAR, MISC + 8);
    int lo = a_in.ph_lo, hi = a_in.ph_hi;
#define IN(k) (lo <= (k) && (k) < hi)
#define SEAM(k) do { if (!MK_MULTI && IN(k) && IN((k) + 1)) xcd_barrier(bar, wave_s == 0 && lane_id_now() == 0); } while (0)
#define XN ((bf16_t*)(ws + WS_XN))
#define XN2 ((bf16_t*)(ws + WS_XN2))
#define Qb ((bf16_t*)(ws + WS_Q))
#define KB ((bf16_t*)(ws + WS_KB))
#define VB ((bf16_t*)(ws + WS_VB))
#define UCAT ((bf16_t*)(ws + WS_UCAT))
#define GA ((bf16_t*)(ws + WS_GA))
#define GBb ((bf16_t*)(ws + WS_GB))
#define YG ((bf16_t*)(ws + WS_YG))
#define SSMO ((bf16_t*)(ws + WS_SSMO))
#define Y XN
#define PQ GA
#define hctx ((float*)(ws + WS_HCTX))
#define wl (ws + WS_WT + (size_t)l * WT_LAYER)
#define mod ((const float*)(ws + WS_MOD) + (size_t)l * 9 * MODW)

    if (DG(0) && IN(0)) REPS(0) { PHASE_IDS p0a(a, lds, bx, G, tid); }
    SEAM(0);
    if (DG(1) && IN(1)) { PHASE_IDS pq_bias(a, lds, bx, G, tid); norm_pass(a, 0, 0, XN, gw, NGW, lane, NTOK, a.in[I_X]); }
    SEAM(1);

    for (int l = 0; l < DEPTH; ++l) {
        const int pb = 2 + NPH_LAYER * l;
        asm volatile("" : "+s"(lo), "+s"(hi));
        const int MR = (l + 1 < DEPTH) ? NTOK : NLAT;
        if (DG(2) && IN(pb + 0)) REPS(2) { PHASE_IDS
            ssm_tables(a, l, lds, bx, G, tid);
            pg8::Gemm g{XN, (const bf16_t*)(wl + WT_IN)}; pg8::SplitOrder S; S.init(NTOK, INW, G, bx);
            pg8::EpiIn E{ws};
            pg8::gemm_phase<DM, DM, DM, 0, 0>(lds, g, S, E, tid);
        }
        SEAM(pb + 0);
        if (DG(3) && IN(pb + 1)) REPS(3) { PHASE_IDS
            qk_pass(a, l, gw, NGW, lane);
            __syncthreads();
            pg8::Gemm g{UCAT, (const bf16_t*)(ws + WS_WSTATE)}; pg8::BatchOrder S; S.init(NCOLP / 256, 1, SG, G, (G % 8 == 0) ? (bx % 8) * (G / 8) + bx / 8 : bx);
            pg8::EpiSX E{(float*)(ws + WS_SX)};
            pg8::gemm_phase<512, KCAT, 512, (size_t)NCOLP * KCAT * 2, (size_t)256 * 512 * 2>(lds, g, S, E, tid);
        }
        SEAM(pb + 1);
        if (DG(4) && IN(pb + 2)) REPS(4) { PHASE_IDS
            float nm0;
            { float gq = fmaxf(fabsf(a.in[I_QNG][(size_t)l * HD + lane]), fabsf(a.in[I_QNG][(size_t)l * HD + 64 + lane])), gk = fmaxf(fabsf(a.in[I_KNG][(size_t)l * HD + lane]), fabsf(a.in[I_KNG][(size_t)l * HD + 64 + lane]));
#pragma unroll
              for (int o = 1; o < 64; o <<= 1) { gq = fmaxf(gq, shflx(gq, o, lane)); gk = fmaxf(gk, shflx(gk, o, lane)); }
              nm0 = -(float)HD * gq * gk * att::SCALE * 1.4426950408889634f * 1.01f; }
            for (int vb = G - 1 - bx; vb < 64; vb += G) ssm_carry(a, l, vb, tid);
            __syncthreads();
            const int x8 = bx & 7, j32 = bx >> 3;
            const int nlat = (G == 256) ? 4 : (bx < NB * NQH * 16 ? (NB * NQH * 16 - 1 - bx) / G + 1 : 0);
            const int nctx = (l + 1 < DEPTH && bx < NB * NQH) ? (NB * NQH - 1 - bx) / G + 1 : 0;
#pragma unroll 1
            for (int i = 0; i < nlat + nctx; ++i) {
                size_t qoff, koff; int seq, lpos0;
                if (i < nlat) {
                    int b, h, qb;
                    if (G == 256) { const int combo = x8 + 8 * (i >> 1), un = (i & 1) * 32 + j32; b = combo >> 1; h = (combo & 1) * 4 + (un >> 4); qb = un & 15; }
                    else { const int u = bx + i * G; b = u >> 7; h = (u >> 4) & 7; qb = u & 15; }
                    qoff = ((size_t)b * SEQ + qb * 256) * DM + h * HD; koff = (size_t)b * KVLEN * KVW + (h >> 2) * HD; seq = KVLEN; lpos0 = qb * 256;
                } else {
                    const int u = bx + (i - nlat) * G, b = u >> 3, h = u & 7;
                    qoff = ((size_t)NLAT + b * CTXL) * DM + h * HD; koff = ((size_t)b * KVLEN + SEQ) * KVW + (h >> 2) * HD; seq = CTXL; lpos0 = -1;
                }
                att::attn_dense_body_dma(Qb + qoff, KB + koff, seq, (char*)lds_, lds, wave_s * 64 + lane_id_now(), (PROBE_PHASE == 4 && rep_ + 1 < PROBE_REPS) ? (long)WS_YG - (long)WS_Q : 0L, nm0,
                                         a.in[I_QNG] + (size_t)l * HD, (const float*)(ws + WS_ROPE), lpos0);
            }
        }
        SEAM(pb + 2);
        if (DG(5) && IN(pb + 3)) REPS(5) { PHASE_IDS
            pg8::Gemm g{UCAT, (const bf16_t*)(ws + WS_WCAT)}; pg8::BatchOrder S; S.init(l + 1 < DEPTH ? NCOLP / 256 : NCOLP / 256 - 1, 2, SG, G, (G % 8 == 0) ? (bx % 8) * (G / 8) + bx / 8 : bx, l + 1 < DEPTH ? NCOLP / 256 - 1 : -1);
            pg8::EpiS3 E{UCAT, a.in[I_SD] + (size_t)l * SSMW, YG};
            pg8::gemm_phase<KCAT, KCAT, KCAT, (size_t)NCOLP * KCAT * 2, (size_t)512 * KCAT * 2>(lds, g, S, E, tid);
        }
        SEAM(pb + 3);
        if (DG(6) && IN(pb + 4)) REPS(6) { PHASE_IDS
            pg8::Gemm g{YG, (const bf16_t*)(wl + WT_GLU)}; pg8::SplitOrder S; S.init(MR, SSMW, G, bx);
            pg8::EpiGlu E{YG, a.in[I_BGLU] + (size_t)l * SSMW, SSMO};
            pg8::gemm_phase<SSMW, SSMW, SSMW, 0, 0>(lds, g, S, E, tid);
        }
        SEAM(pb + 4);
        if (DG(7) && IN(pb + 5)) REPS(7) { PHASE_IDS
            pg8::SplitOrder S; S.init(MR, DM, G, bx);
            { pg8::Gemm g{Qb, (const bf16_t*)(wl + WT_BA)}; pg8::EpiMerge<false> E{GA, Y}; pg8::gemm_phase<DM, DM, DM, 0, 0>(lds, g, S, E, tid); }
            { pg8::Gemm g{SSMO, (const bf16_t*)(wl + WT_BS)}; pg8::EpiMerge<true> E{GBb, Y}; pg8::gemm_phase<SSMW, SSMW, SSMW, 0, 0>(lds, g, S, E, tid); }
        }
        SEAM(pb + 5);
        if (DG(8) && IN(pb + 6)) REPS(8) { PHASE_IDS
            pg8::Gemm g{Y, (const bf16_t*)(wl + WT_O)}; pg8::SplitOrder S; S.init(MR, DM, G, bx);
            pg8::EpiWo E{l == 0 ? a.in[I_X] : (const float*)a.out, a.out, hctx, mod, a.in[I_NFG] + (size_t)l * DM, XN2, (float*)(ws + WS_SSP), (LAS float*)(lds + MISC_OFF + 256)};
            pg8::gemm_phase<DM, DM, DM, 0, 0>(lds, g, S, E, tid);
        }
        SEAM(pb + 6);
        if (DG(10) && IN(pb + 8)) REPS(10) { PHASE_IDS
            pg8::Gemm g{XN2, (const bf16_t*)(wl + WT_Q)}; pg8::SplitOrder S; S.init(MR, PQW, G, bx);
            pg8::EpiPQ E{PQ, (const float*)(ws + WS_SSP), (const float*)(ws + WS_PQB) + (size_t)l * 9 * PQW};
            pg8::gemm_phase<DM, DM, DM, 0, 0>(lds, g, S, E, tid);
        }
        SEAM(pb + 8);
        if (DG(11) && IN(pb + 9)) REPS(11) { PHASE_IDS peer_topk(a, l, lds, gw, NGW, tid, MR, PROBE_PHASE == 11 && rep_ + 1 < PROBE_REPS); }
        SEAM(pb + 9);
    }
#undef IN
#undef SEAM
}

extern "C" void kernel_launch(void* const* d_in, const int* in_sizes, int n_in, void* d_out, int out_size, void* d_ws, size_t ws_size, hipStream_t stream) {
    static int grid = 0;
    if (grid == 0) {
        if (n_in != 28 || out_size != NLAT * DM || ws_size < WS_END) { fprintf(stderr, "kernel_launch: unexpected shapes (n_in %d out %d ws %zu, need ws >= %zu)\n", n_in, out_size, ws_size, (size_t)WS_END); grid = -1; return; }
        int dev = 0, cus = 0;
        if (hipGetDevice(&dev) != hipSuccess || hipDeviceGetAttribute(&cus, hipDeviceAttributeMultiprocessorCount, dev) != hipSuccess) { grid = -1; return; }
        if (hipFuncSetAttribute((const void*)mega_fwd, hipFuncAttributeMaxDynamicSharedMemorySize, LDS_BYTES) != hipSuccess) { fprintf(stderr, "kernel_launch: hipFuncSetAttribute failed\n"); grid = -1; return; }
        int per_cu = 0;
        if (hipOccupancyMaxActiveBlocksPerMultiprocessor(&per_cu, (const void*)mega_fwd, 512, LDS_BYTES) != hipSuccess || per_cu < 1) fprintf(stderr, "kernel_launch: occupancy query reports %d\n", per_cu);
        (void)hipGetLastError();
        grid = cus;
    }
    if (grid < 0) return;
    (void)hipMemsetAsync((char*)d_ws + WS_CTL, 0, CTL_ZERO_BYTES, stream);
    Args a{};
    for (int i = 0; i < 28; ++i) a.in[i] = (const float*)d_in[i];
    a.out = (float*)d_out; a.ws = (unsigned char*)d_ws;
#if MK_MULTI
    for (int p = 0; p < NPHASE; ++p) { a.ph_lo = p; a.ph_hi = p + 1; hipLaunchKernelGGL(mega_fwd, dim3(grid), dim3(512), LDS_BYTES, stream, a); }
#else
    a.ph_lo = 0; a.ph_hi = NPHASE;
    hipLaunchKernelGGL(mega_fwd, dim3(grid), dim3(512), LDS_BYTES, stream, a);
#endif
    const hipError_t le = hipPeekAtLastError();
    if (le != hipSuccess) fprintf(stderr, "kernel_launch: launch failed: %s\n", hipGetErrorName(le));
}
```

```cpp
#include <hip/hip_runtime.h>
#include <cstdio>
#include <cstdint>

#define GAS __attribute__((address_space(1)))
#define LAS __attribute__((address_space(3)))
typedef unsigned short bf16_t;
typedef short bf16x8 __attribute__((ext_vector_type(8)));
typedef short s16x4 __attribute__((ext_vector_type(4)));
typedef float f32x2 __attribute__((ext_vector_type(2)));
typedef float f32x4 __attribute__((ext_vector_type(4)));
typedef float f32x16 __attribute__((ext_vector_type(16)));
typedef unsigned u32x2 __attribute__((ext_vector_type(2)));
typedef unsigned u32x4 __attribute__((ext_vector_type(4)));

#ifndef MK_MULTI
#define MK_MULTI 0
#endif
#ifndef DIAG_MASK
#define DIAG_MASK 0xFFFF
#endif
#define DG(k) ((DIAG_MASK >> (k)) & 1)
#ifndef PEER_FP4
#define PEER_FP4 1
#endif
#ifndef PROBE_PHASE
#define PROBE_PHASE -1
#endif
#ifndef PROBE_REPS
#define PROBE_REPS 1
#endif
#define REPS(k) _Pragma("unroll 1") for (int rep_ = 0; rep_ < ((PROBE_PHASE == (k)) ? PROBE_REPS : 1); ++rep_)
#ifndef EN_ATTN
#define EN_ATTN 1
#endif
#ifndef EN_SSM
#define EN_SSM 1
#endif
#ifndef EN_PEER
#define EN_PEER 1
#endif

constexpr int DM = 1024, NB = 8, SEQ = 4096, DEPTH = 4, CTXL = 256;
constexpr int NLAT = NB * SEQ, NCTX = NB * CTXL, NTOK = NLAT + NCTX;
constexpr int HD = 128, NQH = 8, NKVH = 2, KVW = NKVH * HD, KVLEN = SEQ + CTXL;
constexpr int SSMW = 512, SG = 32, SP = 16, SN = 64, ST = 32;
constexpr int NCH = KVLEN / ST, NCHL = SEQ / ST, NCOL = NB * NCH, NCOLP = 1280, KCAT = 768;
constexpr int INW = 4096, NMOD = 6, MODW = NMOD * DM;
constexpr int PH = 8, PKEYS = 128, PEXP = PKEYS * PKEYS, PQW = 2048, PTOPK = 16;
constexpr float EPS = 1e-6f;

constexpr size_t MiB = 1u << 20;
constexpr size_t WS_CTL = 0, CTL_ZERO_BYTES = 64 * 1024;
constexpr size_t WS_MOD = 1 * MiB;
constexpr size_t WS_ROPE = 2 * MiB;
constexpr size_t WS_KEYS = 3 * MiB;
constexpr size_t WS_HCTX = 4 * MiB;
constexpr size_t WS_WT = 12 * MiB;
constexpr size_t WT_IN = 0, WT_BA = 8 * MiB, WT_BS = 10 * MiB, WT_O = 11 * MiB, WT_GLU = 13 * MiB, WT_Q = 13 * MiB + 512 * 1024, WT_LAYER = 17 * MiB + 512 * 1024;
constexpr size_t WS_WCAT = 82 * MiB;
constexpr size_t WS_WSTATE = 106 * MiB;
constexpr size_t WS_UCAT = 114 * MiB;
constexpr size_t WS_SX = 174 * MiB;
constexpr size_t WS_XN = 214 * MiB;
constexpr size_t WS_XN2 = 282 * MiB;
constexpr size_t WS_Q = 350 * MiB;
constexpr size_t WS_KB = 418 * MiB, WS_VB = 435 * MiB;
constexpr size_t WS_GA = 452 * MiB, WS_GB = 520 * MiB;
constexpr size_t WS_YG = 588 * MiB, WS_SSMO = 622 * MiB;
constexpr size_t WS_K8 = 656 * MiB;
constexpr size_t WS_PU = 690 * MiB, WS_PV = 754 * MiB;
constexpr int PROW = PEER_FP4 ? 512 : 768;
constexpr float QMAX = PEER_FP4 ? 6.0f : 7.5f;
constexpr size_t WS_PSU = 818 * MiB, WS_PSV = 819 * MiB;
constexpr size_t WS_END = 820 * MiB;
constexpr int CW_BAR = 1024;

constexpr int RING_BYTES = 131072;
constexpr int MISC_OFF = RING_BYTES;
constexpr int LDS_BYTES = 147456;

__device__ __forceinline__ unsigned f2bf(float f) { unsigned u = __builtin_bit_cast(unsigned, f); return (u + 0x7fffu + ((u >> 16) & 1u)) >> 16; }
__device__ __forceinline__ unsigned pk2(float lo, float hi) { return f2bf(lo) | (f2bf(hi) << 16); }
__device__ __forceinline__ unsigned cvt_pk_bf16(float lo, float hi) { unsigned r; asm volatile("v_cvt_pk_bf16_f32 %0, %1, %2" : "=v"(r) : "v"(lo), "v"(hi)); return r; }
__device__ __forceinline__ float bflo(unsigned w) { return __builtin_bit_cast(float, w << 16); }
__device__ __forceinline__ float bfhi(unsigned w) { return __builtin_bit_cast(float, w & 0xffff0000u); }
__device__ __forceinline__ int lane_id_now() { int l_; asm volatile("v_mbcnt_lo_u32_b32 %0, -1, 0\n\tv_mbcnt_hi_u32_b32 %0, -1, %0" : "=v"(l_)); return l_; }
__device__ __forceinline__ float shflx(float v, int o, int lane) { return __builtin_bit_cast(float, __builtin_amdgcn_ds_bpermute((lane ^ o) << 2, __builtin_bit_cast(int, v))); }
__device__ __forceinline__ float wave_sum(float v, int lane) {
#pragma unroll
    for (int o = 1; o < 64; o <<= 1) v += shflx(v, o, lane);
    return v;
}
__device__ __forceinline__ float sigmoidf_(float x) { return __builtin_amdgcn_rcpf(1.0f + __builtin_amdgcn_exp2f(-1.4426950408889634f * x)); }
__device__ __forceinline__ float gelu_tanh(float x) {
    const float z = 0.7978845608028654f * (x + 0.044715f * x * x * x);
    const float t = 1.0f - 2.0f * __builtin_amdgcn_rcpf(__builtin_amdgcn_exp2f(2.0f * 1.4426950408889634f * z) + 1.0f);
    return 0.5f * x * (1.0f + t);
}
__device__ __forceinline__ u32x4 pack8(const f32x4 a, const f32x4 b) {
    u32x4 w; w.x = cvt_pk_bf16(a[0], a[1]); w.y = cvt_pk_bf16(a[2], a[3]); w.z = cvt_pk_bf16(b[0], b[1]); w.w = cvt_pk_bf16(b[2], b[3]); return w;
}
__device__ __forceinline__ void unpack8(const u32x4 w, f32x4& a, f32x4& b) {
    a[0] = bflo(w.x); a[1] = bfhi(w.x); a[2] = bflo(w.y); a[3] = bfhi(w.y); b[0] = bflo(w.z); b[1] = bfhi(w.z); b[2] = bflo(w.w); b[3] = bfhi(w.w);
}
__device__ __forceinline__ int modrow_of(int r) { return r < NLAT ? (r >> 12) : NB; }
__device__ __forceinline__ int kvrow_of(int r) { if (r < NLAT) return (r >> 12) * KVLEN + (r & 4095); const int q = r - NLAT; return (q >> 8) * KVLEN + SEQ + (q & 255); }

#define XB_TMO      128
#define XB_XCNT(j)  (256  + 64 * (j))
#define XB_XSUB(j)  (1280 + 64 * (j))
#define XB_XGEN(j)  (2304 + 64 * (j))
#define XB_TOP      3328
#define XB_TOPGEN   3392
#define XCD_BAR_WORDS 3456
#define XB_SPIN_CAP (1u << 18)
__device__ __forceinline__ unsigned xb_ld(unsigned* p)              { return __hip_atomic_load(p, __ATOMIC_RELAXED, __HIP_MEMORY_SCOPE_AGENT); }
__device__ __forceinline__ unsigned xb_add(unsigned* p, unsigned v) { return __hip_atomic_fetch_add(p, v, __ATOMIC_RELAXED, __HIP_MEMORY_SCOPE_AGENT); }
__device__ __forceinline__ unsigned xb_xcc_id() { return (unsigned)__builtin_amdgcn_s_getreg((3 << 11) | 20) & 0xFu; }
#define XB_SPIN(cond, bar) do { unsigned _sp = 0; while (cond) { __builtin_amdgcn_s_sleep(1); \
    if ((++_sp & 255u) == 0u) { if (xb_ld(&(bar)[XB_TMO])) break; if (_sp > XB_SPIN_CAP) { atomicAdd(&(bar)[XB_TMO], 1u); break; } } } } while (0)
struct XcdBarrier { unsigned* bar; unsigned x; volatile LAS unsigned* st; };
__device__ __forceinline__ XcdBarrier xcd_barrier_post(unsigned* bar, volatile LAS unsigned* st) {
    XcdBarrier b; b.bar = bar; b.x = xb_xcc_id(); b.st = st;
    if (threadIdx.x == 0) (void)xb_add(&bar[XB_XCNT(b.x)], 1u);
    return b;
}
__device__ __forceinline__ void xcd_barrier_complete(unsigned* bar, unsigned x, unsigned& nloc, unsigned& nx) {
    const unsigned G = gridDim.x * gridDim.y * gridDim.z;
    unsigned sum, cnt, mine, sp = 0u;
    for (;;) {
        sum = 0u; cnt = 0u; mine = 0u;
#pragma unroll
        for (unsigned j = 0; j < 16; ++j) { const unsigned c = xb_ld(&bar[XB_XCNT(j)]); sum += c; cnt += (c > 0u) ? 1u : 0u; mine = (j == x) ? c : mine; }
        if (sum == G) break;
        __builtin_amdgcn_s_sleep(1);
        if ((++sp & 255u) == 0u) { if (xb_ld(&bar[XB_TMO])) break; if (sp > XB_SPIN_CAP) { atomicAdd(&bar[XB_TMO], 1u); break; } }
    }
    nloc = mine > 0u ? mine : 1u; nx = cnt > 0u ? cnt : 1u;
}
__device__ __forceinline__ void xcd_barrier(const XcdBarrier& b, const bool t0  ) {
    asm volatile("s_waitcnt vmcnt(0)" ::: "memory");
    __syncthreads();
    if (t0) {
        unsigned* bar = b.bar;
        __builtin_amdgcn_s_waitcnt(0);
        unsigned nloc = b.st[0], nx = b.st[1];
        if (nloc == 0u) { unsigned x_ = b.x; asm volatile("" : "+s"(x_));
            xcd_barrier_complete(bar, x_, nloc, nx); b.st[0] = nloc; b.st[1] = nx; }
        const unsigned old = xb_add(&bar[XB_XSUB(b.x)], 1u);
        const unsigned gen = old / nloc;
        if (old + 1u == (gen + 1u) * nloc) {
            __builtin_amdgcn_fence(__ATOMIC_RELEASE, "agent");
            asm volatile("s_waitcnt vmcnt(0)" ::: "memory");
            const unsigned og = xb_add(&bar[XB_TOP], 1u);
            const unsigned tg = og / nx;
            if (og + 1u == (tg + 1u) * nx) xb_add(&bar[XB_TOPGEN], 1u);
            else XB_SPIN(xb_ld(&bar[XB_TOPGEN]) == tg, bar);
            __builtin_amdgcn_fence(__ATOMIC_ACQUIRE, "agent");
            xb_add(&bar[XB_XGEN(b.x)], 1u);
            asm volatile("s_waitcnt vmcnt(0)" ::: "memory");
        } else {
            XB_SPIN(xb_ld(&bar[XB_XGEN(b.x)]) == gen, bar);
            __builtin_amdgcn_fence(__ATOMIC_ACQUIRE, "agent");
            asm volatile("s_waitcnt vmcnt(0)" ::: "memory");
        }
    }
    __syncthreads();
}

namespace pg8 {
constexpr int BM = 256, BK = 64, HALF = 128, HTB = HALF * BK * 2, STAGE_BYTES = 8 * HTB, NXCD = 8, WGM = 8;
__host__ __device__ __forceinline__ int lds_byte(int r, int c) { const int st = (r >> 4) * 2 + (c >> 5), rr = r & 15, cc = c & 31, ob = rr * 64 + cc * 2; return st * 1024 + (ob ^ (((ob >> 9) & 1) << 5)); }
__host__ __device__ __forceinline__ void stage_rc(int b, int& R, int& C) { const int st = b / 1024, sb = b % 1024, swz = sb ^ (((sb >> 9) & 1) << 5); R = (st >> 1) * 16 + swz / 64; C = (st & 1) * 32 + (swz % 64) / 2; }
__host__ __device__ __forceinline__ int perm32(int rho) { const int n = rho >> 4, i = rho & 15; return 8 * (i >> 2) + 4 * n + (i & 3); }

struct Unit { int pm, pn, pb, hm; };
struct Gemm { const bf16_t* A; const bf16_t* Bt; };

struct StaticOrder {
    int nM, nN, nwg, G, c;
    __device__ void init(int M, int N, int G_, int c_) { nM = M / BM; nN = N / BM; nwg = nM * nN; G = G_; c = c_; }
    __device__ void map(int wgid, int& pm, int& pn) const {
        { const int q = nwg / NXCD, r = nwg % NXCD, xcd = wgid % NXCD, off = wgid / NXCD; wgid = (xcd < r ? xcd * (q + 1) : r * (q + 1) + (xcd - r) * q) + off; }
        const int nig = WGM * nN, gid = wgid / nig, fm = gid * WGM, gsz = (nM - fm) < WGM ? (nM - fm) : WGM;
        pm = fm + ((wgid % nig) % gsz); pn = (wgid % nig) / gsz;
    }
    __device__ bool next(int i, Unit& u) const {
        const long L = (long)i * G + c; if (L >= nwg) return false;
        int pm, pn; map((int)L, pm, pn); u.pm = pm; u.pn = pn; u.pb = 0; u.hm = -1; return true;
    }
};
struct SplitOrder {
    StaticOrder lat; int nN, nLat, nH, G, c;
    __device__ void init(int M, int N, int G_, int c_) { lat.init(NLAT, N, G_, c_); nN = N / BM; nLat = lat.nwg; nH = M > NLAT ? ((M - NLAT) / HALF) * nN : 0; G = G_; c = c_; }
    __device__ bool next(int i, Unit& u) const {
        const long L = (long)i * G + c; if (L >= (long)nLat + nH) return false;
        const bool isl = L < nLat;
        int pmL, pnL; lat.map(isl ? (int)L : 0, pmL, pnL);
        const int h = isl ? 0 : (int)(L - nLat);
        const int per = 2 * nN, hu = (nH % NXCD == 0) ? (h % NXCD) * (nH / NXCD) + h / NXCD : h, t = hu / per, j = hu - t * per;
        u.pm = isl ? pmL : NLAT / BM + t; u.pn = isl ? pnL : (j >> 1); u.pb = 0; u.hm = isl ? -1 : (j & 1); return true;
    }
};
struct BatchOrder {
    int nM, nN, nb, G, c, tailM;
    __device__ void init(int nM_, int nN_, int nb_, int G_, int c_, int tailM_ = -1) { nM = nM_; nN = nN_; nb = nb_; G = G_; c = c_; tailM = tailM_; }
    __device__ bool next(int i, Unit& u) const {
        const long L = (long)i * G + c; if (L >= (long)nM * nN * nb) return false;
        const int nMf = tailM >= 0 ? nM - 1 : nM, per = nMf * nN, nfull = per * nb, l = (int)L; const bool full = l < nfull;
        const int lf = full ? l : 0, pbF = lf / per, rF = lf - pbF * per, pnF = rF / nMf, pmF = rF - pnF * nMf;
        const int rT = full ? 0 : l - nfull, pbT = rT / nN, pnT = rT - pbT * nN;
        u.pb = full ? pbF : pbT; u.pn = full ? pnF : pnT; u.pm = full ? pmF : tailM; u.hm = full ? -1 : 0; return true;
    }
};

template <int K, int LDA, int LDB, size_t SA, size_t SB, class Epi, class Sched>
__device__ __forceinline__ void gemm_phase(LAS unsigned char* lds, const Gemm g, const Sched& S, const Epi& E, const int tid) {
    static_assert(Epi::PERM, "all epilogues here use the permuted column map");
    const int wid = __builtin_amdgcn_readfirstlane(tid >> 6), lane = tid & 63, wr = wid >> 2, wc = wid & 3, fr = lane & 15, fq = lane >> 4;
    constexpr int nt = K / BK;
    unsigned voffA[2], voffB[2];
#pragma unroll
    for (int i = 0; i < 2; ++i) { int R, C; stage_rc(tid * 16 + i * 8192, R, C); const int Rb = (R & ~31) + perm32(R & 31);
        voffA[i] = (unsigned)(R * LDA + C) * 2u; voffB[i] = (unsigned)(Rb * LDB + C) * 2u; }
    constexpr size_t kstep = (size_t)(BK * 2);
    constexpr size_t hstepA = (size_t)HALF * LDA * 2, hstepB = (size_t)HALF * LDB * 2;
    constexpr size_t tstepA = 2 * hstepA, tstepB = 2 * hstepB;
    const unsigned ldsw = (unsigned)wid * 1024u;
    const int aoff = lds_byte(wr * 64 + fr, fq * 8), boff = lds_byte(wc * 32 + fr, fq * 8);
#define PG8_SA(b, h) (((b) * 2 + (h)) * HTB)
#define PG8_SB(b, h) ((4 + (b) * 2 + (h)) * HTB)
#define PG8_STAGE(bufoff, gbase, voff) do { _Pragma("unroll") for (int _i = 0; _i < 2; ++_i) \
        __builtin_amdgcn_global_load_lds((const unsigned*)((const char*)(gbase) + (voff)[_i]), (LAS unsigned*)(lds + (bufoff) + ldsw + _i * 8192), 16, 0, 0); } while (0)
#define PG8_LDA(dst, b, h) do { _Pragma("unroll") for (int m = 0; m < 4; ++m) _Pragma("unroll") for (int k = 0; k < 2; ++k) dst[m][k] = *(const LAS bf16x8*)(lds + PG8_SA(b, h) + aoff + m * 2048 + k * 1024); } while (0)
#define PG8_LDB(dst, b, h) do { _Pragma("unroll") for (int n = 0; n < 2; ++n) _Pragma("unroll") for (int k = 0; k < 2; ++k) dst[n][k] = *(const LAS bf16x8*)(lds + PG8_SB(b, h) + boff + n * 2048 + k * 1024); } while (0)
#define PG8_MMA(ai, bj, At, Bt) do { __builtin_amdgcn_s_setprio(1); _Pragma("unroll") for (int m = 0; m < 4; ++m) _Pragma("unroll") for (int n = 0; n < 2; ++n) _Pragma("unroll") for (int k = 0; k < 2; ++k) \
        acc[ai][bj][m][n] = __builtin_amdgcn_mfma_f32_16x16x32_bf16(Bt[n][k], At[m][k], acc[ai][bj][m][n], 0, 0, 0); __builtin_amdgcn_s_setprio(0); } while (0)
#define PG8_WAIT_V(n) asm volatile("s_waitcnt vmcnt(" #n ")" ::: "memory")
#define PG8_WAIT_L(n) asm volatile("s_waitcnt lgkmcnt(" #n ")" ::: "memory")
#define PG8_BAR __builtin_amdgcn_s_barrier()
#define PG8_SCHED __builtin_amdgcn_sched_barrier(0)
    Unit cur, nxt; int ui = 0;
    if (!S.next(0, cur)) return;
    f32x4 acc[2][2][4][2];
#pragma unroll
    for (int a = 0; a < 2; ++a)
#pragma unroll
        for (int b = 0; b < 2; ++b)
#pragma unroll
            for (int m = 0; m < 4; ++m)
#pragma unroll
                for (int n = 0; n < 2; ++n) acc[a][b][m][n] = (f32x4){0.f, 0.f, 0.f, 0.f};
    bf16x8 At[4][2], B0[2][2], B1[2][2];
    const char* cA = (const char*)g.A + (size_t)cur.pb * SA + (size_t)cur.pm * tstepA + (cur.hm > 0 ? hstepA : (size_t)0); const char* cB = (const char*)g.Bt + (size_t)cur.pb * SB + (size_t)cur.pn * tstepB;
    unsigned cH = cur.hm < 0 ? (unsigned)hstepA : 0u;
    PG8_STAGE(PG8_SB(0, 0), cB, voffB); PG8_STAGE(PG8_SB(0, 1), cB + hstepB, voffB); PG8_STAGE(PG8_SA(0, 0), cA, voffA); PG8_STAGE(PG8_SA(0, 1), cA + cH, voffA);
    if (wr == 1) PG8_BAR;
    PG8_WAIT_V(2); PG8_BAR;
    PG8_STAGE(PG8_SB(1, 0), cB + kstep, voffB); PG8_STAGE(PG8_SA(1, 0), cA + kstep, voffA); PG8_STAGE(PG8_SB(1, 1), cB + hstepB + kstep, voffB);
    PG8_WAIT_V(6); PG8_BAR;
    for (;;) {
        const bool has_next = S.next(ui + 1, nxt);
        const char* nA = has_next ? (const char*)g.A + (size_t)nxt.pb * SA + (size_t)nxt.pm * tstepA + (nxt.hm > 0 ? hstepA : (size_t)0) : cA; const char* nB = has_next ? (const char*)g.Bt + (size_t)nxt.pb * SB + (size_t)nxt.pn * tstepB : cB;
        const unsigned nH = has_next ? (nxt.hm < 0 ? (unsigned)hstepA : 0u) : cH;
        const bool whole = cur.hm < 0;
        for (int t = 0; t < nt; t += 2) {
            const bool last = (t == nt - 2);
            const char* a1 = cA + (size_t)(t + 1) * kstep;
            const char* a2 = last ? nA : cA + (size_t)(t + 2) * kstep; const char* b2 = last ? nB : cB + (size_t)(t + 2) * kstep; const unsigned h2 = last ? nH : cH;
            const char* a3 = a2 + kstep; const char* b3 = b2 + kstep;
            PG8_LDB(B0, 0, 0); PG8_LDB(B1, 0, 1); PG8_SCHED; PG8_LDA(At, 0, 0); PG8_STAGE(PG8_SA(1, 1), a1 + cH, voffA);
            PG8_WAIT_V(8); PG8_WAIT_L(0); PG8_BAR; PG8_MMA(0, 0, At, B0); PG8_MMA(0, 1, At, B1); PG8_BAR; PG8_SCHED;
            PG8_LDA(At, 0, 1); PG8_STAGE(PG8_SB(0, 0), b2, voffB); PG8_STAGE(PG8_SB(0, 1), b2 + hstepB, voffB); PG8_STAGE(PG8_SA(0, 0), a2, voffA);
            PG8_WAIT_V(8); PG8_WAIT_L(0); PG8_BAR; if (whole) { PG8_MMA(1, 0, At, B0); PG8_MMA(1, 1, At, B1); } PG8_BAR; PG8_SCHED;
            PG8_LDB(B0, 1, 0); PG8_LDB(B1, 1, 1); PG8_SCHED; PG8_LDA(At, 1, 0); PG8_STAGE(PG8_SA(0, 1), a2 + h2, voffA);
            PG8_WAIT_V(8); PG8_WAIT_L(0); PG8_BAR; PG8_MMA(0, 0, At, B0); PG8_MMA(0, 1, At, B1); PG8_BAR; PG8_SCHED;
            PG8_LDA(At, 1, 1); PG8_STAGE(PG8_SB(1, 0), b3, voffB); PG8_STAGE(PG8_SB(1, 1), b3 + hstepB, voffB); PG8_STAGE(PG8_SA(1, 0), a3, voffA);
            PG8_WAIT_V(8); PG8_WAIT_L(0); PG8_BAR; if (whole) { PG8_MMA(1, 0, At, B0); PG8_MMA(1, 1, At, B1); } PG8_BAR; PG8_SCHED;
        }
        if (wr == 0) PG8_BAR;
        E(acc, cur, wr, wc, fr, fq);
        if (!has_next) break;
#pragma unroll
        for (int a = 0; a < 2; ++a)
#pragma unroll
            for (int b = 0; b < 2; ++b)
#pragma unroll
                for (int m = 0; m < 4; ++m)
#pragma unroll
                    for (int n = 0; n < 2; ++n) acc[a][b][m][n] = (f32x4){0.f, 0.f, 0.f, 0.f};
        cur = nxt; cA = nA; cB = nB; cH = nH; ++ui;
        if (wr == 1) PG8_BAR;
    }
    PG8_WAIT_V(0);
    PG8_BAR;
#undef PG8_SA
#undef PG8_SB
#undef PG8_STAGE
#undef PG8_LDA
#undef PG8_LDB
#undef PG8_MMA
#undef PG8_WAIT_V
#undef PG8_WAIT_L
#undef PG8_BAR
#undef PG8_SCHED
}

#define EPI_ON (uhm_ < 0 || ai == uhm_)
#define EPI_ACC(k_) ((ai == 1 && uhm_ >= 0) ? acc[0][bj][m][k_] : acc[ai][bj][m][k_])
#define EPI_FOR _Pragma("unroll") for (int ai = 0; ai < 2; ++ai) if (EPI_ON) _Pragma("unroll") for (int m = 0; m < 4; ++m) _Pragma("unroll") for (int bj = 0; bj < 2; ++bj)
#define EPI_COORDS const int ln_ = lane_id_now(), wr = wr_, wc = wc_, fr = ln_ & 15, fq = ln_ >> 4, uhm_ = u.hm;
#define EPI_V const f32x4 v0 = EPI_ACC(0), v1 = EPI_ACC(1);

struct EpiIn {
    static constexpr bool PERM = true;
    unsigned char* ws;
    __device__ __forceinline__ void operator()(const f32x4 (&acc)[2][2][4][2], const Unit& u, int wr_, int wc_, int fr_, int fq_) const {
        EPI_COORDS
        const int pn = u.pn, r0 = u.pm * BM, rl = wr * 64 + fr, cl0 = wc * 32 + 8 * fq;
        size_t boff; long sA, sM1, sM0, sB;
        if (pn == 4 || pn == 5) {
            int kv0; if (r0 < NLAT) kv0 = (r0 >> 12) * KVLEN + (r0 & 4095); else kv0 = ((r0 - NLAT) >> 8) * KVLEN + SEQ;
            boff = WS_KB + (size_t)(pn - 4) * (WS_VB - WS_KB) + ((size_t)(kv0 + rl) * KVW + cl0) * 2; sA = 128 * KVW; sM1 = 32 * KVW; sM0 = 16 * KVW; sB = 128;
        } else if (pn == 6 || pn == 7) {
            int col0; if (r0 < NLAT) col0 = ((r0 & 4095) >> 5) * 8 + (r0 >> 12); else col0 = NCHL * 8 + ((r0 - NLAT) >> 8);
            boff = WS_UCAT + ((size_t)(((pn - 6) * 16 + wc * 2 + (fq >> 1)) * NCOLP + col0 + wr * 16) * KCAT + fr * SP + (fq & 1) * 8) * 2;
            sA = (long)32 * KCAT; sM1 = (long)8 * KCAT; sM0 = 16 * SP; sB = (long)8 * NCOLP * KCAT;
        } else {
            const int grp = pn < 4 ? 0 : (pn < 12 ? 1 : 2), pc = pn - (grp == 0 ? 0 : (grp == 1 ? 8 : 12));
            const size_t tb = WS_Q + (size_t)grp * (WS_GA - WS_Q) - (grp == 2 ? (size_t)((WS_GA - WS_Q) - (WS_GB - WS_GA)) : 0);
            boff = tb + ((size_t)(r0 + rl) * DM + pc * 256 + cl0) * 2; sA = 128 * DM; sM1 = 32 * DM; sM0 = 16 * DM; sB = 128;
        }
        bf16_t* base = (bf16_t*)(ws + boff);
        EPI_FOR { EPI_V *(u32x4*)(base + ai * sA + (m >> 1) * sM1 + (m & 1) * sM0 + bj * sB) = pack8(v0, v1); }
    }
};
struct EpiBf16 {
    static constexpr bool PERM = true;
    bf16_t* O; int ldc;
    __device__ __forceinline__ void operator()(const f32x4 (&acc)[2][2][4][2], const Unit& u, int wr_, int wc_, int fr_, int fq_) const {
        EPI_COORDS
        bf16_t* base = O + (size_t)(u.pm * BM + wr * 64 + fr) * ldc + u.pn * BM + wc * 32 + 8 * fq; const long sR = (long)16 * ldc;
        EPI_FOR { EPI_V *(u32x4*)(base + (ai * 8 + m) * sR + bj * 128) = pack8(v0, v1); }
    }
};
struct EpiSX {
    static constexpr bool PERM = true;
    float* SX;
    __device__ __forceinline__ void operator()(const f32x4 (&acc)[2][2][4][2], const Unit& u, int wr_, int wc_, int fr_, int fq_) const {
        EPI_COORDS
        float* base = SX + ((size_t)(u.pb * NCOLP + u.pm * BM + wr * 64 + fr) * 256 + wc * 32 + 8 * fq);
        const bool tail = (u.pm == 4);
        EPI_FOR { EPI_V if (!tail || (ai == 0 && wr == 0)) { float* d = base + (ai * 8 + m) * (16 * 256) + bj * 128; *(f32x4*)d = v0; *(f32x4*)(d + 4) = v1; } }
    }
};
#define EPI_GROUPS _Pragma("unroll") for (int ai = 0; ai < 2; ++ai) if (EPI_ON) _Pragma("unroll") for (int mh = 0; mh < 2; ++mh)
#define EPI_IN_GROUP _Pragma("unroll") for (int e_ = 0; e_ < 4; ++e_)
#define EPI_GIDX const int m = 2 * mh + (e_ >> 1), bj = e_ & 1; (void)m; (void)bj;
struct EpiS3 {
    static constexpr bool PERM = true;
    const bf16_t* UCAT; const float* dsk; bf16_t* YG;
    __device__ __forceinline__ void operator()(const f32x4 (&acc)[2][2][4][2], const Unit& u, int wr_, int wc_, int fr_, int fq_) const {
        EPI_COORDS
        const int gg = u.pb, b = fr & 7, p0 = (fq & 1) * 8, tl = u.pn * 16 + wc * 2 + (fq >> 1);
        const bool tail = (u.pm == 4);
        const int tok0 = tail ? NLAT + b * CTXL + (fr >> 3) * ST + tl : b * SEQ + (u.pm * 32 + wr * 8 + (fr >> 3)) * ST + tl;
        const bf16_t* ub = UCAT + ((size_t)(gg * NCOLP + u.pm * BM + wr * 64 + fr) * KCAT + tl * SP + p0);
        bf16_t* yb = YG + (size_t)tok0 * SSMW + gg * SP + p0;
        const f32x4 d0 = *(const f32x4*)(dsk + gg * SP + p0), d1 = *(const f32x4*)(dsk + gg * SP + p0 + 4);
        EPI_GROUPS { if (!tail || (ai == 0 && wr == 0)) {
            u32x4 uw[4];
            EPI_IN_GROUP { EPI_GIDX uw[e_] = *(const u32x4*)(ub + (size_t)(ai * 128 + m * 16) * KCAT + bj * 8 * SP); }
            EPI_IN_GROUP { EPI_GIDX const f32x4 v0 = EPI_ACC(0), v1 = EPI_ACC(1);
                f32x4 u0, u1; unpack8(uw[e_], u0, u1);
                f32x4 y0 = v0 + d0 * u0, y1 = v1 + d1 * u1;
#pragma unroll
                for (int i = 0; i < 4; ++i) { y0[i] = gelu_tanh(y0[i]); y1[i] = gelu_tanh(y1[i]); }
                *(u32x4*)(yb + (size_t)((ai * 16 + m * 2) * ST + bj * 8) * SSMW) = pack8(y0, y1); } } }
    }
};
struct EpiGlu {
    static constexpr bool PERM = true;
    const bf16_t* YG; const float* bias; bf16_t* O;
    __device__ __forceinline__ void operator()(const f32x4 (&acc)[2][2][4][2], const Unit& u, int wr_, int wc_, int fr_, int fq_) const {
        EPI_COORDS
        const int c0 = u.pn * BM + wc * 32 + 8 * fq; const size_t off = (size_t)(u.pm * BM + wr * 64 + fr) * SSMW + c0;
        f32x4 bb[2][2];
#pragma unroll
        for (int bj = 0; bj < 2; ++bj) { bb[bj][0] = *(const f32x4*)(bias + c0 + bj * 128); bb[bj][1] = *(const f32x4*)(bias + c0 + bj * 128 + 4); }
        EPI_GROUPS {
            u32x4 yw[4];
            EPI_IN_GROUP { EPI_GIDX yw[e_] = *(const u32x4*)(YG + off + (size_t)(ai * 128 + m * 16) * SSMW + bj * 128); }
            EPI_IN_GROUP { EPI_GIDX const f32x4 v0 = EPI_ACC(0), v1 = EPI_ACC(1);
                f32x4 y0, y1; unpack8(yw[e_], y0, y1);
                f32x4 o0, o1;
#pragma unroll
                for (int i = 0; i < 4; ++i) { o0[i] = y0[i] * sigmoidf_(v0[i] + bb[bj][0][i]); o1[i] = y1[i] * sigmoidf_(v1[i] + bb[bj][1][i]); }
                *(u32x4*)(O + off + (size_t)(ai * 128 + m * 16) * SSMW + bj * 128) = pack8(o0, o1); } }
    }
};
template <bool ADD> struct EpiMerge {
    static constexpr bool PERM = true;
    const bf16_t* G; bf16_t* Y;
    __device__ __forceinline__ void operator()(const f32x4 (&acc)[2][2][4][2], const Unit& u, int wr_, int wc_, int fr_, int fq_) const {
        EPI_COORDS
        const size_t off = (size_t)(u.pm * BM + wr * 64 + fr) * DM + u.pn * BM + wc * 32 + 8 * fq;
        EPI_GROUPS {
            u32x4 gw[4], yw[4];
            EPI_IN_GROUP { EPI_GIDX const size_t o = off + (size_t)(ai * 128 + m * 16) * DM + bj * 128; gw[e_] = *(const u32x4*)(G + o); if (ADD) yw[e_] = *(const u32x4*)(Y + o); }
            EPI_IN_GROUP { EPI_GIDX const size_t o = off + (size_t)(ai * 128 + m * 16) * DM + bj * 128; const f32x4 v0 = EPI_ACC(0), v1 = EPI_ACC(1);
                f32x4 g0, g1; unpack8(gw[e_], g0, g1);
                f32x4 o0, o1;
#pragma unroll
                for (int i = 0; i < 4; ++i) { o0[i] = sigmoidf_(g0[i]) * v0[i]; o1[i] = sigmoidf_(g1[i]) * v1[i]; }
                if (ADD) { f32x4 y0, y1; unpack8(yw[e_], y0, y1); o0 += y0; o1 += y1; }
                *(u32x4*)(Y + o) = pack8(o0, o1); } }
    }
};
struct EpiWo {
    static constexpr bool PERM = true;
    const float* hsrc; float* hlat; float* hctx; const float* gate;
    __device__ __forceinline__ void operator()(const f32x4 (&acc)[2][2][4][2], const Unit& u, int wr_, int wc_, int fr_, int fq_) const {
        EPI_COORDS
        const int r0 = u.pm * BM, c0 = u.pn * BM + wc * 32 + 8 * fq;
        const size_t roff = (size_t)(wr * 64 + fr) * DM + c0;
        const float* sb = (r0 < NLAT ? hsrc + (size_t)r0 * DM : hctx + (size_t)(r0 - NLAT) * DM) + roff;
        float* hb = (r0 < NLAT ? hlat + (size_t)r0 * DM : hctx + (size_t)(r0 - NLAT) * DM) + roff;
        const float* gr = gate + (size_t)(r0 < NLAT ? (r0 >> 12) : NB) * MODW + c0;
        f32x4 gg[2][2];
#pragma unroll
        for (int bj = 0; bj < 2; ++bj) { gg[bj][0] = *(const f32x4*)(gr + bj * 128); gg[bj][1] = *(const f32x4*)(gr + bj * 128 + 4); }
        EPI_GROUPS {
            f32x4 h0[4], h1[4];
            EPI_IN_GROUP { EPI_GIDX const size_t o = (size_t)(ai * 128 + m * 16) * DM + bj * 128; h0[e_] = *(const f32x4*)(sb + o); h1[e_] = *(const f32x4*)(sb + o + 4); }
            EPI_IN_GROUP { EPI_GIDX const size_t o = (size_t)(ai * 128 + m * 16) * DM + bj * 128; const f32x4 v0 = EPI_ACC(0), v1 = EPI_ACC(1);
                *(f32x4*)(hb + o) = h0[e_] + gg[bj][0] * v0; *(f32x4*)(hb + o + 4) = h1[e_] + gg[bj][1] * v1; } }
    }
};
#undef EPI_GROUPS
#undef EPI_IN_GROUP
#undef EPI_GIDX
}

namespace att {
constexpr int D = 128, NW = 8, QBLK = 32, KVBLK = 64;
constexpr float SCALE = 0.088388347648318440f;
constexpr float THR = 8.f;
#ifndef ATT_SDEPTH
#define ATT_SDEPTH 1
#endif
constexpr int SDEPTH = ATT_SDEPTH;
constexpr int LDQ = DM, LDK = KVW, LDO = DM;
constexpr size_t SHM_V = KVBLK * D * 2, SHM_K = KVBLK * D * 2, SHM_ATTN = 2 * SHM_V + 2 * SHM_K + NW * 64 * 4;
#define KSWZ(row, colB) ((row) * 256 + ((colB) ^ (((row) & 7) << 4)))
#define SBAR() __builtin_amdgcn_sched_barrier(0)
__device__ __forceinline__ int crow(int r, int hi) { return (r & 3) + 8 * (r >> 2) + 4 * hi; }
__device__ __forceinline__ unsigned cvtpk(float lo, float hi) { unsigned r; asm volatile("v_cvt_pk_bf16_f32 %0, %1, %2" : "=v"(r) : "v"(lo), "v"(hi)); return r; }
__device__ __forceinline__ void partialSM(f32x16& p0) {
  for (int r = 0; r < 16; ++r) p0[r] = __builtin_amdgcn_exp2f(p0[r]);
}
__device__ __forceinline__ void finishSM(f32x16& p0, f32x16& p1, float& l_reg, bf16x8& pa0, bf16x8& pa1, bf16x8& pa2, bf16x8& pa3) {
  for (int r = 0; r < 16; ++r) p1[r] = __builtin_amdgcn_exp2f(p1[r]);
  float ps = 0; for (int r = 0; r < 16; ++r) ps += p0[r]; for (int r = 0; r < 16; ++r) ps += p1[r];
  l_reg += ps;
#define PK4(P, BASE, OUT) do { unsigned a0 = cvtpk(P[BASE + 0], P[BASE + 1]), a1 = cvtpk(P[BASE + 2], P[BASE + 3]);   \
    unsigned b0 = cvtpk(P[BASE + 4], P[BASE + 5]), b1 = cvtpk(P[BASE + 6], P[BASE + 7]);                              \
    auto r0 = __builtin_amdgcn_permlane32_swap(a0, b0, false, false); auto r1 = __builtin_amdgcn_permlane32_swap(a1, b1, false, false); \
    u32x4 w = {r0[0], r1[0], r0[1], r1[1]}; OUT = *reinterpret_cast<bf16x8*>(&w); } while (0)
  PK4(p0, 0, pa0); PK4(p0, 8, pa1); PK4(p1, 0, pa2); PK4(p1, 8, pa3);
#undef PK4
}
__device__ __forceinline__ void qkt(f32x16& p0, f32x16& p1, const bf16_t* Ks, const bf16x8* qr, int r32, int hi, float nm0) {
#pragma unroll
  for (int r = 0; r < 16; ++r) { p0[r] = nm0; p1[r] = nm0; }
  const char* kb0 = (const char*)Ks + r32 * 256; const char* kb1 = kb0 + 32 * 256; const int swz = (r32 & 7) << 4;
#define KFRAG(base, d0) (*reinterpret_cast<const bf16x8*>((base) + ((((d0) * 32) + hi * 16) ^ swz)))
  bf16x8 fa0 = KFRAG(kb0, 0), fa1 = KFRAG(kb1, 0), fb0 = KFRAG(kb0, 1), fb1 = KFRAG(kb1, 1);
#pragma unroll
  for (int d0 = 0; d0 < 8; d0 += 2) {
    bf16x8 na0 = fa0, na1 = fa1, nb0 = fb0, nb1 = fb1;
    if (d0 + 2 < 8) { na0 = KFRAG(kb0, d0 + 2); na1 = KFRAG(kb1, d0 + 2); }
    p0 = __builtin_amdgcn_mfma_f32_32x32x16_bf16(fa0, qr[d0], p0, 0, 0, 0);
    p1 = __builtin_amdgcn_mfma_f32_32x32x16_bf16(fa1, qr[d0], p1, 0, 0, 0);
    __builtin_amdgcn_sched_group_barrier(0x100, 2, 0); __builtin_amdgcn_sched_group_barrier(0x008, 2, 0);
    if (d0 + 3 < 8) { nb0 = KFRAG(kb0, d0 + 3); nb1 = KFRAG(kb1, d0 + 3); }
    p0 = __builtin_amdgcn_mfma_f32_32x32x16_bf16(fb0, qr[d0 + 1], p0, 0, 0, 0);
    p1 = __builtin_amdgcn_mfma_f32_32x32x16_bf16(fb1, qr[d0 + 1], p1, 0, 0, 0);
    __builtin_amdgcn_sched_group_barrier(0x100, 2, 0); __builtin_amdgcn_sched_group_barrier(0x008, 2, 0);
    fa0 = na0; fa1 = na1; fb0 = nb0; fb1 = nb1;
  }
#undef KFRAG
}
typedef int v8i __attribute__((ext_vector_type(8)));
__device__ __forceinline__ void qkt8(f32x16& p0, f32x16& p1, const char* Ks, const v8i* q8, int r32, int hi, float nm0) {
#pragma unroll
  for (int r = 0; r < 16; ++r) { p0[r] = nm0; p1[r] = nm0; }
  const int sw = (r32 >> 1) & 7;
  const char* k0 = Ks + r32 * 128; const char* k1 = k0 + 32 * 128;
#define K8FRAG(base, ks) ({ const u32x4 lo_ = *reinterpret_cast<const u32x4*>((base) + ((((ks) * 4 + hi * 2) ^ sw) << 4)), hi_ = *reinterpret_cast<const u32x4*>((base) + ((((ks) * 4 + hi * 2 + 1) ^ sw) << 4)); \
    (v8i){(int)lo_.x, (int)lo_.y, (int)lo_.z, (int)lo_.w, (int)hi_.x, (int)hi_.y, (int)hi_.z, (int)hi_.w}; })
  const v8i a00 = K8FRAG(k0, 0), a10 = K8FRAG(k1, 0), a01 = K8FRAG(k0, 1), a11 = K8FRAG(k1, 1);
  p0 = __builtin_amdgcn_mfma_scale_f32_32x32x64_f8f6f4(a00, q8[0], p0, 0, 0, 0, 0x7F7F7F7F, 0, 0x7F7F7F7F);
  p1 = __builtin_amdgcn_mfma_scale_f32_32x32x64_f8f6f4(a10, q8[0], p1, 0, 0, 0, 0x7F7F7F7F, 0, 0x7F7F7F7F);
  p0 = __builtin_amdgcn_mfma_scale_f32_32x32x64_f8f6f4(a01, q8[1], p0, 0, 0, 0, 0x7F7F7F7F, 0, 0x7F7F7F7F);
  p1 = __builtin_amdgcn_mfma_scale_f32_32x32x64_f8f6f4(a11, q8[1], p1, 0, 0, 0, 0x7F7F7F7F, 0, 0x7F7F7F7F);
#undef K8FRAG
}
__device__ __forceinline__ int v_st(int k, int c) { const int kk = (k & ~0xC) | ((k & 4) << 1) | ((k & 8) >> 1); return ((kk >> 3) * 4 + (c >> 5)) * 512 + ((kk & 7) * 32 + (c & 31)) * 2; }
__device__ __forceinline__ int v_rd_base(int lane) { return ((lane & 3) << 3) | (((lane >> 2) & 3) << 6) | (((lane >> 4) & 1) << 5) | (((lane >> 5) & 1) << 8); }
constexpr int v_rd_off(int d0, int ks, int half) { return d0 * 512 + ks * 4096 + half * 2048; }
template <int OFF> __device__ __forceinline__ s16x4 tr_read(int vb) {
  s16x4 r; asm volatile("ds_read_b64_tr_b16 %0, %1 offset:%2" : "=&v"(r) : "v"(vb), "i"(OFF) : "memory"); return r;
}
template <int D0> __device__ __forceinline__ void pv_one(f32x16& od, int vb, bf16x8 pa0, bf16x8 pa1, bf16x8 pa2, bf16x8 pa3) {
  const s16x4 l0 = tr_read<v_rd_off(D0, 0, 0)>(vb), h0 = tr_read<v_rd_off(D0, 0, 1)>(vb), l1 = tr_read<v_rd_off(D0, 1, 0)>(vb), h1 = tr_read<v_rd_off(D0, 1, 1)>(vb);
  const s16x4 l2 = tr_read<v_rd_off(D0, 2, 0)>(vb), h2 = tr_read<v_rd_off(D0, 2, 1)>(vb), l3 = tr_read<v_rd_off(D0, 3, 0)>(vb), h3 = tr_read<v_rd_off(D0, 3, 1)>(vb);
  asm volatile("s_waitcnt lgkmcnt(0)" ::: "memory"); SBAR();
#define PK(L, H) (bf16x8){L[0], L[1], L[2], L[3], H[0], H[1], H[2], H[3]}
  od = __builtin_amdgcn_mfma_f32_32x32x16_bf16(pa0, PK(l0, h0), od, 0, 0, 0);
  od = __builtin_amdgcn_mfma_f32_32x32x16_bf16(pa1, PK(l1, h1), od, 0, 0, 0);
  od = __builtin_amdgcn_mfma_f32_32x32x16_bf16(pa2, PK(l2, h2), od, 0, 0, 0);
  od = __builtin_amdgcn_mfma_f32_32x32x16_bf16(pa3, PK(l3, h3), od, 0, 0, 0);
#undef PK
}
__device__ __forceinline__ void pv_d0(f32x16* o, int vb, bf16x8 pa0, bf16x8 pa1, bf16x8 pa2, bf16x8 pa3) {
  pv_one<0>(o[0], vb, pa0, pa1, pa2, pa3); pv_one<1>(o[1], vb, pa0, pa1, pa2, pa3); pv_one<2>(o[2], vb, pa0, pa1, pa2, pa3); pv_one<3>(o[3], vb, pa0, pa1, pa2, pa3);
}
__device__ __forceinline__ void attn_dense_body(bf16_t* Qb, const bf16_t* Kh, int seq, char* lds, const int tid, const long odelta, const float nm0) {
  const bf16_t* Vh = (const bf16_t*)((const char*)Kh + (WS_VB - WS_KB)); bf16_t* Ob = (bf16_t*)((char*)Qb + odelta);
  const int wid = tid >> 6, lane = tid & 63, r32 = lane & 31, hi = lane >> 5;
  bf16_t* V_lds = (bf16_t*)lds; bf16_t* K_lds = (bf16_t*)(lds + 2 * SHM_V);
  float* ws = (float*)(lds + 2 * SHM_V + 2 * SHM_K) + wid * 64; float* li_l = ws;
  float l_reg = 0; f32x16 o[4] = {}; bf16x8 qr[8];
  const bf16_t* Qw = Qb + (long)(wid * QBLK + r32) * LDQ + hi * 8;
#pragma unroll
  for (int d0 = 0; d0 < 8; ++d0) qr[d0] = *reinterpret_cast<const bf16x8*>(Qw + d0 * 16);
  const int sr = tid >> 4, sc = (tid & 15) * 8, vst0 = v_st(sr, sc), vst1 = v_st(32 + sr, sc);
  const int vb0 = (int)(uintptr_t)V_lds + v_rd_base(lane);
  struct { bf16x8 vs0, vs1, ks0, ks1; } sr_[SDEPTH];
#define LD8(p) (*reinterpret_cast<const bf16x8*>(p))
#define SLOAD(i, k0) do { sr_[i].vs0 = LD8(&Vh[(long)((k0) + sr) * LDK + sc]); sr_[i].vs1 = LD8(&Vh[(long)((k0) + 32 + sr) * LDK + sc]); \
    sr_[i].ks0 = LD8(&Kh[(long)((k0) + sr) * LDK + sc]); sr_[i].ks1 = LD8(&Kh[(long)((k0) + 32 + sr) * LDK + sc]); } while (0)
#define SWRITE(b, i) do { *(bf16x8*)((char*)V_lds + (b) * SHM_V + vst0) = sr_[i].vs0;          \
    *(bf16x8*)((char*)V_lds + (b) * SHM_V + vst1) = sr_[i].vs1; int kc = sc * 2;               \
    *(bf16x8*)((char*)K_lds + (b) * SHM_K + KSWZ(sr, kc)) = sr_[i].ks0;                       \
    *(bf16x8*)((char*)K_lds + (b) * SHM_K + KSWZ(32 + sr, kc)) = sr_[i].ks1; } while (0)
#define SWAIT() do { if constexpr (SDEPTH == 2) asm volatile("s_waitcnt vmcnt(4)" ::: "memory"); else asm volatile("s_waitcnt vmcnt(0)" ::: "memory"); } while (0)
  f32x16 pA0, pA1, pB0, pB1; bf16x8 pa0, pa1, pa2, pa3; const int NT = seq / KVBLK;
  constexpr int SE = 0, SO = SDEPTH - 1;
  SLOAD(SE, 0); asm volatile("s_waitcnt vmcnt(0)" ::: "memory"); SWRITE(0, SE); __syncthreads();
  qkt(pA0, pA1, K_lds, qr, r32, hi, nm0); partialSM(pA0);
  SLOAD(SO, KVBLK); if constexpr (SDEPTH == 2) { if (2 < NT) SLOAD(SE, 2 * KVBLK); }
  SWAIT(); SWRITE(1, SO); __syncthreads();
  for (int j = 1; j + 1 < NT; j += 2) {
    SBAR(); qkt(pB0, pB1, (bf16_t*)((char*)K_lds + SHM_K), qr, r32, hi, nm0);
    finishSM(pA0, pA1, l_reg, pa0, pa1, pa2, pa3); SBAR();
    SLOAD(SO, (j + SDEPTH) * KVBLK); SBAR();
    pv_d0(o, vb0, pa0, pa1, pa2, pa3); partialSM(pB0);
    __syncthreads(); SWAIT(); SWRITE(0, SE);
    __syncthreads();
    SBAR(); qkt(pA0, pA1, K_lds, qr, r32, hi, nm0);
    finishSM(pB0, pB1, l_reg, pa0, pa1, pa2, pa3); SBAR();
    if (SDEPTH == 1 || j + 3 < NT) SLOAD(SE, (j + 1 + SDEPTH) * KVBLK); SBAR();
    pv_d0(o, vb0 + (int)SHM_V, pa0, pa1, pa2, pa3); partialSM(pA0);
    __syncthreads(); SWAIT(); SWRITE(1, SO);
    __syncthreads();
  }
  SBAR(); qkt(pB0, pB1, (bf16_t*)((char*)K_lds + SHM_K), qr, r32, hi, nm0);
  finishSM(pA0, pA1, l_reg, pa0, pa1, pa2, pa3); SBAR();
  pv_d0(o, vb0, pa0, pa1, pa2, pa3); partialSM(pB0);
  __syncthreads();
  finishSM(pB0, pB1, l_reg, pa0, pa1, pa2, pa3); SBAR();
  pv_d0(o, vb0 + (int)SHM_V, pa0, pa1, pa2, pa3);
  { auto rr = __builtin_amdgcn_permlane32_swap(__float_as_uint(l_reg), __float_as_uint(l_reg), false, false); l_reg = __uint_as_float(rr[0]) + __uint_as_float(rr[1]); }
  if (hi == 0) li_l[r32] = l_reg; asm volatile("s_waitcnt lgkmcnt(0)" ::: "memory");
  float rli[16];
#pragma unroll
  for (int r = 0; r < 16; ++r) rli[r] = __builtin_amdgcn_rcpf(li_l[crow(r, hi)]);
  bf16_t* Ow = Ob + (long)(wid * QBLK) * LDO;
#pragma unroll
  for (int r = 0; r < 16; ++r) { int orow = crow(r, hi);
    for (int d0 = 0; d0 < 4; ++d0) Ow[(long)orow * LDO + d0 * 32 + r32] = (bf16_t)f2bf(o[d0][r] * rli[r]); }
  __syncthreads();
#undef LD8
#undef SLOAD
#undef SWRITE
#undef SWAIT
}
constexpr int SLOT = 32768;
__device__ __forceinline__ void attn_dense_body_dma(bf16_t* Qb, const bf16_t* Kh, int seq, char* lds, LAS unsigned char* ldsl, const int tid, const long odelta, const float nm0,
                                                    const float* qgain, const float* rope, const int lpos0, const unsigned char* K8h  ) {
  const bf16_t* Vh = (const bf16_t*)((const char*)Kh + (WS_VB - WS_KB)); bf16_t* Ob = (bf16_t*)((char*)Qb + odelta);
  const int wid = __builtin_amdgcn_readfirstlane(tid >> 6), lane = tid & 63, r32 = lane & 31, hi = lane >> 5;
  float* li_l = (float*)(lds + 3 * SLOT) + wid * 64;
  float l_reg = 0; f32x16 o[4] = {}; v8i q8[2];
  { const bf16_t* Qw = Qb + (long)(wid * QBLK + r32) * LDQ + hi * 16;
    f32x4 x[2][2][4]; float ss = 0.f;
#pragma unroll
    for (int ks = 0; ks < 2; ++ks)
#pragma unroll
      for (int t = 0; t < 2; ++t) { const u32x4 w0 = *reinterpret_cast<const u32x4*>(Qw + ks * 64 + t * 32), w1 = *reinterpret_cast<const u32x4*>(Qw + ks * 64 + t * 32 + 8);
        unpack8(w0, x[ks][t][0], x[ks][t][1]); unpack8(w1, x[ks][t][2], x[ks][t][3]);
#pragma unroll
        for (int j = 0; j < 4; ++j)
#pragma unroll
          for (int i = 0; i < 4; ++i) ss += x[ks][t][j][i] * x[ks][t][j][i]; }
    { auto rr = __builtin_amdgcn_permlane32_swap(__float_as_uint(ss), __float_as_uint(ss), false, false); ss = __uint_as_float(rr[0]) + __uint_as_float(rr[1]); }
    const float rstd = (SCALE * 1.4426950408889634f) * __builtin_amdgcn_rsqf(ss * (1.0f / D) + EPS);
#pragma unroll
    for (int ks = 0; ks < 2; ++ks)
#pragma unroll
      for (int t = 0; t < 2; ++t)
#pragma unroll
        for (int j = 0; j < 4; ++j) x[ks][t][j] = x[ks][t][j] * rstd * *(const f32x4*)(qgain + ks * 64 + t * 32 + hi * 16 + 4 * j);
    if (lpos0 >= 0) { const int lpos = lpos0 + wid * QBLK + r32;
#pragma unroll
      for (int ks = 0; ks < 2; ++ks) { const int posi = ks == 0 ? (lpos >> 6) : (lpos & 63); const float* cp = rope + posi * 32 + hi * 16;
#pragma unroll
        for (int j = 0; j < 4; ++j) { const f32x4 cs = *(const f32x4*)(cp + 4 * j), sn = *(const f32x4*)(cp + 2048 + 4 * j); const f32x4 x1 = x[ks][0][j], x2 = x[ks][1][j];
          x[ks][0][j] = x1 * cs - x2 * sn; x[ks][1][j] = x1 * sn + x2 * cs; } } }
#pragma unroll
    for (int ks = 0; ks < 2; ++ks)
#pragma unroll
      for (int t = 0; t < 2; ++t)
#pragma unroll
        for (int j = 0; j < 4; ++j) { int v = 0; v = __builtin_amdgcn_cvt_pk_fp8_f32(x[ks][t][j][0], x[ks][t][j][1], v, false); v = __builtin_amdgcn_cvt_pk_fp8_f32(x[ks][t][j][2], x[ks][t][j][3], v, true); q8[ks][t * 4 + j] = v; } }
  unsigned ksrc, vsrc[2];
  { const int b = wid * 1024 + lane * 16, row = b >> 7, g = ((b & 127) >> 4) ^ ((row >> 1) & 7); ksrc = (unsigned)(row * KVW + g * 16); }
#pragma unroll
  for (int q = 0; q < 2; ++q) { const int b = q * 8192 + wid * 1024 + lane * 16;
      const int sub = b >> 9, w = (b & 511) >> 1, kk = (sub >> 2) * 8 + (w >> 5), c = (sub & 3) * 32 + (w & 31), k = (kk & ~0xC) | ((kk & 4) << 1) | ((kk & 8) >> 1);
      vsrc[q] = (unsigned)(k * (LDK * 2) + c * 2); }
#define ADMA(tile, s) do { const char* kb_ = (const char*)K8h + (size_t)(tile) * (KVBLK * KVW); const char* vb_ = (const char*)Vh + (size_t)(tile) * (KVBLK * LDK * 2); \
    __builtin_amdgcn_global_load_lds((const unsigned*)(kb_ + ksrc), (LAS unsigned*)(ldsl + (s) * SLOT + wid * 1024), 16, 0, 0); \
    _Pragma("unroll") for (int q = 0; q < 2; ++q) __builtin_amdgcn_global_load_lds((const unsigned*)(vb_ + vsrc[q]), (LAS unsigned*)(ldsl + (s) * SLOT + 16384 + q * 8192 + wid * 1024), 16, 0, 0); } while (0)
#define KSLOT(s) ((const char*)(lds + (s) * SLOT))
#define VBASE(s) (vbl + (s) * SLOT)
#define NEXT3(s) ((s) == 2 ? 0 : (s) + 1)
  const int vbl = (int)(uintptr_t)(lds + 16384) + v_rd_base(lane);
  f32x16 pA0, pA1, pB0, pB1; bf16x8 pa0, pa1, pa2, pa3; const int NT = seq / KVBLK;
  ADMA(0, 0);
  __syncthreads(); ADMA(1, 1);
  qkt8(pA0, pA1, KSLOT(0), q8, r32, hi, nm0); partialSM(pA0);
  int sj = 1;
  for (int j = 1; j + 1 < NT; j += 2) {
    { const int sp = sj == 0 ? 2 : sj - 1, sn = NEXT3(sj);
      __syncthreads(); ADMA(j + 1, sn);
      SBAR(); qkt8(pB0, pB1, KSLOT(sj), q8, r32, hi, nm0);
      finishSM(pA0, pA1, l_reg, pa0, pa1, pa2, pa3); SBAR();
      pv_d0(o, VBASE(sp), pa0, pa1, pa2, pa3); partialSM(pB0);
      sj = sn; }
    { const int sp = sj == 0 ? 2 : sj - 1, sn = NEXT3(sj);
      __syncthreads(); if (j + 2 < NT) ADMA(j + 2, sn);
      SBAR(); qkt8(pA0, pA1, KSLOT(sj), q8, r32, hi, nm0);
      finishSM(pB0, pB1, l_reg, pa0, pa1, pa2, pa3); SBAR();
      pv_d0(o, VBASE(sp), pa0, pa1, pa2, pa3); partialSM(pA0);
      sj = sn; }
  }
  { const int sp = sj == 0 ? 2 : sj - 1;
    __syncthreads();
    SBAR(); qkt8(pB0, pB1, KSLOT(sj), q8, r32, hi, nm0);
    finishSM(pA0, pA1, l_reg, pa0, pa1, pa2, pa3); SBAR();
    pv_d0(o, VBASE(sp), pa0, pa1, pa2, pa3); partialSM(pB0);
    finishSM(pB0, pB1, l_reg, pa0, pa1, pa2, pa3); SBAR();
    pv_d0(o, VBASE(sj), pa0, pa1, pa2, pa3); }
  { auto rr = __builtin_amdgcn_permlane32_swap(__float_as_uint(l_reg), __float_as_uint(l_reg), false, false); l_reg = __uint_as_float(rr[0]) + __uint_as_float(rr[1]); }
  if (hi == 0) li_l[r32] = l_reg; asm volatile("s_waitcnt lgkmcnt(0)" ::: "memory");
  float rli[16];
#pragma unroll
  for (int r = 0; r < 16; ++r) rli[r] = __builtin_amdgcn_rcpf(li_l[crow(r, hi)]);
  bf16_t* Ow = Ob + (long)(wid * QBLK) * LDO;
#pragma unroll
  for (int r = 0; r < 16; ++r) { int orow = crow(r, hi);
    for (int d0 = 0; d0 < 4; ++d0) Ow[(long)orow * LDO + d0 * 32 + r32] = (bf16_t)f2bf(o[d0][r] * rli[r]); }
  __syncthreads();
#undef ADMA
#undef KSLOT
#undef VBASE
#undef NEXT3
}
}

namespace peer {
__device__ __forceinline__ float vmax(float a, float b) { float r; asm("v_max_f32 %0, %1, %2" : "=v"(r) : "v"(a), "v"(b)); return r; }
__device__ __forceinline__ float vmin(float a, float b) { float r; asm("v_min_f32 %0, %1, %2" : "=v"(r) : "v"(a), "v"(b)); return r; }
__device__ __forceinline__ void cswap(float& hi_, float& lo_) { const float mx = vmax(hi_, lo_), mn = vmin(hi_, lo_); hi_ = mx; lo_ = mn; }
__device__ __forceinline__ void sort16(float (&v)[16]) {
    constexpr int NET[63][2] = {{0,1},{2,3},{0,2},{1,3},{1,2},{4,5},{6,7},{4,6},{5,7},{5,6},{0,4},{2,6},{2,4},{1,5},{3,7},{3,5},{1,2},{3,4},{5,6},{8,9},{10,11},{8,10},{9,11},{9,10},{12,13},{14,15},{12,14},{13,15},{13,14},
        {8,12},{10,14},{10,12},{9,13},{11,15},{11,13},{9,10},{11,12},{13,14},{0,8},{4,12},{4,8},{2,10},{6,14},{6,10},{2,4},{6,8},{10,12},{1,9},{5,13},{5,9},{3,11},{7,15},{7,11},{3,5},{7,9},{11,13},{1,2},{3,4},{5,6},{7,8},{9,10},{11,12},{13,14}};
#pragma unroll
    for (int k = 0; k < 63; ++k) cswap(v[NET[k][0]], v[NET[k][1]]);
}
__device__ __forceinline__ void bmerge16(float (&v)[16]) {
#pragma unroll
    for (int j = 8; j > 0; j >>= 1)
#pragma unroll
        for (int i = 0; i < 16; ++i) { const int l = i ^ j; if (l > i) cswap(v[i], v[l]); }
}
__device__ __forceinline__ void merge_top16(float (&a)[16], const float (&b)[16]) {
#pragma unroll
    for (int i = 0; i < 16; ++i) a[i] = vmax(a[i], b[15 - i]);
    bmerge16(a);
}
__device__ __forceinline__ float setlow(float v, unsigned mask, unsigned bits) { return __uint_as_float((__float_as_uint(v) & ~mask) | bits); }
__device__ __forceinline__ void top16_of_acc(const f32x16 (&acc)[4], int hi, float (&out)[16]) {
    float t[16];
#pragma unroll
    for (int blk = 0; blk < 4; ++blk) {
#pragma unroll
        for (int r = 0; r < 16; ++r) { const unsigned key = (unsigned)(32 * blk + (r & 3) + 8 * (r >> 2)) | ((unsigned)hi << 2); if (blk == 0) out[r] = setlow(acc[blk][r], 0x7Fu, key); else t[r] = setlow(acc[blk][r], 0x7Fu, key); }
        if (blk == 0) sort16(out); else { sort16(t); merge_top16(out, t); }
    }
}
}

struct Args { const float* in[28]; float* out; unsigned char* ws; int ph_lo, ph_hi; };
enum { I_X = 0, I_C, I_CTX, I_CCTX, I_WMOD, I_BMOD, I_NMG, I_WIN, I_QNG, I_KNG, I_ARE, I_AIM, I_LDT, I_BRE, I_BIM, I_CRE, I_CIM, I_SD, I_WGLU, I_BGLU, I_WBA, I_WBS, I_WO, I_NFG, I_PWQ, I_PKEYS, I_PU, I_PV };

__device__ __forceinline__ void transpose_item(const float* W, int K, int N, bf16_t* WT, LAS float* scr, int item, int lane) {
    const int nblk = N / 32, kb = item / nblk, nb = item % nblk, k0 = 64 * kb, n0 = 32 * nb;
    { f32x4 t[8]; const int kr = lane >> 3, nq = (lane & 7) * 4;
#pragma unroll
      for (int i = 0; i < 8; ++i) t[i] = *(const f32x4*)(W + (size_t)(k0 + 8 * i + kr) * N + n0 + nq);
#pragma unroll
      for (int i = 0; i < 8; ++i) { LAS float* d = scr + (8 * i + kr) * 33 + nq; d[0] = t[i][0]; d[1] = t[i][1]; d[2] = t[i][2]; d[3] = t[i][3]; } }
    asm volatile("s_waitcnt lgkmcnt(0)" ::: "memory");
    const int c = lane & 7;
#pragma unroll
    for (int j = 0; j < 4; ++j) { const int n = (lane >> 3) + 8 * j; const LAS float* s = scr + (8 * c) * 33 + n;
        u32x4 o; o.x = pk2(s[0 * 33], s[1 * 33]); o.y = pk2(s[2 * 33], s[3 * 33]); o.z = pk2(s[4 * 33], s[5 * 33]); o.w = pk2(s[6 * 33], s[7 * 33]);
        *(u32x4*)(WT + (size_t)(n0 + n) * K + k0 + 8 * c) = o; }
    asm volatile("s_waitcnt lgkmcnt(0)" ::: "memory");
}

__device__ __forceinline__ void norm_mod_row(const float* hr, const float* g, const float* sh, const float* sc, bf16_t* orow, int lane) {
    f32x4 v[4]; float ss = 0.f;
#pragma unroll
    for (int j = 0; j < 4; ++j) { v[j] = *(const f32x4*)(hr + (j >> 1) * 512 + lane * 8 + (j & 1) * 4); ss += (v[j][0] * v[j][0] + v[j][1] * v[j][1]) + (v[j][2] * v[j][2] + v[j][3] * v[j][3]); }
    ss = wave_sum(ss, lane);
    const float rstd = __builtin_amdgcn_rsqf(ss * (1.0f / DM) + EPS);
#pragma unroll
    for (int hh = 0; hh < 2; ++hh) {
        const int c0 = hh * 512 + lane * 8; f32x4 o[2];
#pragma unroll
        for (int j = 0; j < 2; ++j) { const f32x4 gg = *(const f32x4*)(g + c0 + 4 * j), s1 = *(const f32x4*)(sc + c0 + 4 * j), s0 = *(const f32x4*)(sh + c0 + 4 * j);
            o[j] = v[hh * 2 + j] * rstd * gg * (1.0f + s1) + s0; }
        *(u32x4*)(orow + c0) = pack8(o[0], o[1]);
    }
}
__device__ __forceinline__ const float* hrow_c(const float* hlat, const float* hctx, int r) { return r < NLAT ? hlat + (size_t)r * DM : hctx + (size_t)(r - NLAT) * DM; }
__device__ __forceinline__ float* hrow_m(float* hlat, float* hctx, int r) { return r < NLAT ? hlat + (size_t)r * DM : hctx + (size_t)(r - NLAT) * DM; }

__device__ __forceinline__ void p0a(const Args& a, LAS unsigned char* lds, int bx, int G, int tid) {
    const int lane = tid & 63, wave = tid >> 6, gw = bx * 8 + wave, NGW = G * 8;
    unsigned char* ws = a.ws;
    { LAS float* scr = (LAS float*)(lds + wave * 16384);
      constexpr int I_IN = 16 * 128, I_BA = 16 * 32, I_BS = 8 * 32, I_OO = 16 * 32, I_GL = 8 * 16, I_QQ = 16 * 64, PER = I_IN + I_BA + I_BS + I_OO + I_GL + I_QQ;
      for (int it = gw; it < PER * DEPTH; it += NGW) {
          const int l = it / PER; int r = it - l * PER; bf16_t* base = (bf16_t*)(ws + WS_WT + (size_t)l * WT_LAYER);
          if (r < I_IN) { transpose_item(a.in[I_WIN] + (size_t)l * DM * INW, DM, INW, (bf16_t*)((char*)base + WT_IN), scr, r, lane); continue; } r -= I_IN;
          if (r < I_BA) { transpose_item(a.in[I_WBA] + (size_t)l * DM * DM, DM, DM, (bf16_t*)((char*)base + WT_BA), scr, r, lane); continue; } r -= I_BA;
          if (r < I_BS) { transpose_item(a.in[I_WBS] + (size_t)l * SSMW * DM, SSMW, DM, (bf16_t*)((char*)base + WT_BS), scr, r, lane); continue; } r -= I_BS;
          if (r < I_OO) { transpose_item(a.in[I_WO] + (size_t)l * DM * DM, DM, DM, (bf16_t*)((char*)base + WT_O), scr, r, lane); continue; } r -= I_OO;
          if (r < I_GL) { transpose_item(a.in[I_WGLU] + (size_t)l * SSMW * SSMW, SSMW, SSMW, (bf16_t*)((char*)base + WT_GLU), scr, r, lane); continue; } r -= I_GL;
          transpose_item(a.in[I_PWQ] + (size_t)l * DM * PQW, DM, PQW, (bf16_t*)((char*)base + WT_Q), scr, r, lane);
      } }
    { const size_t gt = (size_t)bx * 512 + tid, GT = (size_t)G * 512;
      { typedef float v16f_ __attribute__((ext_vector_type(16))); typedef int v6i_ __attribute__((ext_vector_type(6)));
        constexpr int NROWS = 2 * DEPTH * PEXP;
        f32x4 cur[2][4];
#define P0A_TLOAD(dst, r0_) do { _Pragma("unroll") for (int rr = 0; rr < 2; ++rr) { const int row = ((r0_) + rr * NGW < NROWS) ? (r0_) + rr * NGW : (r0_); const bool isU = row < DEPTH * PEXP; const int idx = isU ? row : row - DEPTH * PEXP; \
            const float* src = (isU ? a.in[I_PU] : a.in[I_PV]) + (size_t)idx * DM + lane * 16; _Pragma("unroll") for (int j = 0; j < 4; ++j) dst[rr][j] = *(const f32x4*)(src + 4 * j); } } while (0)
        if (gw < NROWS) P0A_TLOAD(cur, gw);
        for (int row0 = gw; row0 < NROWS; row0 += 2 * NGW) {
          f32x4 nx[2][4];
          if (row0 + 2 * NGW < NROWS) P0A_TLOAD(nx, row0 + 2 * NGW);
          float v[2][16]; float sc[2], inv[2];
#pragma unroll
          for (int rr = 0; rr < 2; ++rr)
#pragma unroll
              for (int j = 0; j < 4; ++j) { v[rr][4 * j] = cur[rr][j][0]; v[rr][4 * j + 1] = cur[rr][j][1]; v[rr][4 * j + 2] = cur[rr][j][2]; v[rr][4 * j + 3] = cur[rr][j][3]; }
#pragma unroll
          for (int rr = 0; rr < 2; ++rr) { float mx = 0.f;
#pragma unroll
              for (int j = 0; j < 16; ++j) mx = fmaxf(mx, fabsf(v[rr][j]));
#pragma unroll
              for (int o = 1; o < 64; o <<= 1) mx = fmaxf(mx, shflx(mx, o, lane));
              sc[rr] = mx > 0.f ? QMAX / mx : 1.0f; inv[rr] = mx > 0.f ? mx * (1.0f / QMAX) : 1.0f; }
#if PEER_FP4
#pragma unroll
          for (int rr = 0; rr < 2; ++rr) { const int row = row0 + rr * NGW; if (row < NROWS) { const bool isU = row < DEPTH * PEXP; const int idx = isU ? row : row - DEPTH * PEXP;
              unsigned w0 = 0u, w1 = 0u;
#define P0A_PK(b) w0 = __builtin_amdgcn_cvt_scalef32_pk_fp4_f32(w0, v[rr][2 * b] * sc[rr], v[rr][2 * b + 1] * sc[rr], 1.0f, b); w1 = __builtin_amdgcn_cvt_scalef32_pk_fp4_f32(w1, v[rr][8 + 2 * b] * sc[rr], v[rr][8 + 2 * b + 1] * sc[rr], 1.0f, b);
              P0A_PK(0) P0A_PK(1) P0A_PK(2) P0A_PK(3)
#undef P0A_PK
              unsigned* dst = (unsigned*)(ws + (isU ? WS_PU : WS_PV) + (size_t)idx * PROW + lane * 8);
              dst[0] = w0; dst[1] = w1;
              if (lane == 0) ((float*)(ws + (isU ? WS_PSU : WS_PSV)))[idx] = inv[rr]; } }
#else
          v16f_ ga, gb;
#pragma unroll
          for (int j = 0; j < 8; ++j) { ga[j] = v[0][2 * j] * sc[0]; gb[j] = v[0][2 * j + 1] * sc[0]; ga[8 + j] = v[1][2 * j] * sc[1]; gb[8 + j] = v[1][2 * j + 1] * sc[1]; }
          const v6i_ pk = __builtin_amdgcn_cvt_scalef32_2xpk16_fp6_f32(ga, gb, 1.0f);
#pragma unroll
          for (int rr = 0; rr < 2; ++rr) { const int row = row0 + rr * NGW; if (row < NROWS) { const bool isU = row < DEPTH * PEXP; const int idx = isU ? row : row - DEPTH * PEXP;
              unsigned* dst = (unsigned*)(ws + (isU ? WS_PU : WS_PV) + (size_t)idx * 768 + lane * 12);
              dst[0] = (unsigned)pk[3 * rr]; dst[1] = (unsigned)pk[3 * rr + 1]; dst[2] = (unsigned)pk[3 * rr + 2];
              if (lane == 0) ((float*)(ws + (isU ? WS_PSU : WS_PSV)))[idx] = inv[rr]; } }
#endif
#pragma unroll
          for (int rr = 0; rr < 2; ++rr)
#pragma unroll
              for (int j = 0; j < 4; ++j) cur[rr][j] = nx[rr][j];
        } }
#undef P0A_TLOAD
      const size_t k8 = (size_t)DEPTH * 2 * PKEYS * 128 / 8;
      for (size_t i = gt; i < k8; i += GT) { const float* src = a.in[I_PKEYS] + i * 8; const f32x4 x0 = *(const f32x4*)src, x1 = *(const f32x4*)(src + 4);
          u32x4 o; o.x = pk2(x0[0], x0[1]); o.y = pk2(x0[2], x0[3]); o.z = pk2(x1[0], x1[1]); o.w = pk2(x1[2], x1[3]);
          *(u32x4*)((bf16_t*)(ws + WS_KEYS) + i * 8) = o; }
      const size_t nc4 = (size_t)NCTX * DM / 4;
      for (size_t i = gt; i < nc4; i += GT) ((f32x4*)(ws + WS_HCTX))[i] = ((const f32x4*)a.in[I_CTX])[i];
      if (bx == 0) { float* ct = (float*)(ws + WS_ROPE); for (int i = tid; i < 64 * 32; i += 512) { const int pos = i >> 5, f = i & 31;
          const float invf = (float)pow(10000.0, -(double)f / 32.0); const float ang = (float)pos * invf; ct[i] = (float)cos((double)ang); ct[2048 + i] = (float)sin((double)ang); } }
    }
    { __syncthreads();
      LAS float* sv = (LAS float*)lds;
      LAS float* part = (LAS float*)(lds + 9 * 1024 * 4);
      for (int i = tid; i < 9 * DM; i += 512) { const int m = i >> 10, k = i & 1023; const float c = m < NB ? a.in[I_C][m * DM + k] : a.in[I_CCTX][k]; sv[i] = c / (1.0f + __expf(-c)); }
      __syncthreads();
      for (int it = bx; it < DEPTH * (MODW / 32); it += G) {
          const int l = it / (MODW / 32), jb = it % (MODW / 32), kh = lane >> 5, j = jb * 32 + (lane & 31), kb = wave * 128 + kh * 64;
          const float* w = a.in[I_WMOD] + ((size_t)l * DM + kb) * MODW + j;
          float acc[9];
#pragma unroll
          for (int m = 0; m < 9; ++m) acc[m] = 0.f;
#pragma unroll 1
          for (int k0 = 0; k0 < 64; k0 += 16) { float wv[16];
#pragma unroll
              for (int i = 0; i < 16; ++i) wv[i] = w[(size_t)(k0 + i) * MODW];
#pragma unroll
              for (int i = 0; i < 16; ++i)
#pragma unroll
                  for (int m = 0; m < 9; ++m) acc[m] += sv[m * DM + kb + k0 + i] * wv[i]; }
#pragma unroll
          for (int m = 0; m < 9; ++m) part[(wave * 9 + m) * 64 + lane] = acc[m];
          __syncthreads();
          for (int i = tid; i < 9 * 32; i += 512) { const int m = i >> 5, jj = i & 31; float s = 0.f;
#pragma unroll
              for (int w8 = 0; w8 < 8; ++w8) s += part[(w8 * 9 + m) * 64 + jj] + part[(w8 * 9 + m) * 64 + 32 + jj];
              ((float*)(ws + WS_MOD))[((size_t)l * 9 + m) * MODW + jb * 32 + jj] = s + a.in[I_BMOD][(size_t)l * MODW + jb * 32 + jj]; }
          __syncthreads();
      }
    }
}

__device__ __forceinline__ void norm_pass(const Args& a, int l, int sel, bf16_t* dst, int gw, int NGW, int lane, int nrows, const float* hlat) {
    const float* mod = (const float*)(a.ws + WS_MOD) + (size_t)l * 9 * MODW;
    const float* g = a.in[sel ? I_NFG : I_NMG] + (size_t)l * DM;
    const float* hctx = (const float*)(a.ws + WS_HCTX);
    for (int r = gw; r < nrows; r += NGW) { const float* mr = mod + (size_t)modrow_of(r) * MODW + sel * 3 * DM;
        norm_mod_row(hrow_c(hlat, hctx, r), g, mr, mr + DM, dst + (size_t)r * DM, lane); }
}

__device__ __forceinline__ void ssm_tables(const Args& a, int l, LAS unsigned char* lds, int bx, int G, int tid) {
    LAS float* ErT = (LAS float*)lds;
    LAS float* EiT = ErT + 1024;
    LAS float* kr = EiT + 1024;
    LAS float* ki = kr + 128;
    LAS float* red = ki + 128;
    LAS float* E2r = red + 2048;
    LAS float* E2i = E2r + 512;
    LAS float* E3r = E2i + 512;
    LAS float* E3i = E3r + 512;
    LAS float* Cr = E3i + 512;
    LAS float* Ci = Cr + 2048;
    LAS float* kBr = Ci + 2048;
    LAS float* kBi = kBr + 2048;
    bf16_t* WCAT = (bf16_t*)(a.ws + WS_WCAT); bf16_t* WST = (bf16_t*)(a.ws + WS_WSTATE);
    for (int unit = bx; unit < SG * 8; unit += G) {
        const int g = unit >> 3, oc = unit & 7;
        __syncthreads();
        { const int d = tid >> 8, v = tid & 255; const size_t o4 = (((size_t)l * 2 + d) * SG + g) * (SP * SN) + v * 4;
          *(LAS f32x4*)(Cr + tid * 4) = *(const f32x4*)(a.in[I_CRE] + o4); *(LAS f32x4*)(Ci + tid * 4) = *(const f32x4*)(a.in[I_CIM] + o4);
          *(LAS f32x4*)(kBr + tid * 4) = *(const f32x4*)(a.in[I_BRE] + o4); *(LAS f32x4*)(kBi + tid * 4) = *(const f32x4*)(a.in[I_BIM] + o4); }
        {   const int dn = tid & 127, d = dn >> 6, n = dn & 63; const size_t o = (((size_t)l * 2 + d) * SG + g) * SN + n;
            const float are = a.in[I_ARE][o], aim = a.in[I_AIM][o], dt = expf(a.in[I_LDT][((size_t)l * 2 + d) * SG + g]);
            const float th = aim * dt;
            if (tid < 128) { const float mag = expf(are * dt), abr = mag * cosf(th), abi = mag * sinf(th);
                const float den = are * are + aim * aim, nr = abr - 1.0f, ni = abi;
                kr[tid] = (nr * are + ni * aim) / den; ki[tid] = (ni * are - nr * aim) / den; }
#pragma unroll
            for (int ii = 0; ii < 2; ++ii) { const int i = (tid >> 7) + 4 * ii, dl = -31 + 8 * oc + i; const int e = dl < 0 ? -dl : dl;
                const bool on = (dl == 0) || (dl > 0 && d == 0) || (dl < 0 && d == 1);
                const float mg = expf((float)e * are * dt), ph = (float)e * th;
                ErT[dn * 8 + i] = (on && dl <= 31) ? mg * cosf(ph) : 0.f; EiT[dn * 8 + i] = (on && dl <= 31) ? mg * sinf(ph) : 0.f; }
        }
        {
            const int q4 = tid >> 7, d = (tid >> 6) & 1, n = tid & 63; const size_t o = (((size_t)l * 2 + d) * SG + g) * SN + n;
            const float are = a.in[I_ARE][o], aim = a.in[I_AIM][o], dt = expf(a.in[I_LDT][((size_t)l * 2 + d) * SG + g]);
            const int t = 4 * oc + q4;
            const int e2 = d == 0 ? t + 1 : ST - t;
            const int e3 = d == 0 ? ST - 1 - t : t;
            const float m2 = expf((float)e2 * are * dt), p2 = (float)e2 * aim * dt, m3 = expf((float)e3 * are * dt), p3 = (float)e3 * aim * dt;
            E2r[tid] = m2 * cosf(p2); E2i[tid] = m2 * sinf(p2); E3r[tid] = m3 * cosf(p3); E3i[tid] = m3 * sinf(p3);
        }
        __syncthreads();
        { const int dn = tid >> 2; const float k_r = kr[dn], k_i = ki[dn];
          const f32x4 br = *(LAS f32x4*)(kBr + tid * 4), bi = *(LAS f32x4*)(kBi + tid * 4);
          *(LAS f32x4*)(kBr + tid * 4) = k_r * br - k_i * bi; *(LAS f32x4*)(kBi + tid * 4) = k_r * bi + k_i * br; }
        __syncthreads();
        {
            const int pq = tid & 255, p = pq >> 4, q = pq & 15, nh = tid >> 8;
            float acc[8];
#pragma unroll
            for (int i = 0; i < 8; ++i) acc[i] = 0.f;
            for (int d = 0; d < 2; ++d) {
#pragma unroll 4
                for (int n = nh * 32; n < nh * 32 + 32; ++n) {
                    const float cr = Cr[d * 1024 + p * 64 + n], ci = Ci[d * 1024 + p * 64 + n], Br = kBr[d * 1024 + n * 16 + q], Bi = kBi[d * 1024 + n * 16 + q];
                    const float xr = cr * Br - ci * Bi, xi = cr * Bi + ci * Br;
                    const f32x4 e0 = *(LAS f32x4*)(ErT + (d * 64 + n) * 8), e1 = *(LAS f32x4*)(ErT + (d * 64 + n) * 8 + 4), f0 = *(LAS f32x4*)(EiT + (d * 64 + n) * 8), f1 = *(LAS f32x4*)(EiT + (d * 64 + n) * 8 + 4);
#pragma unroll
                    for (int i = 0; i < 4; ++i) { acc[i] += xr * e0[i] - xi * f0[i]; acc[4 + i] += xr * e1[i] - xi * f1[i]; }
                }
            }
            if (nh == 1) {
#pragma unroll
                for (int i = 0; i < 8; ++i) red[i * 256 + pq] = acc[i]; }
            __syncthreads();
            if (nh == 0) {
#pragma unroll
                for (int i = 0; i < 8; ++i) red[i * 256 + pq] += acc[i]; }
            __syncthreads();
            for (int idx = tid; idx < 8 * 32 * 32; idx += 512) {
                const int i = idx >> 10, j = (idx >> 5) & 31, p2 = (idx >> 1) & 15, qh = idx & 1, dl = -31 + 8 * oc + i;
                if (dl > 31) continue;
                const int ad = dl < 0 ? -dl : dl; if (j >= ST - ad) continue;
                const int t = (dl > 0 ? dl : 0) + j, s = t - dl;
                const f32x4 v0 = *(LAS f32x4*)(red + i * 256 + p2 * 16 + qh * 8), v1 = *(LAS f32x4*)(red + i * 256 + p2 * 16 + qh * 8 + 4);
                *(u32x4*)(WCAT + ((size_t)g * 512 + t * SP + p2) * KCAT + s * SP + qh * 8) = pack8(v0, v1);
            }
        }
        for (int idx = tid; idx < 4 * 16 * 32; idx += 512) {
            const int kk8 = idx & 31, rp = idx >> 5, q4 = rp >> 4, p = rp & 15, d = kk8 >> 4, part = (kk8 >> 3) & 1, n0 = (kk8 & 7) * 8, t = 4 * oc + q4;
            f32x4 o0, o1;
#pragma unroll
            for (int e = 0; e < 8; ++e) { const int n = n0 + e; const float cr = Cr[d * 1024 + p * 64 + n], ci = Ci[d * 1024 + p * 64 + n], er = E2r[q4 * 128 + d * 64 + n], ei = E2i[q4 * 128 + d * 64 + n];
                const float v = part == 0 ? (cr * er - ci * ei) : -(cr * ei + ci * er); if (e < 4) o0[e] = v; else o1[e - 4] = v; }
            *(u32x4*)(WCAT + ((size_t)g * 512 + t * SP + p) * KCAT + 512 + kk8 * 8) = pack8(o0, o1);
        }
        for (int idx = tid; idx < 256 * 8; idx += 512) {
            const int c8 = idx & 7, j = idx >> 3, q4 = c8 >> 1, q0 = (c8 & 1) * 8, d = j >> 7, part = (j >> 6) & 1, n = j & 63, s = 4 * oc + q4;
            const float er = E3r[q4 * 128 + d * 64 + n], ei = E3i[q4 * 128 + d * 64 + n];
            f32x4 o0, o1;
#pragma unroll
            for (int e = 0; e < 8; ++e) { const float Br = kBr[d * 1024 + n * 16 + q0 + e], Bi = kBi[d * 1024 + n * 16 + q0 + e];
                const float v = part == 0 ? (er * Br - ei * Bi) : (er * Bi + ei * Br); if (e < 4) o0[e] = v; else o1[e - 4] = v; }
            *(u32x4*)(WST + ((size_t)g * 256 + j) * 512 + s * SP + q0) = pack8(o0, o1);
        }
    }
    __syncthreads();
}

__device__ __forceinline__ void ssm_carry(const Args& a, int l, int vb, int tid) {
    const int idx = vb * 512 + tid, n = idx & 63, d = (idx >> 6) & 1, g = (idx >> 7) & 31, b = idx >> 12;
    const size_t o = (((size_t)l * 2 + d) * SG + g) * SN + n;
    const float are = a.in[I_ARE][o], aim = a.in[I_AIM][o], dt = expf(a.in[I_LDT][((size_t)l * 2 + d) * SG + g]);
    const float mg = expf((float)ST * are * dt), ph = (float)ST * aim * dt, pr = mg * cosf(ph), pi = mg * sinf(ph);
    const float* SX = (const float*)(a.ws + WS_SX) + (size_t)g * NCOLP * 256 + d * 128 + n;
    bf16_t* UC = (bf16_t*)(a.ws + WS_UCAT) + (size_t)g * NCOLP * KCAT + 512 + d * 128 + n;
    float hr = 0.f, hi = 0.f;
#pragma unroll 1
    for (int st0 = 0; st0 < NCH; st0 += 34) {
        float xr[34], xi[34];
#pragma unroll
        for (int k = 0; k < 34; ++k) { const int st = st0 + k; int c;
            if (d == 0) c = st < 8 ? NCHL + st : st - 8; else c = st < 8 ? NCHL + 7 - st : NCHL - 1 - (st - 8);
            const int col = c * 8 + b; xr[k] = SX[(size_t)col * 256]; xi[k] = SX[(size_t)col * 256 + 64]; }
#pragma unroll
        for (int k = 0; k < 34; ++k) { const int st = st0 + k; int c;
            if (d == 0) c = st < 8 ? NCHL + st : st - 8; else c = st < 8 ? NCHL + 7 - st : NCHL - 1 - (st - 8);
            const int col = c * 8 + b;
            UC[(size_t)col * KCAT] = (bf16_t)f2bf(hr); UC[(size_t)col * KCAT + 64] = (bf16_t)f2bf(hi);
            const float nr = pr * hr - pi * hi + xr[k], ni = pr * hi + pi * hr + xi[k]; hr = nr; hi = ni; }
    }
}

#define DPPX(v, ctrl) __builtin_bit_cast(float, __builtin_amdgcn_update_dpp(0, __builtin_bit_cast(int, (v)), (ctrl), 0xf, 0xf, false))
__device__ __forceinline__ void qk_head_rows(bf16_t* p, const float* gain, const float* rope, int lpos  , int lane, const float osc, unsigned char* k8 = nullptr  ) {
    const int sub = lane & 7;
    u32x4 w0 = *(const u32x4*)p, w1 = *(const u32x4*)(p + 8);
    float x[16]; { f32x4 a0, a1, b0, b1; unpack8(w0, a0, a1); unpack8(w1, b0, b1);
#pragma unroll
        for (int i = 0; i < 4; ++i) { x[i] = a0[i]; x[4 + i] = a1[i]; x[8 + i] = b0[i]; x[12 + i] = b1[i]; } }
    float ss = 0.f;
#pragma unroll
    for (int i = 0; i < 16; ++i) ss += x[i] * x[i];
    ss += DPPX(ss, 0xB1);
    ss += DPPX(ss, 0x4E);
    ss += DPPX(ss, 0x141);
    const float rstd = osc * __builtin_amdgcn_rsqf(ss * (1.0f / HD) + EPS);
    const f32x4* g4 = (const f32x4*)(gain + sub * 16);
#pragma unroll
    for (int j = 0; j < 4; ++j) { const f32x4 gg = g4[j];
#pragma unroll
        for (int i = 0; i < 4; ++i) x[4 * j + i] = x[4 * j + i] * rstd * gg[i]; }
    float y[16];
    if (lpos >= 0) {
        const int axis = sub >> 2, posi = axis == 0 ? (lpos >> 6) : (lpos & 63), f0 = (sub & 1) * 16;
        const float sgn = (sub & 2) ? 1.0f : -1.0f;
        const f32x4* c4 = (const f32x4*)(rope + posi * 32 + f0); const f32x4* s4 = (const f32x4*)(rope + 2048 + posi * 32 + f0);
#pragma unroll
        for (int j = 0; j < 4; ++j) { const f32x4 cs = c4[j], sn = s4[j];
#pragma unroll
            for (int i = 0; i < 4; ++i) { const float other = DPPX(x[4 * j + i], 0x4E);
                y[4 * j + i] = x[4 * j + i] * cs[i] + sgn * other * sn[i]; } }
    } else {
#pragma unroll
        for (int i = 0; i < 16; ++i) y[i] = x[i];
    }
    if (k8) {
        int w[4];
#pragma unroll
        for (int j = 0; j < 4; ++j) { int v = 0; v = __builtin_amdgcn_cvt_pk_fp8_f32(y[4 * j], y[4 * j + 1], v, false); v = __builtin_amdgcn_cvt_pk_fp8_f32(y[4 * j + 2], y[4 * j + 3], v, true); w[j] = v; }
        *(u32x4*)(k8 + (sub >> 2) * 64 + (sub & 1) * 32 + ((sub >> 1) & 1) * 16) = (u32x4){(unsigned)w[0], (unsigned)w[1], (unsigned)w[2], (unsigned)w[3]};
        return; }
    f32x4 o0 = {y[0], y[1], y[2], y[3]}, o1 = {y[4], y[5], y[6], y[7]}, o2 = {y[8], y[9], y[10], y[11]}, o3 = {y[12], y[13], y[14], y[15]};
    *(u32x4*)p = pack8(o0, o1); *(u32x4*)(p + 8) = pack8(o2, o3);
}
__device__ __forceinline__ void qk_pass(const Args& a, int l, int gw, int NGW, int lane) {
    bf16_t* Q = (bf16_t*)(a.ws + WS_Q); bf16_t* KB = (bf16_t*)(a.ws + WS_KB); const float* rope = (const float*)(a.ws + WS_ROPE);
    const float* qg = a.in[I_QNG] + (size_t)l * HD; const float* kg = a.in[I_KNG] + (size_t)l * HD;
    (void)Q; (void)qg;
    for (int it = gw; it < NTOK / 4; it += NGW) { const int r = it * 4 + (lane >> 4);
        qk_head_rows(KB + (size_t)kvrow_of(r) * KVW + (lane & 15) * 16, kg, rope, r < NLAT ? (r & 4095) : -1, lane, 1.0f, (unsigned char*)(a.ws + WS_K8) + (size_t)kvrow_of(r) * KVW + ((lane & 15) >> 3) * 128); }
}

__host__ __device__ constexpr int cand_off(int i) { int o = 0; for (int k = 0; k < i; ++k) o += 16 / (k + 1); return o; }
__device__ __forceinline__ void gather_token(const Args& a, int l, int tok, const LAS unsigned* sid, const LAS float* sw, int lane, const bool dry);
__device__ __forceinline__ void peer_topk(const Args& a, int l, LAS unsigned char* lds, int gw, int NGW, int tid, int nrows, const bool dry) {
    const int wave = tid >> 6;
    const bf16_t* keys = (const bf16_t*)(a.ws + WS_KEYS) + (size_t)l * 2 * PKEYS * 128;
    const bf16_t* PQ = (const bf16_t*)(a.ws + WS_GA);
    __syncthreads();
    for (int c = tid; c < 4096; c += 512) { const int p = c >> 11, key = (c >> 4) & 127, cc = c & 15;
        *(LAS u32x4*)(lds + p * 32768 + KSWZ(key, cc * 16)) = *(const u32x4*)(keys + ((size_t)p * PKEYS + key) * 128 + cc * 8); }
    __syncthreads();
    LAS unsigned* xs = (LAS unsigned*)(lds + 65536 + wave * 2048);
    LAS unsigned* sid = (LAS unsigned*)(lds + 81920 + wave * 4096);
    LAS float* sw = (LAS float*)(lds + 81920 + wave * 4096 + 2048);
    const int T = (nrows + NGW - 1) / NGW, tbeg = gw * T, tend = (tbeg + T < nrows) ? tbeg + T : nrows;
#pragma unroll 1
    for (int t0 = tbeg; t0 < tend; t0 += 4) {
        const int ntb = (tend - t0 < 4) ? tend - t0 : 4;
        int lane_ = tid & 63; asm volatile("" : "+v"(lane_));
        const int lane = lane_, r32 = lane & 31, hi = lane >> 5;
        const int rv = (r32 >> 3) < ntb ? r32 : (ntb * 8 - 1);
        const size_t R = (size_t)t0 * 8 + rv;
        float a12[2][16];
#pragma unroll
        for (int p = 0; p < 2; ++p) {
            bf16x8 qv[8];
#pragma unroll
            for (int ds = 0; ds < 8; ++ds) qv[ds] = *(const bf16x8*)(PQ + R * 256 + p * 128 + ds * 16 + hi * 8);
            f32x16 acc[4];
#pragma unroll
            for (int kb = 0; kb < 4; ++kb) acc[kb] = f32x16{};
#pragma unroll
            for (int ds = 0; ds < 8; ++ds)
#pragma unroll
                for (int kb = 0; kb < 4; ++kb) { const bf16x8 ka = *(const LAS bf16x8*)(lds + p * 32768 + KSWZ(kb * 32 + r32, ds * 32 + hi * 16));
                    acc[kb] = __builtin_amdgcn_mfma_f32_32x32x16_bf16(ka, qv[ds], acc[kb], 0, 0, 0); }
            __builtin_amdgcn_sched_barrier(0);
            float top[16]; peer::top16_of_acc(acc, hi, top);
            __builtin_amdgcn_sched_barrier(0);
#pragma unroll
            for (int j = 0; j < 16; ++j) a12[p][j] = peer::vmax(top[j], shflx(top[15 - j], 32, lane));
            peer::bmerge16(a12[p]);
            __builtin_amdgcn_sched_barrier(0);
        }
        float cd[64];
#pragma unroll
        for (int i = 0; i < 16; ++i)
#pragma unroll
            for (int j = 0; j < 16; ++j) if ((i + 1) * (j + 1) <= 16) cd[cand_off(i) + j] = peer::setlow(a12[0][i] + a12[1][j], 0xFFu, (unsigned)(i * 16 + j));
#pragma unroll
        for (int n = 50; n < 64; ++n) cd[n] = -3.0e38f;
        __builtin_amdgcn_sched_barrier(0);
        float best[16], t[16];
#pragma unroll
        for (int blk = 0; blk < 4; ++blk) {
#pragma unroll
            for (int r = 0; r < 16; ++r) { if (blk == 0) best[r] = cd[r]; else t[r] = cd[blk * 16 + r]; }
            if (blk == 0) {   }
            else if (blk < 3) { peer::sort16(t); peer::merge_top16(best, t); }
            else { peer::sort16(t);
#pragma unroll
                for (int i = 0; i < 16; ++i) best[i] = peer::vmax(best[i], t[15 - i]); }
            __builtin_amdgcn_sched_barrier(0);
        }
#pragma unroll
        for (int p = 0; p < 2; ++p)
#pragma unroll
            for (int q = 0; q < 4; ++q) { unsigned w = 0;
#pragma unroll
                for (int e = 0; e < 4; ++e) w |= (__float_as_uint(a12[p][4 * q + e]) & 0x7Fu) << (8 * e);
                xs[(p * 4 + q) * 64 + lane] = w; }
        const float mx = cd[0]; float ex[16], sum = 0.f;
#pragma unroll
        for (int k = 0; k < 16; ++k) { ex[k] = __expf(best[k] - mx); sum += ex[k]; }
        const float inv = __builtin_amdgcn_rcpf(sum);
        unsigned ids[8]; float wts[8]; const unsigned him = 0u - (unsigned)hi;
#pragma unroll
        for (int k = 0; k < 8; ++k) { const float bsel = __uint_as_float((__float_as_uint(best[8 + k]) & him) | (__float_as_uint(best[k]) & ~him)); const float esel = __uint_as_float((__float_as_uint(ex[8 + k]) & him) | (__float_as_uint(ex[k]) & ~him));
            const unsigned code = __float_as_uint(bsel) & 0xFFu, ii = code >> 4, jj = code & 15u;
            const unsigned w1 = xs[(ii >> 2) * 64 + lane], w2 = xs[(4 + (jj >> 2)) * 64 + lane];
            const unsigned i1 = (w1 >> (8 * (ii & 3))) & 0x7Fu, i2 = (w2 >> (8 * (jj & 3))) & 0x7Fu;
            ids[k] = i1 * PKEYS + i2; wts[k] = esel * inv; }
        LAS unsigned* di = sid + r32 * 16 + hi * 8; LAS float* dw = sw + r32 * 16 + hi * 8;
        *(LAS u32x4*)di = (u32x4){ids[0], ids[1], ids[2], ids[3]}; *(LAS u32x4*)(di + 4) = (u32x4){ids[4], ids[5], ids[6], ids[7]};
        *(LAS f32x4*)dw = (f32x4){wts[0], wts[1], wts[2], wts[3]}; *(LAS f32x4*)(dw + 4) = (f32x4){wts[4], wts[5], wts[6], wts[7]};
        asm volatile("s_waitcnt lgkmcnt(0)" ::: "memory");
#pragma unroll 1
        for (int t4 = 0; t4 < ntb; ++t4) gather_token(a, l, t0 + t4, sid + t4 * 128, sw + t4 * 128, lane, dry);
    }
    __syncthreads();
}

typedef float f32x2v __attribute__((ext_vector_type(2)));
typedef float v32f __attribute__((ext_vector_type(32)));
typedef int v6i __attribute__((ext_vector_type(6)));
typedef unsigned u32x3 __attribute__((ext_vector_type(3)));
__device__ __forceinline__ float dpp_sum63(float v) {
#define DPP_ADD(ctrl, rmask) v += __builtin_bit_cast(float, __builtin_amdgcn_update_dpp(0, __builtin_bit_cast(int, v), ctrl, rmask, 0xf, false))
    DPP_ADD(0x111, 0xf); DPP_ADD(0x112, 0xf); DPP_ADD(0x114, 0xf); DPP_ADD(0x118, 0xf);
    DPP_ADD(0x142, 0xa); DPP_ADD(0x143, 0xc);
#undef DPP_ADD
    return v;
}
__device__ __forceinline__ void fp8x16(const u32x4 w, float (&f)[16]) {
#pragma unroll
    for (int j = 0; j < 4; ++j) { const f32x2v lo = __builtin_amdgcn_cvt_pk_f32_fp8((int)w[j], false), hi = __builtin_amdgcn_cvt_pk_f32_fp8((int)w[j], true);
        f[4 * j] = lo[0]; f[4 * j + 1] = lo[1]; f[4 * j + 2] = hi[0]; f[4 * j + 3] = hi[1]; }
}
__device__ __forceinline__ float reduce8(const float (&d)[8], int lane) {
    const bool b0 = lane & 1, b1 = lane & 2, b2 = lane & 4;
    float r1[4], r2[2];
#pragma unroll
    for (int p = 0; p < 4; ++p) { const float t = b0 ? d[2 * p + 1] : d[2 * p], u = b0 ? d[2 * p] : d[2 * p + 1]; r1[p] = t + DPPX(u, 0xB1); }
#pragma unroll
    for (int p = 0; p < 2; ++p) { const float t = b1 ? r1[2 * p + 1] : r1[2 * p], u = b1 ? r1[2 * p] : r1[2 * p + 1]; r2[p] = t + DPPX(u, 0x4E); }
    float r;
    { const float t = b2 ? r2[1] : r2[0], u = b2 ? r2[0] : r2[1];
      int x = __builtin_amdgcn_update_dpp(0, __builtin_bit_cast(int, u), 0x104, 0xf, 0x5, false);
      x = __builtin_amdgcn_update_dpp(x, __builtin_bit_cast(int, u), 0x114, 0xf, 0xa, false);
      r = t + __builtin_bit_cast(float, x); }
    r += DPPX(r, 0x128);
    r += __builtin_bit_cast(float, __builtin_amdgcn_ds_swizzle(__builtin_bit_cast(int, r), 0x401F));
    { auto rr = __builtin_amdgcn_permlane32_swap(__float_as_uint(r), __float_as_uint(r), false, false); r = __uint_as_float(rr[0]) + __uint_as_float(rr[1]); }
    return r;
}
__device__ __forceinline__ void gather_token(const Args& a, int l, int tok, const LAS unsigned* sid, const LAS float* sw, int lane, const bool dry) {
    const bf16_t* XN2 = (const bf16_t*)(a.ws + WS_XN2);
    const unsigned char* PU = a.ws + WS_PU + (size_t)l * PEXP * PROW; const unsigned char* PV = a.ws + WS_PV + (size_t)l * PEXP * PROW;
    const float* SU = (const float*)(a.ws + WS_PSU) + (size_t)l * PEXP; const float* SV = (const float*)(a.ws + WS_PSV) + (size_t)l * PEXP;
    const float* mod = (const float*)(a.ws + WS_MOD) + (size_t)l * 9 * MODW;
    float* hctx = (float*)(a.ws + WS_HCTX);
    {
        float x[16];
        { const u32x4 x0 = *(const u32x4*)(XN2 + (size_t)tok * DM + lane * 16), x1 = *(const u32x4*)(XN2 + (size_t)tok * DM + lane * 16 + 8);
#pragma unroll
          for (int i = 0; i < 4; ++i) { x[2 * i] = bflo(x0[i]); x[2 * i + 1] = bfhi(x0[i]); x[8 + 2 * i] = bflo(x1[i]); x[8 + 2 * i + 1] = bfhi(x1[i]); } }
        float out[16];
#pragma unroll
        for (int i = 0; i < 16; ++i) out[i] = 0.f;
#pragma unroll 1
        for (int half = 0; half < 2; ++half) {
            const unsigned id = sid[half * 64 + lane]; const float w = sw[half * 64 + lane];
            const float su = SU[id], sv = SV[id];
            float dotv = 0.f;
#if PEER_FP4
            typedef unsigned u32x2 __attribute__((ext_vector_type(2)));
            u32x2 b0[8], b1[8];
            const unsigned lo8 = (unsigned)lane * 8u;
#define PG_LOAD(dst, TAB, e0) _Pragma("unroll") for (int q = 0; q < 8; ++q) { const unsigned idq = (unsigned)__builtin_amdgcn_readlane((int)id, (e0) + q); dst[q] = *(const u32x2*)(TAB + (idq * 512u + lo8)); }
#define PG_CVT(src, q) const f32x2 f[8] = {__builtin_amdgcn_cvt_scalef32_pk_f32_fp4(src[q][0], 1.0f, 0), __builtin_amdgcn_cvt_scalef32_pk_f32_fp4(src[q][0], 1.0f, 1), __builtin_amdgcn_cvt_scalef32_pk_f32_fp4(src[q][0], 1.0f, 2), __builtin_amdgcn_cvt_scalef32_pk_f32_fp4(src[q][0], 1.0f, 3), \
                __builtin_amdgcn_cvt_scalef32_pk_f32_fp4(src[q][1], 1.0f, 0), __builtin_amdgcn_cvt_scalef32_pk_f32_fp4(src[q][1], 1.0f, 1), __builtin_amdgcn_cvt_scalef32_pk_f32_fp4(src[q][1], 1.0f, 2), __builtin_amdgcn_cvt_scalef32_pk_f32_fp4(src[q][1], 1.0f, 3)};
#define PG_DOT(src, e0) { float d8[8]; _Pragma("unroll") for (int q = 0; q < 8; ++q) { PG_CVT(src, q) f32x2 a0 = {0.f, 0.f}; \
                _Pragma("unroll") for (int i = 0; i < 8; ++i) { const f32x2 xx = {x[2 * i], x[2 * i + 1]}; a0 += f[i] * xx; } d8[q] = a0[0] + a0[1]; } \
                const float tot = reduce8(d8, lane); dotv = ((lane >> 3) == ((e0) >> 3)) ? tot : dotv; }
#define PG_ACC(src, e0) _Pragma("unroll") for (int q = 0; q < 8; ++q) { PG_CVT(src, q) \
                const float c0 = __builtin_bit_cast(float, __builtin_amdgcn_readlane(__builtin_bit_cast(int, coef), (e0) + q)); const f32x2 cc0 = {c0, c0}; \
                _Pragma("unroll") for (int i = 0; i < 8; ++i) { f32x2 o2 = {out[2 * i], out[2 * i + 1]}; o2 += cc0 * f[i]; out[2 * i] = o2[0]; out[2 * i + 1] = o2[1]; } }
#else
            u32x3 b0[8], b1[8];
            const unsigned lo12 = (unsigned)lane * 12u;
#define PG_LOAD(dst, TAB, e0) _Pragma("unroll") for (int q = 0; q < 8; ++q) { const unsigned idq = (unsigned)__builtin_amdgcn_readlane((int)id, (e0) + q); dst[q] = *(const u32x3*)(TAB + (idq * 768u + lo12)); }
#define PG_CVT(src, q) const v6i pk_ = {(int)src[q][0], (int)src[q][1], (int)src[q][2], (int)src[(q) + 1][0], (int)src[(q) + 1][1], (int)src[(q) + 1][2]}; const v32f f = __builtin_amdgcn_cvt_scalef32_pk32_f32_fp6(pk_, 1.0f);
#define F2(i) ((f32x2){f[2 * (i)], f[2 * (i) + 1]})
#define PG_DOT(src, e0) { float d8[8]; _Pragma("unroll") for (int q = 0; q < 8; q += 2) { PG_CVT(src, q) f32x2 a0 = {0.f, 0.f}, a1 = {0.f, 0.f}; \
                _Pragma("unroll") for (int i = 0; i < 8; ++i) { const f32x2 xx = {x[2 * i], x[2 * i + 1]}; a0 += F2(i) * xx; a1 += F2(8 + i) * xx; } d8[q] = a0[0] + a0[1]; d8[q + 1] = a1[0] + a1[1]; } \
                const float tot = reduce8(d8, lane); dotv = ((lane >> 3) == ((e0) >> 3)) ? tot : dotv; }
#define PG_ACC(src, e0) _Pragma("unroll") for (int q = 0; q < 8; q += 2) { PG_CVT(src, q) \
                const float c0 = __builtin_bit_cast(float, __builtin_amdgcn_readlane(__builtin_bit_cast(int, coef), (e0) + q)), c1 = __builtin_bit_cast(float, __builtin_amdgcn_readlane(__builtin_bit_cast(int, coef), (e0) + q + 1)); \
                const f32x2 cc0 = {c0, c0}, cc1 = {c1, c1}; \
                _Pragma("unroll") for (int i = 0; i < 8; ++i) { f32x2 o2 = {out[2 * i], out[2 * i + 1]}; o2 += cc0 * F2(i); o2 += cc1 * F2(8 + i); out[2 * i] = o2[0]; out[2 * i + 1] = o2[1]; } }
#endif
#if PEER_FP4
            u32x2 b2[8];
#else
            u32x3 b2[8];
#endif
#define PG_STEPA(cur, nxt, kb) { const int kl_ = (kb) + 2; if (kl_ < 8) { PG_LOAD(nxt, PU, kl_ * 8) } else { PG_LOAD(nxt, PV, (kl_ - 8) * 8) } PG_DOT(cur, (kb) * 8) }
#define PG_STEPB(cur, nxt, kb) { const int kl_ = (kb) + 2; if (kl_ < 8) { PG_LOAD(nxt, PV, kl_ * 8) } PG_ACC(cur, (kb) * 8) }
            PG_LOAD(b0, PU, 0) PG_LOAD(b1, PU, 8)
#pragma unroll 1
            for (int kb = 0; kb < 6; kb += 3) { PG_STEPA(b0, b2, kb) PG_STEPA(b1, b0, kb + 1) PG_STEPA(b2, b1, kb + 2) }
            PG_STEPA(b0, b2, 6) PG_STEPA(b1, b0, 7)
            const float coef = w * gelu_tanh(dotv * su) * sv;
#pragma unroll 1
            for (int kb = 0; kb < 6; kb += 3) { PG_STEPB(b2, b1, kb) PG_STEPB(b0, b2, kb + 1) PG_STEPB(b1, b0, kb + 2) }
            PG_STEPB(b2, b1, 6) PG_STEPB(b0, b2, 7)
#undef PG_STEPA
#undef PG_STEPB
#undef PG_LOAD
#undef PG_CVT
#undef PG_DOT
#undef PG_ACC
        }
        if (dry) { float sink = 0.f;
#pragma unroll
            for (int i = 0; i < 16; ++i) sink += out[i];
            asm volatile("" :: "v"(sink)); return; }
        float* hr = hrow_m(a.out, hctx, tok) + lane * 16;
        const float* gt = mod + (size_t)modrow_of(tok) * MODW + 5 * DM + lane * 16;
        f32x4 hv[4]; float ss = 0.f;
#pragma unroll
        for (int j = 0; j < 4; ++j) { hv[j] = *(const f32x4*)(hr + 4 * j); const f32x4 g4 = *(const f32x4*)(gt + 4 * j);
#pragma unroll
            for (int i = 0; i < 4; ++i) hv[j][i] += g4[i] * out[4 * j + i];
            *(f32x4*)(hr + 4 * j) = hv[j];
            ss += (hv[j][0] * hv[j][0] + hv[j][1] * hv[j][1]) + (hv[j][2] * hv[j][2] + hv[j][3] * hv[j][3]); }
        if (l + 1 < DEPTH) {
            ss = wave_sum(ss, lane);
            const float rstd = __builtin_amdgcn_rsqf(ss * (1.0f / DM) + EPS);
            const float* g = a.in[I_NMG] + (size_t)(l + 1) * DM + lane * 16; const float* mr = mod + 9 * MODW + (size_t)modrow_of(tok) * MODW + lane * 16;
            bf16_t* orow = (bf16_t*)(a.ws + WS_XN) + (size_t)tok * DM + lane * 16;
            f32x4 o[4];
#pragma unroll
            for (int j = 0; j < 4; ++j) { const f32x4 gg = *(const f32x4*)(g + 4 * j), s1 = *(const f32x4*)(mr + DM + 4 * j), s0 = *(const f32x4*)(mr + 4 * j);
                o[j] = hv[j] * rstd * gg * (1.0f + s1) + s0; }
            *(u32x4*)orow = pack8(o[0], o[1]); *(u32x4*)(orow + 8) = pack8(o[2], o[3]);
        }
    }
}

constexpr int NPH_LAYER = 10, NPHASE = 2 + NPH_LAYER * DEPTH;
__global__ void __launch_bounds__(512, 2) mega_fwd(Args a_in) {
    extern __shared__ __attribute__((aligned(16))) unsigned char lds_[];
    LAS unsigned char* lds = (LAS unsigned char*)lds_;
    const int bx = blockIdx.x, G = gridDim.x, NGW = G * 8;
#define PHASE_IDS const int lane = lane_id_now(), wave = wave_s, tid = wave_s * 64 + lane, gw = bx * 8 + wave; (void)lane; (void)gw; (void)tid; \
    const __attribute__((address_space(4))) Args* ap_ = (const __attribute__((address_space(4))) Args*)__builtin_amdgcn_kernarg_segment_ptr(); asm volatile("" : "+s"(ap_)); const Args& a = *(const Args*)ap_; \
    unsigned char* ws = a.ws; (void)ws;
    const int wave_s = __builtin_amdgcn_readfirstlane(threadIdx.x >> 6);
    volatile LAS unsigned* MISC = (volatile LAS unsigned*)(lds + MISC_OFF);
    if (threadIdx.x < 32) MISC[threadIdx.x] = 0u;
    __syncthreads();
    unsigned* ctl = (unsigned*)(a_in.ws + WS_CTL);
    XcdBarrier bar; bar.bar = ctl + CW_BAR; bar.x = 0; bar.st = MISC + 8;
    if (!MK_MULTI) bar = xcd_barrier_post(ctl + CW_BAR, MISC + 8);
    int lo = a_in.ph_lo, hi = a_in.ph_hi;
#define IN(k) (lo <= (k) && (k) < hi)
#define SEAM(k) do { if (!MK_MULTI && IN(k) && IN((k) + 1)) xcd_barrier(bar, wave_s == 0 && lane_id_now() == 0); } while (0)
#define XN ((bf16_t*)(ws + WS_XN))
#define XN2 ((bf16_t*)(ws + WS_XN2))
#define Qb ((bf16_t*)(ws + WS_Q))
#define KB ((bf16_t*)(ws + WS_KB))
#define VB ((bf16_t*)(ws + WS_VB))
#define UCAT ((bf16_t*)(ws + WS_UCAT))
#define GA ((bf16_t*)(ws + WS_GA))
#define GBb ((bf16_t*)(ws + WS_GB))
#define YG ((bf16_t*)(ws + WS_YG))
#define SSMO ((bf16_t*)(ws + WS_SSMO))
#define Y XN
#define PQ GA
#define hctx ((float*)(ws + WS_HCTX))
#define wl (ws + WS_WT + (size_t)l * WT_LAYER)
#define mod ((const float*)(ws + WS_MOD) + (size_t)l * 9 * MODW)

    if (DG(0) && IN(0)) REPS(0) { PHASE_IDS p0a(a, lds, bx, G, tid); }
    SEAM(0);
    if (DG(1) && IN(1)) { PHASE_IDS norm_pass(a, 0, 0, XN, gw, NGW, lane, NTOK, a.in[I_X]); }
    SEAM(1);

    for (int l = 0; l < DEPTH; ++l) {
        const int pb = 2 + NPH_LAYER * l;
        asm volatile("" : "+s"(lo), "+s"(hi));
        const int MR = (l + 1 < DEPTH) ? NTOK : NLAT;
        if (DG(2) && IN(pb + 0)) REPS(2) { PHASE_IDS
            ssm_tables(a, l, lds, bx, G, tid);
            pg8::Gemm g{XN, (const bf16_t*)(wl + WT_IN)}; pg8::SplitOrder S; S.init(NTOK, INW, G, bx);
            pg8::EpiIn E{ws};
            pg8::gemm_phase<DM, DM, DM, 0, 0>(lds, g, S, E, tid);
        }
        SEAM(pb + 0);
        if (DG(3) && IN(pb + 1)) REPS(3) { PHASE_IDS
            qk_pass(a, l, gw, NGW, lane);
            __syncthreads();
            pg8::Gemm g{UCAT, (const bf16_t*)(ws + WS_WSTATE)}; pg8::BatchOrder S; S.init(NCOLP / 256, 1, SG, G, (G % 8 == 0) ? (bx % 8) * (G / 8) + bx / 8 : bx);
            pg8::EpiSX E{(float*)(ws + WS_SX)};
            pg8::gemm_phase<512, KCAT, 512, (size_t)NCOLP * KCAT * 2, (size_t)256 * 512 * 2>(lds, g, S, E, tid);
        }
        SEAM(pb + 1);
        if (DG(4) && IN(pb + 2)) REPS(4) { PHASE_IDS
            float nm0;
            { float gq = fmaxf(fabsf(a.in[I_QNG][(size_t)l * HD + lane]), fabsf(a.in[I_QNG][(size_t)l * HD + 64 + lane])), gk = fmaxf(fabsf(a.in[I_KNG][(size_t)l * HD + lane]), fabsf(a.in[I_KNG][(size_t)l * HD + 64 + lane]));
#pragma unroll
              for (int o = 1; o < 64; o <<= 1) { gq = fmaxf(gq, shflx(gq, o, lane)); gk = fmaxf(gk, shflx(gk, o, lane)); }
              nm0 = -(float)HD * gq * gk * att::SCALE * 1.4426950408889634f * 1.01f; }
            for (int vb = G - 1 - bx; vb < 64; vb += G) ssm_carry(a, l, vb, tid);
            __syncthreads();
            const int x8 = bx & 7, j32 = bx >> 3;
            const int nlat = (G == 256) ? 4 : (bx < NB * NQH * 16 ? (NB * NQH * 16 - 1 - bx) / G + 1 : 0);
            const int nctx = (l + 1 < DEPTH && bx < NB * NQH) ? (NB * NQH - 1 - bx) / G + 1 : 0;
#pragma unroll 1
            for (int i = 0; i < nlat + nctx; ++i) {
                size_t qoff, koff; int seq, lpos0;
                if (i < nlat) {
                    int b, h, qb;
                    if (G == 256) { const int combo = x8 + 8 * (i >> 1), un = (i & 1) * 32 + j32; b = combo >> 1; h = (combo & 1) * 4 + (un >> 4); qb = un & 15; }
                    else { const int u = bx + i * G; b = u >> 7; h = (u >> 4) & 7; qb = u & 15; }
                    qoff = ((size_t)b * SEQ + qb * 256) * DM + h * HD; koff = (size_t)b * KVLEN * KVW + (h >> 2) * HD; seq = KVLEN; lpos0 = qb * 256;
                } else {
                    const int u = bx + (i - nlat) * G, b = u >> 3, h = u & 7;
                    qoff = ((size_t)NLAT + b * CTXL) * DM + h * HD; koff = ((size_t)b * KVLEN + SEQ) * KVW + (h >> 2) * HD; seq = CTXL; lpos0 = -1;
                }
                att::attn_dense_body_dma(Qb + qoff, KB + koff, seq, (char*)lds_, lds, wave_s * 64 + lane_id_now(), (PROBE_PHASE == 4 && rep_ + 1 < PROBE_REPS) ? (long)WS_YG - (long)WS_Q : 0L, nm0,
                                         a.in[I_QNG] + (size_t)l * HD, (const float*)(ws + WS_ROPE), lpos0, (const unsigned char*)(ws + WS_K8) + koff);
            }
        }
        SEAM(pb + 2);
        if (DG(5) && IN(pb + 3)) REPS(5) { PHASE_IDS
            pg8::Gemm g{UCAT, (const bf16_t*)(ws + WS_WCAT)}; pg8::BatchOrder S; S.init(l + 1 < DEPTH ? NCOLP / 256 : NCOLP / 256 - 1, 2, SG, G, (G % 8 == 0) ? (bx % 8) * (G / 8) + bx / 8 : bx, l + 1 < DEPTH ? NCOLP / 256 - 1 : -1);
            pg8::EpiS3 E{UCAT, a.in[I_SD] + (size_t)l * SSMW, YG};
            pg8::gemm_phase<KCAT, KCAT, KCAT, (size_t)NCOLP * KCAT * 2, (size_t)512 * KCAT * 2>(lds, g, S, E, tid);
        }
        SEAM(pb + 3);
        if (DG(6) && IN(pb + 4)) REPS(6) { PHASE_IDS
            pg8::Gemm g{YG, (const bf16_t*)(wl + WT_GLU)}; pg8::SplitOrder S; S.init(MR, SSMW, G, bx);
            pg8::EpiGlu E{YG, a.in[I_BGLU] + (size_t)l * SSMW, SSMO};
            pg8::gemm_phase<SSMW, SSMW, SSMW, 0, 0>(lds, g, S, E, tid);
        }
        SEAM(pb + 4);
        if (DG(7) && IN(pb + 5)) REPS(7) { PHASE_IDS
            pg8::SplitOrder S; S.init(MR, DM, G, bx);
            { pg8::Gemm g{Qb, (const bf16_t*)(wl + WT_BA)}; pg8::EpiMerge<false> E{GA, Y}; pg8::gemm_phase<DM, DM, DM, 0, 0>(lds, g, S, E, tid); }
            { pg8::Gemm g{SSMO, (const bf16_t*)(wl + WT_BS)}; pg8::EpiMerge<true> E{GBb, Y}; pg8::gemm_phase<SSMW, SSMW, SSMW, 0, 0>(lds, g, S, E, tid); }
        }
        SEAM(pb + 5);
        if (DG(8) && IN(pb + 6)) REPS(8) { PHASE_IDS
            pg8::Gemm g{Y, (const bf16_t*)(wl + WT_O)}; pg8::SplitOrder S; S.init(MR, DM, G, bx);
            pg8::EpiWo E{l == 0 ? a.in[I_X] : (const float*)a.out, a.out, hctx, mod + 2 * DM};
            pg8::gemm_phase<DM, DM, DM, 0, 0>(lds, g, S, E, tid);
        }
        SEAM(pb + 6);
        if (DG(9) && IN(pb + 7)) REPS(9) { PHASE_IDS norm_pass(a, l, 1, XN2, gw, NGW, lane, MR, a.out); }
        SEAM(pb + 7);
        if (DG(10) && IN(pb + 8)) REPS(10) { PHASE_IDS
            pg8::Gemm g{XN2, (const bf16_t*)(wl + WT_Q)}; pg8::SplitOrder S; S.init(MR, PQW, G, bx);
            pg8::EpiBf16 E{PQ, PQW};
            pg8::gemm_phase<DM, DM, DM, 0, 0>(lds, g, S, E, tid);
        }
        SEAM(pb + 8);
        if (DG(11) && IN(pb + 9)) REPS(11) { PHASE_IDS peer_topk(a, l, lds, gw, NGW, tid, MR, PROBE_PHASE == 11 && rep_ + 1 < PROBE_REPS); }
        SEAM(pb + 9);
    }
#undef IN
#undef SEAM
}

extern "C" void kernel_launch(void* const* d_in, const int* in_sizes, int n_in, void* d_out, int out_size, void* d_ws, size_t ws_size, hipStream_t stream) {
    static int grid = 0;
    if (grid == 0) {
        if (n_in != 28 || out_size != NLAT * DM || ws_size < WS_END) { fprintf(stderr, "kernel_launch: unexpected shapes (n_in %d out %d ws %zu, need ws >= %zu)\n", n_in, out_size, ws_size, (size_t)WS_END); grid = -1; return; }
        int dev = 0, cus = 0;
        if (hipGetDevice(&dev) != hipSuccess || hipDeviceGetAttribute(&cus, hipDeviceAttributeMultiprocessorCount, dev) != hipSuccess) { grid = -1; return; }
        if (hipFuncSetAttribute((const void*)mega_fwd, hipFuncAttributeMaxDynamicSharedMemorySize, LDS_BYTES) != hipSuccess) { fprintf(stderr, "kernel_launch: hipFuncSetAttribute failed\n"); grid = -1; return; }
        int per_cu = 0;
        if (hipOccupancyMaxActiveBlocksPerMultiprocessor(&per_cu, (const void*)mega_fwd, 512, LDS_BYTES) != hipSuccess || per_cu < 1) fprintf(stderr, "kernel_launch: occupancy query reports %d\n", per_cu);
        (void)hipGetLastError();
        grid = cus;
    }
    if (grid < 0) return;
    (void)hipMemsetAsync((char*)d_ws + WS_CTL, 0, CTL_ZERO_BYTES, stream);
    Args a{};
    for (int i = 0; i < 28; ++i) a.in[i] = (const float*)d_in[i];
    a.out = (float*)d_out; a.ws = (unsigned char*)d_ws;
#if MK_MULTI
    for (int p = 0; p < NPHASE; ++p) { a.ph_lo = p; a.ph_hi = p + 1; hipLaunchKernelGGL(mega_fwd, dim3(grid), dim3(512), LDS_BYTES, stream, a); }
#else
    a.ph_lo = 0; a.ph_hi = NPHASE;
    hipLaunchKernelGGL(mega_fwd, dim3(grid), dim3(512), LDS_BYTES, stream, a);
#endif
    const hipError_t le = hipPeekAtLastError();
    if (le != hipSuccess) fprintf(stderr, "kernel_launch: launch failed: %s\n", hipGetErrorName(le));
}
```

```cpp
#include <hip/hip_runtime.h>
#include <cstdio>
#include <cstdint>

#define GAS __attribute__((address_space(1)))
#define LAS __attribute__((address_space(3)))
typedef unsigned short bf16_t;
typedef short bf16x8 __attribute__((ext_vector_type(8)));
typedef short s16x4 __attribute__((ext_vector_type(4)));
typedef float f32x2 __attribute__((ext_vector_type(2)));
typedef float f32x4 __attribute__((ext_vector_type(4)));
typedef float f32x16 __attribute__((ext_vector_type(16)));
typedef unsigned u32x2 __attribute__((ext_vector_type(2)));
typedef unsigned u32x4 __attribute__((ext_vector_type(4)));

#ifndef MK_MULTI
#define MK_MULTI 0
#endif
#ifndef DIAG_MASK
#define DIAG_MASK 0xFFFF
#endif
#define DG(k) ((DIAG_MASK >> (k)) & 1)
#ifndef PEER_FP4
#define PEER_FP4 1
#endif
#ifndef PROBE_PHASE
#define PROBE_PHASE -1
#endif
#ifndef PROBE_REPS
#define PROBE_REPS 1
#endif
#define REPS(k) _Pragma("unroll 1") for (int rep_ = 0; rep_ < ((PROBE_PHASE == (k)) ? PROBE_REPS : 1); ++rep_)
#ifndef EN_ATTN
#define EN_ATTN 1
#endif
#ifndef EN_SSM
#define EN_SSM 1
#endif
#ifndef EN_PEER
#define EN_PEER 1
#endif

constexpr int DM = 1024, NB = 8, SEQ = 4096, DEPTH = 4, CTXL = 256;
constexpr int NLAT = NB * SEQ, NCTX = NB * CTXL, NTOK = NLAT + NCTX;
constexpr int HD = 128, NQH = 8, NKVH = 2, KVW = NKVH * HD, KVLEN = SEQ + CTXL;
constexpr int SSMW = 512, SG = 32, SP = 16, SN = 64, ST = 32;
constexpr int NCH = KVLEN / ST, NCHL = SEQ / ST, NCOL = NB * NCH, NCOLP = 1280, KCAT = 768;
constexpr int INW = 4096, NMOD = 6, MODW = NMOD * DM;
constexpr int PH = 8, PKEYS = 128, PEXP = PKEYS * PKEYS, PQW = 2048, PTOPK = 16;
constexpr float EPS = 1e-6f;

constexpr size_t MiB = 1u << 20;
constexpr size_t WS_CTL = 0, CTL_ZERO_BYTES = 64 * 1024;
constexpr size_t WS_MOD = 1 * MiB;
constexpr size_t WS_ROPE = 2 * MiB;
constexpr size_t WS_KEYS = 3 * MiB;
constexpr size_t WS_HCTX = 4 * MiB;
constexpr size_t WS_WT = 12 * MiB;
constexpr size_t WT_IN = 0, WT_BA = 8 * MiB, WT_BS = 10 * MiB, WT_O = 11 * MiB, WT_GLU = 13 * MiB, WT_Q = 13 * MiB + 512 * 1024, WT_LAYER = 17 * MiB + 512 * 1024;
constexpr size_t WS_WCAT = 82 * MiB;
constexpr size_t WS_WSTATE = 106 * MiB;
constexpr size_t WS_UCAT = 114 * MiB;
constexpr size_t WS_SX = 174 * MiB;
constexpr size_t WS_XN = 214 * MiB;
constexpr size_t WS_XN2 = 282 * MiB;
constexpr size_t WS_Q = 350 * MiB;
constexpr size_t WS_KB = 418 * MiB, WS_VB = 435 * MiB;
constexpr size_t WS_GA = 452 * MiB, WS_GB = 520 * MiB;
constexpr size_t WS_YG = 588 * MiB, WS_SSMO = 622 * MiB;
constexpr size_t WS_V8T = 672 * MiB;
constexpr size_t WS_K8 = 656 * MiB;
constexpr size_t WS_PU = 690 * MiB, WS_PV = 754 * MiB;
constexpr int PROW = PEER_FP4 ? 512 : 768;
constexpr float QMAX = PEER_FP4 ? 6.0f : 7.5f;
constexpr size_t WS_PSU = 818 * MiB, WS_PSV = 819 * MiB;
constexpr size_t WS_END = 820 * MiB;
constexpr int CW_BAR = 1024;

constexpr int RING_BYTES = 131072;
constexpr int MISC_OFF = RING_BYTES;
constexpr int LDS_BYTES = 147456;

__device__ __forceinline__ unsigned f2bf(float f) { unsigned u = __builtin_bit_cast(unsigned, f); return (u + 0x7fffu + ((u >> 16) & 1u)) >> 16; }
__device__ __forceinline__ unsigned pk2(float lo, float hi) { return f2bf(lo) | (f2bf(hi) << 16); }
__device__ __forceinline__ unsigned cvt_pk_bf16(float lo, float hi) { unsigned r; asm volatile("v_cvt_pk_bf16_f32 %0, %1, %2" : "=v"(r) : "v"(lo), "v"(hi)); return r; }
__device__ __forceinline__ float bflo(unsigned w) { return __builtin_bit_cast(float, w << 16); }
__device__ __forceinline__ float bfhi(unsigned w) { return __builtin_bit_cast(float, w & 0xffff0000u); }
__device__ __forceinline__ int lane_id_now() { int l_; asm volatile("v_mbcnt_lo_u32_b32 %0, -1, 0\n\tv_mbcnt_hi_u32_b32 %0, -1, %0" : "=v"(l_)); return l_; }
__device__ __forceinline__ float shflx(float v, int o, int lane) { return __builtin_bit_cast(float, __builtin_amdgcn_ds_bpermute((lane ^ o) << 2, __builtin_bit_cast(int, v))); }
__device__ __forceinline__ float wave_sum(float v, int lane) {
#pragma unroll
    for (int o = 1; o < 64; o <<= 1) v += shflx(v, o, lane);
    return v;
}
__device__ __forceinline__ float sigmoidf_(float x) { return __builtin_amdgcn_rcpf(1.0f + __builtin_amdgcn_exp2f(-1.4426950408889634f * x)); }
__device__ __forceinline__ float gelu_tanh(float x) {
    const float z = 0.7978845608028654f * (x + 0.044715f * x * x * x);
    const float t = 1.0f - 2.0f * __builtin_amdgcn_rcpf(__builtin_amdgcn_exp2f(2.0f * 1.4426950408889634f * z) + 1.0f);
    return 0.5f * x * (1.0f + t);
}
__device__ __forceinline__ u32x4 pack8(const f32x4 a, const f32x4 b) {
    u32x4 w; w.x = cvt_pk_bf16(a[0], a[1]); w.y = cvt_pk_bf16(a[2], a[3]); w.z = cvt_pk_bf16(b[0], b[1]); w.w = cvt_pk_bf16(b[2], b[3]); return w;
}
__device__ __forceinline__ void unpack8(const u32x4 w, f32x4& a, f32x4& b) {
    a[0] = bflo(w.x); a[1] = bfhi(w.x); a[2] = bflo(w.y); a[3] = bfhi(w.y); b[0] = bflo(w.z); b[1] = bfhi(w.z); b[2] = bflo(w.w); b[3] = bfhi(w.w);
}
__device__ __forceinline__ int modrow_of(int r) { return r < NLAT ? (r >> 12) : NB; }
__device__ __forceinline__ int kvrow_of(int r) { if (r < NLAT) return (r >> 12) * KVLEN + (r & 4095); const int q = r - NLAT; return (q >> 8) * KVLEN + SEQ + (q & 255); }

#define XB_TMO      128
#define XB_XCNT(j)  (256  + 64 * (j))
#define XB_XSUB(j)  (1280 + 64 * (j))
#define XB_XGEN(j)  (2304 + 64 * (j))
#define XB_TOP      3328
#define XB_TOPGEN   3392
#define XCD_BAR_WORDS 3456
#define XB_SPIN_CAP (1u << 18)
__device__ __forceinline__ unsigned xb_ld(unsigned* p)              { return __hip_atomic_load(p, __ATOMIC_RELAXED, __HIP_MEMORY_SCOPE_AGENT); }
__device__ __forceinline__ unsigned xb_add(unsigned* p, unsigned v) { return __hip_atomic_fetch_add(p, v, __ATOMIC_RELAXED, __HIP_MEMORY_SCOPE_AGENT); }
__device__ __forceinline__ unsigned xb_xcc_id() { return (unsigned)__builtin_amdgcn_s_getreg((3 << 11) | 20) & 0xFu; }
#define XB_SPIN(cond, bar) do { unsigned _sp = 0; while (cond) { __builtin_amdgcn_s_sleep(1); \
    if ((++_sp & 255u) == 0u) { if (xb_ld(&(bar)[XB_TMO])) break; if (_sp > XB_SPIN_CAP) { atomicAdd(&(bar)[XB_TMO], 1u); break; } } } } while (0)
struct XcdBarrier { unsigned* bar; unsigned x; volatile LAS unsigned* st; };
__device__ __forceinline__ XcdBarrier xcd_barrier_post(unsigned* bar, volatile LAS unsigned* st) {
    XcdBarrier b; b.bar = bar; b.x = xb_xcc_id(); b.st = st;
    if (threadIdx.x == 0) (void)xb_add(&bar[XB_XCNT(b.x)], 1u);
    return b;
}
__device__ __forceinline__ void xcd_barrier_complete(unsigned* bar, unsigned x, unsigned& nloc, unsigned& nx) {
    const unsigned G = gridDim.x * gridDim.y * gridDim.z;
    unsigned sum, cnt, mine, sp = 0u;
    for (;;) {
        sum = 0u; cnt = 0u; mine = 0u;
#pragma unroll
        for (unsigned j = 0; j < 16; ++j) { const unsigned c = xb_ld(&bar[XB_XCNT(j)]); sum += c; cnt += (c > 0u) ? 1u : 0u; mine = (j == x) ? c : mine; }
        if (sum == G) break;
        __builtin_amdgcn_s_sleep(1);
        if ((++sp & 255u) == 0u) { if (xb_ld(&bar[XB_TMO])) break; if (sp > XB_SPIN_CAP) { atomicAdd(&bar[XB_TMO], 1u); break; } }
    }
    nloc = mine > 0u ? mine : 1u; nx = cnt > 0u ? cnt : 1u;
}
__device__ __forceinline__ void xcd_barrier(const XcdBarrier& b, const bool t0  ) {
    asm volatile("s_waitcnt vmcnt(0)" ::: "memory");
    __syncthreads();
    if (t0) {
        unsigned* bar = b.bar;
        __builtin_amdgcn_s_waitcnt(0);
        unsigned nloc = b.st[0], nx = b.st[1];
        if (nloc == 0u) { unsigned x_ = b.x; asm volatile("" : "+s"(x_));
            xcd_barrier_complete(bar, x_, nloc, nx); b.st[0] = nloc; b.st[1] = nx; }
        const unsigned old = xb_add(&bar[XB_XSUB(b.x)], 1u);
        const unsigned gen = old / nloc;
        if (old + 1u == (gen + 1u) * nloc) {
            __builtin_amdgcn_fence(__ATOMIC_RELEASE, "agent");
            asm volatile("s_waitcnt vmcnt(0)" ::: "memory");
            const unsigned og = xb_add(&bar[XB_TOP], 1u);
            const unsigned tg = og / nx;
            if (og + 1u == (tg + 1u) * nx) xb_add(&bar[XB_TOPGEN], 1u);
            else XB_SPIN(xb_ld(&bar[XB_TOPGEN]) == tg, bar);
            __builtin_amdgcn_fence(__ATOMIC_ACQUIRE, "agent");
            xb_add(&bar[XB_XGEN(b.x)], 1u);
            asm volatile("s_waitcnt vmcnt(0)" ::: "memory");
        } else {
            XB_SPIN(xb_ld(&bar[XB_XGEN(b.x)]) == gen, bar);
            __builtin_amdgcn_fence(__ATOMIC_ACQUIRE, "agent");
            asm volatile("s_waitcnt vmcnt(0)" ::: "memory");
        }
    }
    __syncthreads();
}

namespace pg8 {
constexpr int BM = 256, BK = 64, HALF = 128, HTB = HALF * BK * 2, STAGE_BYTES = 8 * HTB, NXCD = 8, WGM = 8;
__host__ __device__ __forceinline__ int lds_byte(int r, int c) { const int st = (r >> 4) * 2 + (c >> 5), rr = r & 15, cc = c & 31, ob = rr * 64 + cc * 2; return st * 1024 + (ob ^ (((ob >> 9) & 1) << 5)); }
__host__ __device__ __forceinline__ void stage_rc(int b, int& R, int& C) { const int st = b / 1024, sb = b % 1024, swz = sb ^ (((sb >> 9) & 1) << 5); R = (st >> 1) * 16 + swz / 64; C = (st & 1) * 32 + (swz % 64) / 2; }
__host__ __device__ __forceinline__ int perm32(int rho) { const int n = rho >> 4, i = rho & 15; return 8 * (i >> 2) + 4 * n + (i & 3); }

struct Unit { int pm, pn, pb, hm; };
struct Gemm { const bf16_t* A; const bf16_t* Bt; };

struct StaticOrder {
    int nM, nN, nwg, G, c;
    __device__ void init(int M, int N, int G_, int c_) { nM = M / BM; nN = N / BM; nwg = nM * nN; G = G_; c = c_; }
    __device__ void map(int wgid, int& pm, int& pn) const {
        { const int q = nwg / NXCD, r = nwg % NXCD, xcd = wgid % NXCD, off = wgid / NXCD; wgid = (xcd < r ? xcd * (q + 1) : r * (q + 1) + (xcd - r) * q) + off; }
        const int nig = WGM * nN, gid = wgid / nig, fm = gid * WGM, gsz = (nM - fm) < WGM ? (nM - fm) : WGM;
        pm = fm + ((wgid % nig) % gsz); pn = (wgid % nig) / gsz;
    }
    __device__ bool next(int i, Unit& u) const {
        const long L = (long)i * G + c; if (L >= nwg) return false;
        int pm, pn; map((int)L, pm, pn); u.pm = pm; u.pn = pn; u.pb = 0; u.hm = -1; return true;
    }
};
struct SplitOrder {
    StaticOrder lat; int nN, nLat, nH, G, c;
    __device__ void init(int M, int N, int G_, int c_) { lat.init(NLAT, N, G_, c_); nN = N / BM; nLat = lat.nwg; nH = M > NLAT ? ((M - NLAT) / HALF) * nN : 0; G = G_; c = c_; }
    __device__ bool next(int i, Unit& u) const {
        const long L = (long)i * G + c; if (L >= (long)nLat + nH) return false;
        const bool isl = L < nLat;
        int pmL, pnL; lat.map(isl ? (int)L : 0, pmL, pnL);
        const int h = isl ? 0 : (int)(L - nLat);
        const int per = 2 * nN, hu = (nH % NXCD == 0) ? (h % NXCD) * (nH / NXCD) + h / NXCD : h, t = hu / per, j = hu - t * per;
        u.pm = isl ? pmL : NLAT / BM + t; u.pn = isl ? pnL : (j >> 1); u.pb = 0; u.hm = isl ? -1 : (j & 1); return true;
    }
};
struct BatchOrder {
    int nM, nN, nb, G, c, tailM;
    __device__ void init(int nM_, int nN_, int nb_, int G_, int c_, int tailM_ = -1) { nM = nM_; nN = nN_; nb = nb_; G = G_; c = c_; tailM = tailM_; }
    __device__ bool next(int i, Unit& u) const {
        const long L = (long)i * G + c; if (L >= (long)nM * nN * nb) return false;
        const int nMf = tailM >= 0 ? nM - 1 : nM, per = nMf * nN, nfull = per * nb, l = (int)L; const bool full = l < nfull;
        const int lf = full ? l : 0, pbF = lf / per, rF = lf - pbF * per, pnF = rF / nMf, pmF = rF - pnF * nMf;
        const int rT = full ? 0 : l - nfull, pbT = rT / nN, pnT = rT - pbT * nN;
        u.pb = full ? pbF : pbT; u.pn = full ? pnF : pnT; u.pm = full ? pmF : tailM; u.hm = full ? -1 : 0; return true;
    }
};

template <int K, int LDA, int LDB, size_t SA, size_t SB, class Epi, class Sched>
__device__ __forceinline__ void gemm_phase(LAS unsigned char* lds, const Gemm g, const Sched& S, const Epi& E, const int tid) {
    static_assert(Epi::PERM, "all epilogues here use the permuted column map");
    const int wid = __builtin_amdgcn_readfirstlane(tid >> 6), lane = tid & 63, wr = wid >> 2, wc = wid & 3, fr = lane & 15, fq = lane >> 4;
    constexpr int nt = K / BK;
    unsigned voffA[2], voffB[2];
#pragma unroll
    for (int i = 0; i < 2; ++i) { int R, C; stage_rc(tid * 16 + i * 8192, R, C); const int Rb = (R & ~31) + perm32(R & 31);
        voffA[i] = (unsigned)(R * LDA + C) * 2u; voffB[i] = (unsigned)(Rb * LDB + C) * 2u; }
    constexpr size_t kstep = (size_t)(BK * 2);
    constexpr size_t hstepA = (size_t)HALF * LDA * 2, hstepB = (size_t)HALF * LDB * 2;
    constexpr size_t tstepA = 2 * hstepA, tstepB = 2 * hstepB;
    const unsigned ldsw = (unsigned)wid * 1024u;
    const int aoff = lds_byte(wr * 64 + fr, fq * 8), boff = lds_byte(wc * 32 + fr, fq * 8);
#define PG8_SA(b, h) (((b) * 2 + (h)) * HTB)
#define PG8_SB(b, h) ((4 + (b) * 2 + (h)) * HTB)
#define PG8_STAGE(bufoff, gbase, voff) do { _Pragma("unroll") for (int _i = 0; _i < 2; ++_i) \
        __builtin_amdgcn_global_load_lds((const unsigned*)((const char*)(gbase) + (voff)[_i]), (LAS unsigned*)(lds + (bufoff) + ldsw + _i * 8192), 16, 0, 0); } while (0)
#define PG8_LDA(dst, b, h) do { _Pragma("unroll") for (int m = 0; m < 4; ++m) _Pragma("unroll") for (int k = 0; k < 2; ++k) dst[m][k] = *(const LAS bf16x8*)(lds + PG8_SA(b, h) + aoff + m * 2048 + k * 1024); } while (0)
#define PG8_LDB(dst, b, h) do { _Pragma("unroll") for (int n = 0; n < 2; ++n) _Pragma("unroll") for (int k = 0; k < 2; ++k) dst[n][k] = *(const LAS bf16x8*)(lds + PG8_SB(b, h) + boff + n * 2048 + k * 1024); } while (0)
#define PG8_MMA(ai, bj, At, Bt) do { __builtin_amdgcn_s_setprio(1); _Pragma("unroll") for (int m = 0; m < 4; ++m) _Pragma("unroll") for (int n = 0; n < 2; ++n) _Pragma("unroll") for (int k = 0; k < 2; ++k) \
        acc[ai][bj][m][n] = __builtin_amdgcn_mfma_f32_16x16x32_bf16(Bt[n][k], At[m][k], acc[ai][bj][m][n], 0, 0, 0); __builtin_amdgcn_s_setprio(0); } while (0)
#define PG8_WAIT_V(n) asm volatile("s_waitcnt vmcnt(" #n ")" ::: "memory")
#define PG8_WAIT_L(n) asm volatile("s_waitcnt lgkmcnt(" #n ")" ::: "memory")
#define PG8_BAR __builtin_amdgcn_s_barrier()
#define PG8_SCHED __builtin_amdgcn_sched_barrier(0)
    Unit cur, nxt; int ui = 0;
    if (!S.next(0, cur)) return;
    f32x4 acc[2][2][4][2];
#pragma unroll
    for (int a = 0; a < 2; ++a)
#pragma unroll
        for (int b = 0; b < 2; ++b)
#pragma unroll
            for (int m = 0; m < 4; ++m)
#pragma unroll
                for (int n = 0; n < 2; ++n) acc[a][b][m][n] = (f32x4){0.f, 0.f, 0.f, 0.f};
    bf16x8 At[4][2], B0[2][2], B1[2][2];
    const char* cA = (const char*)g.A + (size_t)cur.pb * SA + (size_t)cur.pm * tstepA + (cur.hm > 0 ? hstepA : (size_t)0); const char* cB = (const char*)g.Bt + (size_t)cur.pb * SB + (size_t)cur.pn * tstepB;
    unsigned cH = cur.hm < 0 ? (unsigned)hstepA : 0u;
    PG8_STAGE(PG8_SB(0, 0), cB, voffB); PG8_STAGE(PG8_SB(0, 1), cB + hstepB, voffB); PG8_STAGE(PG8_SA(0, 0), cA, voffA); PG8_STAGE(PG8_SA(0, 1), cA + cH, voffA);
    if (wr == 1) PG8_BAR;
    PG8_WAIT_V(2); PG8_BAR;
    PG8_STAGE(PG8_SB(1, 0), cB + kstep, voffB); PG8_STAGE(PG8_SA(1, 0), cA + kstep, voffA); PG8_STAGE(PG8_SB(1, 1), cB + hstepB + kstep, voffB);
    PG8_WAIT_V(6); PG8_BAR;
    for (;;) {
        const bool has_next = S.next(ui + 1, nxt);
        const char* nA = has_next ? (const char*)g.A + (size_t)nxt.pb * SA + (size_t)nxt.pm * tstepA + (nxt.hm > 0 ? hstepA : (size_t)0) : cA; const char* nB = has_next ? (const char*)g.Bt + (size_t)nxt.pb * SB + (size_t)nxt.pn * tstepB : cB;
        const unsigned nH = has_next ? (nxt.hm < 0 ? (unsigned)hstepA : 0u) : cH;
        const bool whole = cur.hm < 0;
        for (int t = 0; t < nt; t += 2) {
            const bool last = (t == nt - 2);
            const char* a1 = cA + (size_t)(t + 1) * kstep;
            const char* a2 = last ? nA : cA + (size_t)(t + 2) * kstep; const char* b2 = last ? nB : cB + (size_t)(t + 2) * kstep; const unsigned h2 = last ? nH : cH;
            const char* a3 = a2 + kstep; const char* b3 = b2 + kstep;
            PG8_LDB(B0, 0, 0); PG8_LDB(B1, 0, 1); PG8_SCHED; PG8_LDA(At, 0, 0); PG8_STAGE(PG8_SA(1, 1), a1 + cH, voffA);
            PG8_WAIT_V(8); PG8_WAIT_L(0); PG8_BAR; PG8_MMA(0, 0, At, B0); PG8_MMA(0, 1, At, B1); PG8_BAR; PG8_SCHED;
            PG8_LDA(At, 0, 1); PG8_STAGE(PG8_SB(0, 0), b2, voffB); PG8_STAGE(PG8_SB(0, 1), b2 + hstepB, voffB); PG8_STAGE(PG8_SA(0, 0), a2, voffA);
            PG8_WAIT_V(8); PG8_WAIT_L(0); PG8_BAR; if (whole) { PG8_MMA(1, 0, At, B0); PG8_MMA(1, 1, At, B1); } PG8_BAR; PG8_SCHED;
            PG8_LDB(B0, 1, 0); PG8_LDB(B1, 1, 1); PG8_SCHED; PG8_LDA(At, 1, 0); PG8_STAGE(PG8_SA(0, 1), a2 + h2, voffA);
            PG8_WAIT_V(8); PG8_WAIT_L(0); PG8_BAR; PG8_MMA(0, 0, At, B0); PG8_MMA(0, 1, At, B1); PG8_BAR; PG8_SCHED;
            PG8_LDA(At, 1, 1); PG8_STAGE(PG8_SB(1, 0), b3, voffB); PG8_STAGE(PG8_SB(1, 1), b3 + hstepB, voffB); PG8_STAGE(PG8_SA(1, 0), a3, voffA);
            PG8_WAIT_V(8); PG8_WAIT_L(0); PG8_BAR; if (whole) { PG8_MMA(1, 0, At, B0); PG8_MMA(1, 1, At, B1); } PG8_BAR; PG8_SCHED;
        }
        if (wr == 0) PG8_BAR;
        E(acc, cur, wr, wc, fr, fq);
        if (!has_next) break;
#pragma unroll
        for (int a = 0; a < 2; ++a)
#pragma unroll
            for (int b = 0; b < 2; ++b)
#pragma unroll
                for (int m = 0; m < 4; ++m)
#pragma unroll
                    for (int n = 0; n < 2; ++n) acc[a][b][m][n] = (f32x4){0.f, 0.f, 0.f, 0.f};
        cur = nxt; cA = nA; cB = nB; cH = nH; ++ui;
        if (wr == 1) PG8_BAR;
    }
    PG8_WAIT_V(0);
    PG8_BAR;
#undef PG8_SA
#undef PG8_SB
#undef PG8_STAGE
#undef PG8_LDA
#undef PG8_LDB
#undef PG8_MMA
#undef PG8_WAIT_V
#undef PG8_WAIT_L
#undef PG8_BAR
#undef PG8_SCHED
}

#define EPI_ON (uhm_ < 0 || ai == uhm_)
#define EPI_ACC(k_) ((ai == 1 && uhm_ >= 0) ? acc[0][bj][m][k_] : acc[ai][bj][m][k_])
#define EPI_FOR _Pragma("unroll") for (int ai = 0; ai < 2; ++ai) if (EPI_ON) _Pragma("unroll") for (int m = 0; m < 4; ++m) _Pragma("unroll") for (int bj = 0; bj < 2; ++bj)
#define EPI_COORDS const int ln_ = lane_id_now(), wr = wr_, wc = wc_, fr = ln_ & 15, fq = ln_ >> 4, uhm_ = u.hm;
#define EPI_V const f32x4 v0 = EPI_ACC(0), v1 = EPI_ACC(1);

struct EpiIn {
    static constexpr bool PERM = true;
    unsigned char* ws;
    __device__ __forceinline__ void operator()(const f32x4 (&acc)[2][2][4][2], const Unit& u, int wr_, int wc_, int fr_, int fq_) const {
        EPI_COORDS
        const int pn = u.pn, r0 = u.pm * BM, rl = wr * 64 + fr, cl0 = wc * 32 + 8 * fq;
        size_t boff; long sA, sM1, sM0, sB;
        if (pn == 4 || pn == 5) {
            int kv0; if (r0 < NLAT) kv0 = (r0 >> 12) * KVLEN + (r0 & 4095); else kv0 = ((r0 - NLAT) >> 8) * KVLEN + SEQ;
            boff = WS_KB + (size_t)(pn - 4) * (WS_VB - WS_KB) + ((size_t)(kv0 + rl) * KVW + cl0) * 2; sA = 128 * KVW; sM1 = 32 * KVW; sM0 = 16 * KVW; sB = 128;
        } else if (pn == 6 || pn == 7) {
            int col0; if (r0 < NLAT) col0 = ((r0 & 4095) >> 5) * 8 + (r0 >> 12); else col0 = NCHL * 8 + ((r0 - NLAT) >> 8);
            boff = WS_UCAT + ((size_t)(((pn - 6) * 16 + wc * 2 + (fq >> 1)) * NCOLP + col0 + wr * 16) * KCAT + fr * SP + (fq & 1) * 8) * 2;
            sA = (long)32 * KCAT; sM1 = (long)8 * KCAT; sM0 = 16 * SP; sB = (long)8 * NCOLP * KCAT;
        } else {
            const int grp = pn < 4 ? 0 : (pn < 12 ? 1 : 2), pc = pn - (grp == 0 ? 0 : (grp == 1 ? 8 : 12));
            const size_t tb = WS_Q + (size_t)grp * (WS_GA - WS_Q) - (grp == 2 ? (size_t)((WS_GA - WS_Q) - (WS_GB - WS_GA)) : 0);
            boff = tb + ((size_t)(r0 + rl) * DM + pc * 256 + cl0) * 2; sA = 128 * DM; sM1 = 32 * DM; sM0 = 16 * DM; sB = 128;
        }
        bf16_t* base = (bf16_t*)(ws + boff);
        EPI_FOR { EPI_V *(u32x4*)(base + ai * sA + (m >> 1) * sM1 + (m & 1) * sM0 + bj * sB) = pack8(v0, v1); }
    }
};
struct EpiBf16 {
    static constexpr bool PERM = true;
    bf16_t* O; int ldc;
    __device__ __forceinline__ void operator()(const f32x4 (&acc)[2][2][4][2], const Unit& u, int wr_, int wc_, int fr_, int fq_) const {
        EPI_COORDS
        bf16_t* base = O + (size_t)(u.pm * BM + wr * 64 + fr) * ldc + u.pn * BM + wc * 32 + 8 * fq; const long sR = (long)16 * ldc;
        EPI_FOR { EPI_V *(u32x4*)(base + (ai * 8 + m) * sR + bj * 128) = pack8(v0, v1); }
    }
};
struct EpiSX {
    static constexpr bool PERM = true;
    float* SX;
    __device__ __forceinline__ void operator()(const f32x4 (&acc)[2][2][4][2], const Unit& u, int wr_, int wc_, int fr_, int fq_) const {
        EPI_COORDS
        float* base = SX + ((size_t)(u.pb * NCOLP + u.pm * BM + wr * 64 + fr) * 256 + wc * 32 + 8 * fq);
        const bool tail = (u.pm == 4);
        EPI_FOR { EPI_V if (!tail || (ai == 0 && wr == 0)) { float* d = base + (ai * 8 + m) * (16 * 256) + bj * 128; *(f32x4*)d = v0; *(f32x4*)(d + 4) = v1; } }
    }
};
#define EPI_GROUPS _Pragma("unroll") for (int ai = 0; ai < 2; ++ai) if (EPI_ON) _Pragma("unroll") for (int mh = 0; mh < 2; ++mh)
#define EPI_IN_GROUP _Pragma("unroll") for (int e_ = 0; e_ < 4; ++e_)
#define EPI_GIDX const int m = 2 * mh + (e_ >> 1), bj = e_ & 1; (void)m; (void)bj;
struct EpiS3 {
    static constexpr bool PERM = true;
    const bf16_t* UCAT; const float* dsk; bf16_t* YG;
    __device__ __forceinline__ void operator()(const f32x4 (&acc)[2][2][4][2], const Unit& u, int wr_, int wc_, int fr_, int fq_) const {
        EPI_COORDS
        const int gg = u.pb, b = fr & 7, p0 = (fq & 1) * 8, tl = u.pn * 16 + wc * 2 + (fq >> 1);
        const bool tail = (u.pm == 4);
        const int tok0 = tail ? NLAT + b * CTXL + (fr >> 3) * ST + tl : b * SEQ + (u.pm * 32 + wr * 8 + (fr >> 3)) * ST + tl;
        const bf16_t* ub = UCAT + ((size_t)(gg * NCOLP + u.pm * BM + wr * 64 + fr) * KCAT + tl * SP + p0);
        bf16_t* yb = YG + (size_t)tok0 * SSMW + gg * SP + p0;
        const f32x4 d0 = *(const f32x4*)(dsk + gg * SP + p0), d1 = *(const f32x4*)(dsk + gg * SP + p0 + 4);
        EPI_GROUPS { if (!tail || (ai == 0 && wr == 0)) {
            u32x4 uw[4];
            EPI_IN_GROUP { EPI_GIDX uw[e_] = *(const u32x4*)(ub + (size_t)(ai * 128 + m * 16) * KCAT + bj * 8 * SP); }
            EPI_IN_GROUP { EPI_GIDX const f32x4 v0 = EPI_ACC(0), v1 = EPI_ACC(1);
                f32x4 u0, u1; unpack8(uw[e_], u0, u1);
                f32x4 y0 = v0 + d0 * u0, y1 = v1 + d1 * u1;
#pragma unroll
                for (int i = 0; i < 4; ++i) { y0[i] = gelu_tanh(y0[i]); y1[i] = gelu_tanh(y1[i]); }
                *(u32x4*)(yb + (size_t)((ai * 16 + m * 2) * ST + bj * 8) * SSMW) = pack8(y0, y1); } } }
    }
};
struct EpiGlu {
    static constexpr bool PERM = true;
    const bf16_t* YG; const float* bias; bf16_t* O;
    __device__ __forceinline__ void operator()(const f32x4 (&acc)[2][2][4][2], const Unit& u, int wr_, int wc_, int fr_, int fq_) const {
        EPI_COORDS
        const int c0 = u.pn * BM + wc * 32 + 8 * fq; const size_t off = (size_t)(u.pm * BM + wr * 64 + fr) * SSMW + c0;
        f32x4 bb[2][2];
#pragma unroll
        for (int bj = 0; bj < 2; ++bj) { bb[bj][0] = *(const f32x4*)(bias + c0 + bj * 128); bb[bj][1] = *(const f32x4*)(bias + c0 + bj * 128 + 4); }
        EPI_GROUPS {
            u32x4 yw[4];
            EPI_IN_GROUP { EPI_GIDX yw[e_] = *(const u32x4*)(YG + off + (size_t)(ai * 128 + m * 16) * SSMW + bj * 128); }
            EPI_IN_GROUP { EPI_GIDX const f32x4 v0 = EPI_ACC(0), v1 = EPI_ACC(1);
                f32x4 y0, y1; unpack8(yw[e_], y0, y1);
                f32x4 o0, o1;
#pragma unroll
                for (int i = 0; i < 4; ++i) { o0[i] = y0[i] * sigmoidf_(v0[i] + bb[bj][0][i]); o1[i] = y1[i] * sigmoidf_(v1[i] + bb[bj][1][i]); }
                *(u32x4*)(O + off + (size_t)(ai * 128 + m * 16) * SSMW + bj * 128) = pack8(o0, o1); } }
    }
};
template <bool ADD> struct EpiMerge {
    static constexpr bool PERM = true;
    const bf16_t* G; bf16_t* Y;
    __device__ __forceinline__ void operator()(const f32x4 (&acc)[2][2][4][2], const Unit& u, int wr_, int wc_, int fr_, int fq_) const {
        EPI_COORDS
        const size_t off = (size_t)(u.pm * BM + wr * 64 + fr) * DM + u.pn * BM + wc * 32 + 8 * fq;
        EPI_GROUPS {
            u32x4 gw[4], yw[4];
            EPI_IN_GROUP { EPI_GIDX const size_t o = off + (size_t)(ai * 128 + m * 16) * DM + bj * 128; gw[e_] = *(const u32x4*)(G + o); if (ADD) yw[e_] = *(const u32x4*)(Y + o); }
            EPI_IN_GROUP { EPI_GIDX const size_t o = off + (size_t)(ai * 128 + m * 16) * DM + bj * 128; const f32x4 v0 = EPI_ACC(0), v1 = EPI_ACC(1);
                f32x4 g0, g1; unpack8(gw[e_], g0, g1);
                f32x4 o0, o1;
#pragma unroll
                for (int i = 0; i < 4; ++i) { o0[i] = sigmoidf_(g0[i]) * v0[i]; o1[i] = sigmoidf_(g1[i]) * v1[i]; }
                if (ADD) { f32x4 y0, y1; unpack8(yw[e_], y0, y1); o0 += y0; o1 += y1; }
                *(u32x4*)(Y + o) = pack8(o0, o1); } }
    }
};
struct EpiWo {
    static constexpr bool PERM = true;
    const float* hsrc; float* hlat; float* hctx; const float* gate;
    __device__ __forceinline__ void operator()(const f32x4 (&acc)[2][2][4][2], const Unit& u, int wr_, int wc_, int fr_, int fq_) const {
        EPI_COORDS
        const int r0 = u.pm * BM, c0 = u.pn * BM + wc * 32 + 8 * fq;
        const size_t roff = (size_t)(wr * 64 + fr) * DM + c0;
        const float* sb = (r0 < NLAT ? hsrc + (size_t)r0 * DM : hctx + (size_t)(r0 - NLAT) * DM) + roff;
        float* hb = (r0 < NLAT ? hlat + (size_t)r0 * DM : hctx + (size_t)(r0 - NLAT) * DM) + roff;
        const float* gr = gate + (size_t)(r0 < NLAT ? (r0 >> 12) : NB) * MODW + c0;
        f32x4 gg[2][2];
#pragma unroll
        for (int bj = 0; bj < 2; ++bj) { gg[bj][0] = *(const f32x4*)(gr + bj * 128); gg[bj][1] = *(const f32x4*)(gr + bj * 128 + 4); }
        EPI_GROUPS {
            f32x4 h0[4], h1[4];
            EPI_IN_GROUP { EPI_GIDX const size_t o = (size_t)(ai * 128 + m * 16) * DM + bj * 128; h0[e_] = *(const f32x4*)(sb + o); h1[e_] = *(const f32x4*)(sb + o + 4); }
            EPI_IN_GROUP { EPI_GIDX const size_t o = (size_t)(ai * 128 + m * 16) * DM + bj * 128; const f32x4 v0 = EPI_ACC(0), v1 = EPI_ACC(1);
                *(f32x4*)(hb + o) = h0[e_] + gg[bj][0] * v0; *(f32x4*)(hb + o + 4) = h1[e_] + gg[bj][1] * v1; } }
    }
};
#undef EPI_GROUPS
#undef EPI_IN_GROUP
#undef EPI_GIDX
}

namespace att {
constexpr int D = 128, NW = 8, QBLK = 32, KVBLK = 64;
constexpr float SCALE = 0.088388347648318440f;
constexpr float THR = 8.f;
#ifndef ATT_SDEPTH
#define ATT_SDEPTH 1
#endif
constexpr int SDEPTH = ATT_SDEPTH;
constexpr int LDQ = DM, LDK = KVW, LDO = DM;
constexpr size_t SHM_V = KVBLK * D * 2, SHM_K = KVBLK * D * 2, SHM_ATTN = 2 * SHM_V + 2 * SHM_K + NW * 64 * 4;
#define KSWZ(row, colB) ((row) * 256 + ((colB) ^ (((row) & 7) << 4)))
#define SBAR() __builtin_amdgcn_sched_barrier(0)
__device__ __forceinline__ int crow(int r, int hi) { return (r & 3) + 8 * (r >> 2) + 4 * hi; }
__device__ __forceinline__ unsigned cvtpk(float lo, float hi) { unsigned r; asm volatile("v_cvt_pk_bf16_f32 %0, %1, %2" : "=v"(r) : "v"(lo), "v"(hi)); return r; }
__device__ __forceinline__ void partialSM(f32x16& p0) {
  for (int r = 0; r < 16; ++r) p0[r] = __builtin_amdgcn_exp2f(p0[r]);
}
__device__ __forceinline__ void finishSM(f32x16& p0, f32x16& p1, float& l_reg, bf16x8& pa0, bf16x8& pa1, bf16x8& pa2, bf16x8& pa3) {
  for (int r = 0; r < 16; ++r) p1[r] = __builtin_amdgcn_exp2f(p1[r]);
  float ps = 0; for (int r = 0; r < 16; ++r) ps += p0[r]; for (int r = 0; r < 16; ++r) ps += p1[r];
  l_reg += ps;
#define PK4(P, BASE, OUT) do { unsigned a0 = cvtpk(P[BASE + 0], P[BASE + 1]), a1 = cvtpk(P[BASE + 2], P[BASE + 3]);   \
    unsigned b0 = cvtpk(P[BASE + 4], P[BASE + 5]), b1 = cvtpk(P[BASE + 6], P[BASE + 7]);                              \
    auto r0 = __builtin_amdgcn_permlane32_swap(a0, b0, false, false); auto r1 = __builtin_amdgcn_permlane32_swap(a1, b1, false, false); \
    u32x4 w = {r0[0], r1[0], r0[1], r1[1]}; OUT = *reinterpret_cast<bf16x8*>(&w); } while (0)
  PK4(p0, 0, pa0); PK4(p0, 8, pa1); PK4(p1, 0, pa2); PK4(p1, 8, pa3);
#undef PK4
}
__device__ __forceinline__ void qkt(f32x16& p0, f32x16& p1, const bf16_t* Ks, const bf16x8* qr, int r32, int hi, float nm0) {
#pragma unroll
  for (int r = 0; r < 16; ++r) { p0[r] = nm0; p1[r] = nm0; }
  const char* kb0 = (const char*)Ks + r32 * 256; const char* kb1 = kb0 + 32 * 256; const int swz = (r32 & 7) << 4;
#define KFRAG(base, d0) (*reinterpret_cast<const bf16x8*>((base) + ((((d0) * 32) + hi * 16) ^ swz)))
  bf16x8 fa0 = KFRAG(kb0, 0), fa1 = KFRAG(kb1, 0), fb0 = KFRAG(kb0, 1), fb1 = KFRAG(kb1, 1);
#pragma unroll
  for (int d0 = 0; d0 < 8; d0 += 2) {
    bf16x8 na0 = fa0, na1 = fa1, nb0 = fb0, nb1 = fb1;
    if (d0 + 2 < 8) { na0 = KFRAG(kb0, d0 + 2); na1 = KFRAG(kb1, d0 + 2); }
    p0 = __builtin_amdgcn_mfma_f32_32x32x16_bf16(fa0, qr[d0], p0, 0, 0, 0);
    p1 = __builtin_amdgcn_mfma_f32_32x32x16_bf16(fa1, qr[d0], p1, 0, 0, 0);
    __builtin_amdgcn_sched_group_barrier(0x100, 2, 0); __builtin_amdgcn_sched_group_barrier(0x008, 2, 0);
    if (d0 + 3 < 8) { nb0 = KFRAG(kb0, d0 + 3); nb1 = KFRAG(kb1, d0 + 3); }
    p0 = __builtin_amdgcn_mfma_f32_32x32x16_bf16(fb0, qr[d0 + 1], p0, 0, 0, 0);
    p1 = __builtin_amdgcn_mfma_f32_32x32x16_bf16(fb1, qr[d0 + 1], p1, 0, 0, 0);
    __builtin_amdgcn_sched_group_barrier(0x100, 2, 0); __builtin_amdgcn_sched_group_barrier(0x008, 2, 0);
    fa0 = na0; fa1 = na1; fb0 = nb0; fb1 = nb1;
  }
#undef KFRAG
}
typedef int v8i __attribute__((ext_vector_type(8)));
__device__ __forceinline__ void finishSM8(f32x16& p0, f32x16& p1, float& l_reg, v8i& pa) {
  for (int r = 0; r < 16; ++r) p1[r] = __builtin_amdgcn_exp2f(p1[r]);
  float ps = 0; for (int r = 0; r < 16; ++r) ps += p0[r]; for (int r = 0; r < 16; ++r) ps += p1[r];
  l_reg += ps;
#pragma unroll
  for (int j = 0; j < 4; ++j) { int v = 0, w = 0;
    v = __builtin_amdgcn_cvt_pk_bf8_f32(p0[4 * j], p0[4 * j + 1], v, false); v = __builtin_amdgcn_cvt_pk_bf8_f32(p0[4 * j + 2], p0[4 * j + 3], v, true);
    w = __builtin_amdgcn_cvt_pk_bf8_f32(p1[4 * j], p1[4 * j + 1], w, false); w = __builtin_amdgcn_cvt_pk_bf8_f32(p1[4 * j + 2], p1[4 * j + 3], w, true);
    pa[j] = v; pa[4 + j] = w; }
}
__device__ __forceinline__ void pv8(f32x16* o, const char* Vs, const v8i pa, int r32, int hi) {
  const int sw = (r32 >> 2) & 3;
#pragma unroll
  for (int db = 0; db < 4; ++db) { const char* row = Vs + (db * 32 + r32) * 64;
    const u32x4 lo = *reinterpret_cast<const u32x4*>(row + (((hi * 2) ^ sw) << 4)), hh = *reinterpret_cast<const u32x4*>(row + (((hi * 2 + 1) ^ sw) << 4));
    const v8i vb = {(int)lo.x, (int)lo.y, (int)lo.z, (int)lo.w, (int)hh.x, (int)hh.y, (int)hh.z, (int)hh.w};
    o[db] = __builtin_amdgcn_mfma_scale_f32_32x32x64_f8f6f4(pa, vb, o[db], 1  , 0  , 0, 0x7F7F7F7F, 0, 0x7F7F7F7F); }
}
__device__ __forceinline__ void qkt8(f32x16& p0, f32x16& p1, const char* Ks, const v8i* q8, int r32, int hi, float nm0) {
#pragma unroll
  for (int r = 0; r < 16; ++r) { p0[r] = nm0; p1[r] = nm0; }
  const int sw = (r32 >> 1) & 7;
  const char* k0 = Ks + r32 * 128; const char* k1 = k0 + 32 * 128;
#define K8FRAG(base, ks) ({ const u32x4 lo_ = *reinterpret_cast<const u32x4*>((base) + ((((ks) * 4 + hi * 2) ^ sw) << 4)), hi_ = *reinterpret_cast<const u32x4*>((base) + ((((ks) * 4 + hi * 2 + 1) ^ sw) << 4)); \
    (v8i){(int)lo_.x, (int)lo_.y, (int)lo_.z, (int)lo_.w, (int)hi_.x, (int)hi_.y, (int)hi_.z, (int)hi_.w}; })
  const v8i a00 = K8FRAG(k0, 0), a10 = K8FRAG(k1, 0), a01 = K8FRAG(k0, 1), a11 = K8FRAG(k1, 1);
  p0 = __builtin_amdgcn_mfma_scale_f32_32x32x64_f8f6f4(a00, q8[0], p0, 0, 0, 0, 0x7F7F7F7F, 0, 0x7F7F7F7F);
  p1 = __builtin_amdgcn_mfma_scale_f32_32x32x64_f8f6f4(a10, q8[0], p1, 0, 0, 0, 0x7F7F7F7F, 0, 0x7F7F7F7F);
  p0 = __builtin_amdgcn_mfma_scale_f32_32x32x64_f8f6f4(a01, q8[1], p0, 0, 0, 0, 0x7F7F7F7F, 0, 0x7F7F7F7F);
  p1 = __builtin_amdgcn_mfma_scale_f32_32x32x64_f8f6f4(a11, q8[1], p1, 0, 0, 0, 0x7F7F7F7F, 0, 0x7F7F7F7F);
#undef K8FRAG
}
__device__ __forceinline__ int v_st(int k, int c) { const int kk = (k & ~0xC) | ((k & 4) << 1) | ((k & 8) >> 1); return ((kk >> 3) * 4 + (c >> 5)) * 512 + ((kk & 7) * 32 + (c & 31)) * 2; }
__device__ __forceinline__ int v_rd_base(int lane) { return ((lane & 3) << 3) | (((lane >> 2) & 3) << 6) | (((lane >> 4) & 1) << 5) | (((lane >> 5) & 1) << 8); }
constexpr int v_rd_off(int d0, int ks, int half) { return d0 * 512 + ks * 4096 + half * 2048; }
template <int OFF> __device__ __forceinline__ s16x4 tr_read(int vb) {
  s16x4 r; asm volatile("ds_read_b64_tr_b16 %0, %1 offset:%2" : "=&v"(r) : "v"(vb), "i"(OFF) : "memory"); return r;
}
template <int D0> __device__ __forceinline__ void pv_one(f32x16& od, int vb, bf16x8 pa0, bf16x8 pa1, bf16x8 pa2, bf16x8 pa3) {
  const s16x4 l0 = tr_read<v_rd_off(D0, 0, 0)>(vb), h0 = tr_read<v_rd_off(D0, 0, 1)>(vb), l1 = tr_read<v_rd_off(D0, 1, 0)>(vb), h1 = tr_read<v_rd_off(D0, 1, 1)>(vb);
  const s16x4 l2 = tr_read<v_rd_off(D0, 2, 0)>(vb), h2 = tr_read<v_rd_off(D0, 2, 1)>(vb), l3 = tr_read<v_rd_off(D0, 3, 0)>(vb), h3 = tr_read<v_rd_off(D0, 3, 1)>(vb);
  asm volatile("s_waitcnt lgkmcnt(0)" ::: "memory"); SBAR();
#define PK(L, H) (bf16x8){L[0], L[1], L[2], L[3], H[0], H[1], H[2], H[3]}
  od = __builtin_amdgcn_mfma_f32_32x32x16_bf16(pa0, PK(l0, h0), od, 0, 0, 0);
  od = __builtin_amdgcn_mfma_f32_32x32x16_bf16(pa1, PK(l1, h1), od, 0, 0, 0);
  od = __builtin_amdgcn_mfma_f32_32x32x16_bf16(pa2, PK(l2, h2), od, 0, 0, 0);
  od = __builtin_amdgcn_mfma_f32_32x32x16_bf16(pa3, PK(l3, h3), od, 0, 0, 0);
#undef PK
}
__device__ __forceinline__ void pv_d0(f32x16* o, int vb, bf16x8 pa0, bf16x8 pa1, bf16x8 pa2, bf16x8 pa3) {
  pv_one<0>(o[0], vb, pa0, pa1, pa2, pa3); pv_one<1>(o[1], vb, pa0, pa1, pa2, pa3); pv_one<2>(o[2], vb, pa0, pa1, pa2, pa3); pv_one<3>(o[3], vb, pa0, pa1, pa2, pa3);
}
__device__ __forceinline__ void attn_dense_body(bf16_t* Qb, const bf16_t* Kh, int seq, char* lds, const int tid, const long odelta, const float nm0) {
  const bf16_t* Vh = (const bf16_t*)((const char*)Kh + (WS_VB - WS_KB)); bf16_t* Ob = (bf16_t*)((char*)Qb + odelta);
  const int wid = tid >> 6, lane = tid & 63, r32 = lane & 31, hi = lane >> 5;
  bf16_t* V_lds = (bf16_t*)lds; bf16_t* K_lds = (bf16_t*)(lds + 2 * SHM_V);
  float* ws = (float*)(lds + 2 * SHM_V + 2 * SHM_K) + wid * 64; float* li_l = ws;
  float l_reg = 0; f32x16 o[4] = {}; bf16x8 qr[8];
  const bf16_t* Qw = Qb + (long)(wid * QBLK + r32) * LDQ + hi * 8;
#pragma unroll
  for (int d0 = 0; d0 < 8; ++d0) qr[d0] = *reinterpret_cast<const bf16x8*>(Qw + d0 * 16);
  const int sr = tid >> 4, sc = (tid & 15) * 8, vst0 = v_st(sr, sc), vst1 = v_st(32 + sr, sc);
  const int vb0 = (int)(uintptr_t)V_lds + v_rd_base(lane);
  struct { bf16x8 vs0, vs1, ks0, ks1; } sr_[SDEPTH];
#define LD8(p) (*reinterpret_cast<const bf16x8*>(p))
#define SLOAD(i, k0) do { sr_[i].vs0 = LD8(&Vh[(long)((k0) + sr) * LDK + sc]); sr_[i].vs1 = LD8(&Vh[(long)((k0) + 32 + sr) * LDK + sc]); \
    sr_[i].ks0 = LD8(&Kh[(long)((k0) + sr) * LDK + sc]); sr_[i].ks1 = LD8(&Kh[(long)((k0) + 32 + sr) * LDK + sc]); } while (0)
#define SWRITE(b, i) do { *(bf16x8*)((char*)V_lds + (b) * SHM_V + vst0) = sr_[i].vs0;          \
    *(bf16x8*)((char*)V_lds + (b) * SHM_V + vst1) = sr_[i].vs1; int kc = sc * 2;               \
    *(bf16x8*)((char*)K_lds + (b) * SHM_K + KSWZ(sr, kc)) = sr_[i].ks0;                       \
    *(bf16x8*)((char*)K_lds + (b) * SHM_K + KSWZ(32 + sr, kc)) = sr_[i].ks1; } while (0)
#define SWAIT() do { if constexpr (SDEPTH == 2) asm volatile("s_waitcnt vmcnt(4)" ::: "memory"); else asm volatile("s_waitcnt vmcnt(0)" ::: "memory"); } while (0)
  f32x16 pA0, pA1, pB0, pB1; bf16x8 pa0, pa1, pa2, pa3; const int NT = seq / KVBLK;
  constexpr int SE = 0, SO = SDEPTH - 1;
  SLOAD(SE, 0); asm volatile("s_waitcnt vmcnt(0)" ::: "memory"); SWRITE(0, SE); __syncthreads();
  qkt(pA0, pA1, K_lds, qr, r32, hi, nm0); partialSM(pA0);
  SLOAD(SO, KVBLK); if constexpr (SDEPTH == 2) { if (2 < NT) SLOAD(SE, 2 * KVBLK); }
  SWAIT(); SWRITE(1, SO); __syncthreads();
  for (int j = 1; j + 1 < NT; j += 2) {
    SBAR(); qkt(pB0, pB1, (bf16_t*)((char*)K_lds + SHM_K), qr, r32, hi, nm0);
    finishSM(pA0, pA1, l_reg, pa0, pa1, pa2, pa3); SBAR();
    SLOAD(SO, (j + SDEPTH) * KVBLK); SBAR();
    pv_d0(o, vb0, pa0, pa1, pa2, pa3); partialSM(pB0);
    __syncthreads(); SWAIT(); SWRITE(0, SE);
    __syncthreads();
    SBAR(); qkt(pA0, pA1, K_lds, qr, r32, hi, nm0);
    finishSM(pB0, pB1, l_reg, pa0, pa1, pa2, pa3); SBAR();
    if (SDEPTH == 1 || j + 3 < NT) SLOAD(SE, (j + 1 + SDEPTH) * KVBLK); SBAR();
    pv_d0(o, vb0 + (int)SHM_V, pa0, pa1, pa2, pa3); partialSM(pA0);
    __syncthreads(); SWAIT(); SWRITE(1, SO);
    __syncthreads();
  }
  SBAR(); qkt(pB0, pB1, (bf16_t*)((char*)K_lds + SHM_K), qr, r32, hi, nm0);
  finishSM(pA0, pA1, l_reg, pa0, pa1, pa2, pa3); SBAR();
  pv_d0(o, vb0, pa0, pa1, pa2, pa3); partialSM(pB0);
  __syncthreads();
  finishSM(pB0, pB1, l_reg, pa0, pa1, pa2, pa3); SBAR();
  pv_d0(o, vb0 + (int)SHM_V, pa0, pa1, pa2, pa3);
  { auto rr = __builtin_amdgcn_permlane32_swap(__float_as_uint(l_reg), __float_as_uint(l_reg), false, false); l_reg = __uint_as_float(rr[0]) + __uint_as_float(rr[1]); }
  if (hi == 0) li_l[r32] = l_reg; asm volatile("s_waitcnt lgkmcnt(0)" ::: "memory");
  float rli[16];
#pragma unroll
  for (int r = 0; r < 16; ++r) rli[r] = __builtin_amdgcn_rcpf(li_l[crow(r, hi)]);
  bf16_t* Ow = Ob + (long)(wid * QBLK) * LDO;
#pragma unroll
  for (int r = 0; r < 16; ++r) { int orow = crow(r, hi);
    for (int d0 = 0; d0 < 4; ++d0) Ow[(long)orow * LDO + d0 * 32 + r32] = (bf16_t)f2bf(o[d0][r] * rli[r]); }
  __syncthreads();
#undef LD8
#undef SLOAD
#undef SWRITE
#undef SWAIT
}
constexpr int SLOT = 32768;
__device__ __forceinline__ void attn_dense_body_dma(bf16_t* Qb, const bf16_t* Kh, int seq, char* lds, LAS unsigned char* ldsl, const int tid, const long odelta, const float nm0,
                                                    const float* qgain, const float* rope, const int lpos0, const unsigned char* K8h  , const unsigned char* V8h  ) {
  const bf16_t* Vh = (const bf16_t*)((const char*)Kh + (WS_VB - WS_KB)); bf16_t* Ob = (bf16_t*)((char*)Qb + odelta);
  const int wid = __builtin_amdgcn_readfirstlane(tid >> 6), lane = tid & 63, r32 = lane & 31, hi = lane >> 5;
  float* li_l = (float*)(lds + 3 * SLOT) + wid * 64;
  float l_reg = 0; f32x16 o[4] = {}; v8i q8[2];
  { const bf16_t* Qw = Qb + (long)(wid * QBLK + r32) * LDQ + hi * 16;
    f32x4 x[2][2][4]; float ss = 0.f;
#pragma unroll
    for (int ks = 0; ks < 2; ++ks)
#pragma unroll
      for (int t = 0; t < 2; ++t) { const u32x4 w0 = *reinterpret_cast<const u32x4*>(Qw + ks * 64 + t * 32), w1 = *reinterpret_cast<const u32x4*>(Qw + ks * 64 + t * 32 + 8);
        unpack8(w0, x[ks][t][0], x[ks][t][1]); unpack8(w1, x[ks][t][2], x[ks][t][3]);
#pragma unroll
        for (int j = 0; j < 4; ++j)
#pragma unroll
          for (int i = 0; i < 4; ++i) ss += x[ks][t][j][i] * x[ks][t][j][i]; }
    { auto rr = __builtin_amdgcn_permlane32_swap(__float_as_uint(ss), __float_as_uint(ss), false, false); ss = __uint_as_float(rr[0]) + __uint_as_float(rr[1]); }
    const float rstd = (SCALE * 1.4426950408889634f) * __builtin_amdgcn_rsqf(ss * (1.0f / D) + EPS);
#pragma unroll
    for (int ks = 0; ks < 2; ++ks)
#pragma unroll
      for (int t = 0; t < 2; ++t)
#pragma unroll
        for (int j = 0; j < 4; ++j) x[ks][t][j] = x[ks][t][j] * rstd * *(const f32x4*)(qgain + ks * 64 + t * 32 + hi * 16 + 4 * j);
    if (lpos0 >= 0) { const int lpos = lpos0 + wid * QBLK + r32;
#pragma unroll
      for (int ks = 0; ks < 2; ++ks) { const int posi = ks == 0 ? (lpos >> 6) : (lpos & 63); const float* cp = rope + posi * 32 + hi * 16;
#pragma unroll
        for (int j = 0; j < 4; ++j) { const f32x4 cs = *(const f32x4*)(cp + 4 * j), sn = *(const f32x4*)(cp + 2048 + 4 * j); const f32x4 x1 = x[ks][0][j], x2 = x[ks][1][j];
          x[ks][0][j] = x1 * cs - x2 * sn; x[ks][1][j] = x1 * sn + x2 * cs; } } }
#pragma unroll
    for (int ks = 0; ks < 2; ++ks)
#pragma unroll
      for (int t = 0; t < 2; ++t)
#pragma unroll
        for (int j = 0; j < 4; ++j) { int v = 0; v = __builtin_amdgcn_cvt_pk_fp8_f32(x[ks][t][j][0], x[ks][t][j][1], v, false); v = __builtin_amdgcn_cvt_pk_fp8_f32(x[ks][t][j][2], x[ks][t][j][3], v, true); q8[ks][t * 4 + j] = v; } }
  unsigned ksrc;
  { const int b = wid * 1024 + lane * 16, row = b >> 7, g = ((b & 127) >> 4) ^ ((row >> 1) & 7); ksrc = (unsigned)(row * KVW + g * 16); }
  const unsigned vlin = (unsigned)(wid * 1024 + lane * 16);
#define ADMA(tile, s) do { const char* kb_ = (const char*)K8h + (size_t)(tile) * (KVBLK * KVW); const char* vb_ = (const char*)V8h + (size_t)(tile) * 8192; \
    __builtin_amdgcn_global_load_lds((const unsigned*)(kb_ + ksrc), (LAS unsigned*)(ldsl + (s) * SLOT + wid * 1024), 16, 0, 0); \
    __builtin_amdgcn_global_load_lds((const unsigned*)(vb_ + vlin), (LAS unsigned*)(ldsl + (s) * SLOT + 16384 + wid * 1024), 16, 0, 0); } while (0)
#define KSLOT(s) ((const char*)(lds + (s) * SLOT))
#define VBASE(s) ((const char*)(lds + 16384 + (s) * SLOT))
#define NEXT3(s) ((s) == 2 ? 0 : (s) + 1)
  f32x16 pA0, pA1, pB0, pB1; v8i pa; const int NT = seq / KVBLK; const float nm8 = nm0 + 15.8f;
  ADMA(0, 0);
  __syncthreads(); ADMA(1, 1);
  qkt8(pA0, pA1, KSLOT(0), q8, r32, hi, nm8); partialSM(pA0);
  int sj = 1;
  for (int j = 1; j + 1 < NT; j += 2) {
    { const int sp = sj == 0 ? 2 : sj - 1, sn = NEXT3(sj);
      __syncthreads(); ADMA(j + 1, sn);
      SBAR(); qkt8(pB0, pB1, KSLOT(sj), q8, r32, hi, nm8);
      finishSM8(pA0, pA1, l_reg, pa); SBAR();
      pv8(o, VBASE(sp), pa, r32, hi); partialSM(pB0);
      sj = sn; }
    { const int sp = sj == 0 ? 2 : sj - 1, sn = NEXT3(sj);
      __syncthreads(); if (j + 2 < NT) ADMA(j + 2, sn);
      SBAR(); qkt8(pA0, pA1, KSLOT(sj), q8, r32, hi, nm8);
      finishSM8(pB0, pB1, l_reg, pa); SBAR();
      pv8(o, VBASE(sp), pa, r32, hi); partialSM(pA0);
      sj = sn; }
  }
  { const int sp = sj == 0 ? 2 : sj - 1;
    __syncthreads();
    SBAR(); qkt8(pB0, pB1, KSLOT(sj), q8, r32, hi, nm8);
    finishSM8(pA0, pA1, l_reg, pa); SBAR();
    pv8(o, VBASE(sp), pa, r32, hi); partialSM(pB0);
    finishSM8(pB0, pB1, l_reg, pa); SBAR();
    pv8(o, VBASE(sj), pa, r32, hi); }
  { auto rr = __builtin_amdgcn_permlane32_swap(__float_as_uint(l_reg), __float_as_uint(l_reg), false, false); l_reg = __uint_as_float(rr[0]) + __uint_as_float(rr[1]); }
  if (hi == 0) li_l[r32] = l_reg; asm volatile("s_waitcnt lgkmcnt(0)" ::: "memory");
  float rli[16];
#pragma unroll
  for (int r = 0; r < 16; ++r) rli[r] = __builtin_amdgcn_rcpf(li_l[crow(r, hi)]);
  bf16_t* Ow = Ob + (long)(wid * QBLK) * LDO;
#pragma unroll
  for (int r = 0; r < 16; ++r) { int orow = crow(r, hi);
    for (int d0 = 0; d0 < 4; ++d0) Ow[(long)orow * LDO + d0 * 32 + r32] = (bf16_t)f2bf(o[d0][r] * rli[r]); }
  __syncthreads();
#undef ADMA
#undef KSLOT
#undef VBASE
#undef NEXT3
}
}

namespace peer {
__device__ __forceinline__ float vmax(float a, float b) { float r; asm("v_max_f32 %0, %1, %2" : "=v"(r) : "v"(a), "v"(b)); return r; }
__device__ __forceinline__ float vmin(float a, float b) { float r; asm("v_min_f32 %0, %1, %2" : "=v"(r) : "v"(a), "v"(b)); return r; }
__device__ __forceinline__ void cswap(float& hi_, float& lo_) { const float mx = vmax(hi_, lo_), mn = vmin(hi_, lo_); hi_ = mx; lo_ = mn; }
__device__ __forceinline__ void sort16(float (&v)[16]) {
    constexpr int NET[63][2] = {{0,1},{2,3},{0,2},{1,3},{1,2},{4,5},{6,7},{4,6},{5,7},{5,6},{0,4},{2,6},{2,4},{1,5},{3,7},{3,5},{1,2},{3,4},{5,6},{8,9},{10,11},{8,10},{9,11},{9,10},{12,13},{14,15},{12,14},{13,15},{13,14},
        {8,12},{10,14},{10,12},{9,13},{11,15},{11,13},{9,10},{11,12},{13,14},{0,8},{4,12},{4,8},{2,10},{6,14},{6,10},{2,4},{6,8},{10,12},{1,9},{5,13},{5,9},{3,11},{7,15},{7,11},{3,5},{7,9},{11,13},{1,2},{3,4},{5,6},{7,8},{9,10},{11,12},{13,14}};
#pragma unroll
    for (int k = 0; k < 63; ++k) cswap(v[NET[k][0]], v[NET[k][1]]);
}
__device__ __forceinline__ void bmerge16(float (&v)[16]) {
#pragma unroll
    for (int j = 8; j > 0; j >>= 1)
#pragma unroll
        for (int i = 0; i < 16; ++i) { const int l = i ^ j; if (l > i) cswap(v[i], v[l]); }
}
__device__ __forceinline__ void merge_top16(float (&a)[16], const float (&b)[16]) {
#pragma unroll
    for (int i = 0; i < 16; ++i) a[i] = vmax(a[i], b[15 - i]);
    bmerge16(a);
}
__device__ __forceinline__ float setlow(float v, unsigned mask, unsigned bits) { return __uint_as_float((__float_as_uint(v) & ~mask) | bits); }
__device__ __forceinline__ void top16_of_acc(const f32x16 (&acc)[4], int hi, float (&out)[16]) {
    float t[16];
#pragma unroll
    for (int blk = 0; blk < 4; ++blk) {
#pragma unroll
        for (int r = 0; r < 16; ++r) { const unsigned key = (unsigned)(32 * blk + (r & 3) + 8 * (r >> 2)) | ((unsigned)hi << 2); if (blk == 0) out[r] = setlow(acc[blk][r], 0x7Fu, key); else t[r] = setlow(acc[blk][r], 0x7Fu, key); }
        if (blk == 0) sort16(out); else { sort16(t); merge_top16(out, t); }
    }
}
}

struct Args { const float* in[28]; float* out; unsigned char* ws; int ph_lo, ph_hi; };
enum { I_X = 0, I_C, I_CTX, I_CCTX, I_WMOD, I_BMOD, I_NMG, I_WIN, I_QNG, I_KNG, I_ARE, I_AIM, I_LDT, I_BRE, I_BIM, I_CRE, I_CIM, I_SD, I_WGLU, I_BGLU, I_WBA, I_WBS, I_WO, I_NFG, I_PWQ, I_PKEYS, I_PU, I_PV };

__device__ __forceinline__ void transpose_item(const float* W, int K, int N, bf16_t* WT, LAS float* scr, int item, int lane) {
    const int nblk = N / 32, kb = item / nblk, nb = item % nblk, k0 = 64 * kb, n0 = 32 * nb;
    { f32x4 t[8]; const int kr = lane >> 3, nq = (lane & 7) * 4;
#pragma unroll
      for (int i = 0; i < 8; ++i) t[i] = *(const f32x4*)(W + (size_t)(k0 + 8 * i + kr) * N + n0 + nq);
#pragma unroll
      for (int i = 0; i < 8; ++i) { LAS float* d = scr + (8 * i + kr) * 33 + nq; d[0] = t[i][0]; d[1] = t[i][1]; d[2] = t[i][2]; d[3] = t[i][3]; } }
    asm volatile("s_waitcnt lgkmcnt(0)" ::: "memory");
    const int c = lane & 7;
#pragma unroll
    for (int j = 0; j < 4; ++j) { const int n = (lane >> 3) + 8 * j; const LAS float* s = scr + (8 * c) * 33 + n;
        u32x4 o; o.x = pk2(s[0 * 33], s[1 * 33]); o.y = pk2(s[2 * 33], s[3 * 33]); o.z = pk2(s[4 * 33], s[5 * 33]); o.w = pk2(s[6 * 33], s[7 * 33]);
        *(u32x4*)(WT + (size_t)(n0 + n) * K + k0 + 8 * c) = o; }
    asm volatile("s_waitcnt lgkmcnt(0)" ::: "memory");
}

__device__ __forceinline__ void norm_mod_row(const float* hr, const float* g, const float* sh, const float* sc, bf16_t* orow, int lane) {
    f32x4 v[4]; float ss = 0.f;
#pragma unroll
    for (int j = 0; j < 4; ++j) { v[j] = *(const f32x4*)(hr + (j >> 1) * 512 + lane * 8 + (j & 1) * 4); ss += (v[j][0] * v[j][0] + v[j][1] * v[j][1]) + (v[j][2] * v[j][2] + v[j][3] * v[j][3]); }
    ss = wave_sum(ss, lane);
    const float rstd = __builtin_amdgcn_rsqf(ss * (1.0f / DM) + EPS);
#pragma unroll
    for (int hh = 0; hh < 2; ++hh) {
        const int c0 = hh * 512 + lane * 8; f32x4 o[2];
#pragma unroll
        for (int j = 0; j < 2; ++j) { const f32x4 gg = *(const f32x4*)(g + c0 + 4 * j), s1 = *(const f32x4*)(sc + c0 + 4 * j), s0 = *(const f32x4*)(sh + c0 + 4 * j);
            o[j] = v[hh * 2 + j] * rstd * gg * (1.0f + s1) + s0; }
        *(u32x4*)(orow + c0) = pack8(o[0], o[1]);
    }
}
__device__ __forceinline__ const float* hrow_c(const float* hlat, const float* hctx, int r) { return r < NLAT ? hlat + (size_t)r * DM : hctx + (size_t)(r - NLAT) * DM; }
__device__ __forceinline__ float* hrow_m(float* hlat, float* hctx, int r) { return r < NLAT ? hlat + (size_t)r * DM : hctx + (size_t)(r - NLAT) * DM; }

__device__ __forceinline__ void p0a(const Args& a, LAS unsigned char* lds, int bx, int G, int tid) {
    const int lane = tid & 63, wave = tid >> 6, gw = bx * 8 + wave, NGW = G * 8;
    unsigned char* ws = a.ws;
    { LAS float* scr = (LAS float*)(lds + wave * 16384);
      constexpr int I_IN = 16 * 128, I_BA = 16 * 32, I_BS = 8 * 32, I_OO = 16 * 32, I_GL = 8 * 16, I_QQ = 16 * 64, PER = I_IN + I_BA + I_BS + I_OO + I_GL + I_QQ;
      for (int it = gw; it < PER * DEPTH; it += NGW) {
          const int l = it / PER; int r = it - l * PER; bf16_t* base = (bf16_t*)(ws + WS_WT + (size_t)l * WT_LAYER);
          if (r < I_IN) { transpose_item(a.in[I_WIN] + (size_t)l * DM * INW, DM, INW, (bf16_t*)((char*)base + WT_IN), scr, r, lane); continue; } r -= I_IN;
          if (r < I_BA) { transpose_item(a.in[I_WBA] + (size_t)l * DM * DM, DM, DM, (bf16_t*)((char*)base + WT_BA), scr, r, lane); continue; } r -= I_BA;
          if (r < I_BS) { transpose_item(a.in[I_WBS] + (size_t)l * SSMW * DM, SSMW, DM, (bf16_t*)((char*)base + WT_BS), scr, r, lane); continue; } r -= I_BS;
          if (r < I_OO) { transpose_item(a.in[I_WO] + (size_t)l * DM * DM, DM, DM, (bf16_t*)((char*)base + WT_O), scr, r, lane); continue; } r -= I_OO;
          if (r < I_GL) { transpose_item(a.in[I_WGLU] + (size_t)l * SSMW * SSMW, SSMW, SSMW, (bf16_t*)((char*)base + WT_GLU), scr, r, lane); continue; } r -= I_GL;
          transpose_item(a.in[I_PWQ] + (size_t)l * DM * PQW, DM, PQW, (bf16_t*)((char*)base + WT_Q), scr, r, lane);
      } }
    { const size_t gt = (size_t)bx * 512 + tid, GT = (size_t)G * 512;
      { typedef float v16f_ __attribute__((ext_vector_type(16))); typedef int v6i_ __attribute__((ext_vector_type(6)));
        constexpr int NROWS = 2 * DEPTH * PEXP;
        f32x4 cur[2][4];
#define P0A_TLOAD(dst, r0_) do { _Pragma("unroll") for (int rr = 0; rr < 2; ++rr) { const int row = ((r0_) + rr * NGW < NROWS) ? (r0_) + rr * NGW : (r0_); const bool isU = row < DEPTH * PEXP; const int idx = isU ? row : row - DEPTH * PEXP; \
            const float* src = (isU ? a.in[I_PU] : a.in[I_PV]) + (size_t)idx * DM + lane * 16; _Pragma("unroll") for (int j = 0; j < 4; ++j) dst[rr][j] = *(const f32x4*)(src + 4 * j); } } while (0)
        if (gw < NROWS) P0A_TLOAD(cur, gw);
        for (int row0 = gw; row0 < NROWS; row0 += 2 * NGW) {
          f32x4 nx[2][4];
          if (row0 + 2 * NGW < NROWS) P0A_TLOAD(nx, row0 + 2 * NGW);
          float v[2][16]; float sc[2], inv[2];
#pragma unroll
          for (int rr = 0; rr < 2; ++rr)
#pragma unroll
              for (int j = 0; j < 4; ++j) { v[rr][4 * j] = cur[rr][j][0]; v[rr][4 * j + 1] = cur[rr][j][1]; v[rr][4 * j + 2] = cur[rr][j][2]; v[rr][4 * j + 3] = cur[rr][j][3]; }
#pragma unroll
          for (int rr = 0; rr < 2; ++rr) { float mx = 0.f;
#pragma unroll
              for (int j = 0; j < 16; ++j) mx = fmaxf(mx, fabsf(v[rr][j]));
#pragma unroll
              for (int o = 1; o < 64; o <<= 1) mx = fmaxf(mx, shflx(mx, o, lane));
              sc[rr] = mx > 0.f ? QMAX / mx : 1.0f; inv[rr] = mx > 0.f ? mx * (1.0f / QMAX) : 1.0f; }
#if PEER_FP4
#pragma unroll
          for (int rr = 0; rr < 2; ++rr) { const int row = row0 + rr * NGW; if (row < NROWS) { const bool isU = row < DEPTH * PEXP; const int idx = isU ? row : row - DEPTH * PEXP;
              unsigned w0 = 0u, w1 = 0u;
#define P0A_PK(b) w0 = __builtin_amdgcn_cvt_scalef32_pk_fp4_f32(w0, v[rr][2 * b] * sc[rr], v[rr][2 * b + 1] * sc[rr], 1.0f, b); w1 = __builtin_amdgcn_cvt_scalef32_pk_fp4_f32(w1, v[rr][8 + 2 * b] * sc[rr], v[rr][8 + 2 * b + 1] * sc[rr], 1.0f, b);
              P0A_PK(0) P0A_PK(1) P0A_PK(2) P0A_PK(3)
#undef P0A_PK
              unsigned* dst = (unsigned*)(ws + (isU ? WS_PU : WS_PV) + (size_t)idx * PROW + lane * 8);
              dst[0] = w0; dst[1] = w1;
              if (lane == 0) ((float*)(ws + (isU ? WS_PSU : WS_PSV)))[idx] = inv[rr]; } }
#else
          v16f_ ga, gb;
#pragma unroll
          for (int j = 0; j < 8; ++j) { ga[j] = v[0][2 * j] * sc[0]; gb[j] = v[0][2 * j + 1] * sc[0]; ga[8 + j] = v[1][2 * j] * sc[1]; gb[8 + j] = v[1][2 * j + 1] * sc[1]; }
          const v6i_ pk = __builtin_amdgcn_cvt_scalef32_2xpk16_fp6_f32(ga, gb, 1.0f);
#pragma unroll
          for (int rr = 0; rr < 2; ++rr) { const int row = row0 + rr * NGW; if (row < NROWS) { const bool isU = row < DEPTH * PEXP; const int idx = isU ? row : row - DEPTH * PEXP;
              unsigned* dst = (unsigned*)(ws + (isU ? WS_PU : WS_PV) + (size_t)idx * 768 + lane * 12);
              dst[0] = (unsigned)pk[3 * rr]; dst[1] = (unsigned)pk[3 * rr + 1]; dst[2] = (unsigned)pk[3 * rr + 2];
              if (lane == 0) ((float*)(ws + (isU ? WS_PSU : WS_PSV)))[idx] = inv[rr]; } }
#endif
#pragma unroll
          for (int rr = 0; rr < 2; ++rr)
#pragma unroll
              for (int j = 0; j < 4; ++j) cur[rr][j] = nx[rr][j];
        } }
#undef P0A_TLOAD
      const size_t k8 = (size_t)DEPTH * 2 * PKEYS * 128 / 8;
      for (size_t i = gt; i < k8; i += GT) { const float* src = a.in[I_PKEYS] + i * 8; const f32x4 x0 = *(const f32x4*)src, x1 = *(const f32x4*)(src + 4);
          u32x4 o; o.x = pk2(x0[0], x0[1]); o.y = pk2(x0[2], x0[3]); o.z = pk2(x1[0], x1[1]); o.w = pk2(x1[2], x1[3]);
          *(u32x4*)((bf16_t*)(ws + WS_KEYS) + i * 8) = o; }
      const size_t nc4 = (size_t)NCTX * DM / 4;
      for (size_t i = gt; i < nc4; i += GT) ((f32x4*)(ws + WS_HCTX))[i] = ((const f32x4*)a.in[I_CTX])[i];
      if (bx == 0) { float* ct = (float*)(ws + WS_ROPE); for (int i = tid; i < 64 * 32; i += 512) { const int pos = i >> 5, f = i & 31;
          const float invf = (float)pow(10000.0, -(double)f / 32.0); const float ang = (float)pos * invf; ct[i] = (float)cos((double)ang); ct[2048 + i] = (float)sin((double)ang); } }
    }
    { __syncthreads();
      LAS float* sv = (LAS float*)lds;
      LAS float* part = (LAS float*)(lds + 9 * 1024 * 4);
      for (int i = tid; i < 9 * DM; i += 512) { const int m = i >> 10, k = i & 1023; const float c = m < NB ? a.in[I_C][m * DM + k] : a.in[I_CCTX][k]; sv[i] = c / (1.0f + __expf(-c)); }
      __syncthreads();
      for (int it = bx; it < DEPTH * (MODW / 32); it += G) {
          const int l = it / (MODW / 32), jb = it % (MODW / 32), kh = lane >> 5, j = jb * 32 + (lane & 31), kb = wave * 128 + kh * 64;
          const float* w = a.in[I_WMOD] + ((size_t)l * DM + kb) * MODW + j;
          float acc[9];
#pragma unroll
          for (int m = 0; m < 9; ++m) acc[m] = 0.f;
#pragma unroll 1
          for (int k0 = 0; k0 < 64; k0 += 16) { float wv[16];
#pragma unroll
              for (int i = 0; i < 16; ++i) wv[i] = w[(size_t)(k0 + i) * MODW];
#pragma unroll
              for (int i = 0; i < 16; ++i)
#pragma unroll
                  for (int m = 0; m < 9; ++m) acc[m] += sv[m * DM + kb + k0 + i] * wv[i]; }
#pragma unroll
          for (int m = 0; m < 9; ++m) part[(wave * 9 + m) * 64 + lane] = acc[m];
          __syncthreads();
          for (int i = tid; i < 9 * 32; i += 512) { const int m = i >> 5, jj = i & 31; float s = 0.f;
#pragma unroll
              for (int w8 = 0; w8 < 8; ++w8) s += part[(w8 * 9 + m) * 64 + jj] + part[(w8 * 9 + m) * 64 + 32 + jj];
              ((float*)(ws + WS_MOD))[((size_t)l * 9 + m) * MODW + jb * 32 + jj] = s + a.in[I_BMOD][(size_t)l * MODW + jb * 32 + jj]; }
          __syncthreads();
      }
    }
}

__device__ __forceinline__ void norm_pass(const Args& a, int l, int sel, bf16_t* dst, int gw, int NGW, int lane, int nrows, const float* hlat) {
    const float* mod = (const float*)(a.ws + WS_MOD) + (size_t)l * 9 * MODW;
    const float* g = a.in[sel ? I_NFG : I_NMG] + (size_t)l * DM;
    const float* hctx = (const float*)(a.ws + WS_HCTX);
    for (int r = gw; r < nrows; r += NGW) { const float* mr = mod + (size_t)modrow_of(r) * MODW + sel * 3 * DM;
        norm_mod_row(hrow_c(hlat, hctx, r), g, mr, mr + DM, dst + (size_t)r * DM, lane); }
}

__device__ __forceinline__ void ssm_tables(const Args& a, int l, LAS unsigned char* lds, int bx, int G, int tid) {
    LAS float* ErT = (LAS float*)lds;
    LAS float* EiT = ErT + 1024;
    LAS float* kr = EiT + 1024;
    LAS float* ki = kr + 128;
    LAS float* red = ki + 128;
    LAS float* E2r = red + 2048;
    LAS float* E2i = E2r + 512;
    LAS float* E3r = E2i + 512;
    LAS float* E3i = E3r + 512;
    LAS float* Cr = E3i + 512;
    LAS float* Ci = Cr + 2048;
    LAS float* kBr = Ci + 2048;
    LAS float* kBi = kBr + 2048;
    bf16_t* WCAT = (bf16_t*)(a.ws + WS_WCAT); bf16_t* WST = (bf16_t*)(a.ws + WS_WSTATE);
    for (int unit = bx; unit < SG * 8; unit += G) {
        const int g = unit >> 3, oc = unit & 7;
        __syncthreads();
        { const int d = tid >> 8, v = tid & 255; const size_t o4 = (((size_t)l * 2 + d) * SG + g) * (SP * SN) + v * 4;
          *(LAS f32x4*)(Cr + tid * 4) = *(const f32x4*)(a.in[I_CRE] + o4); *(LAS f32x4*)(Ci + tid * 4) = *(const f32x4*)(a.in[I_CIM] + o4);
          *(LAS f32x4*)(kBr + tid * 4) = *(const f32x4*)(a.in[I_BRE] + o4); *(LAS f32x4*)(kBi + tid * 4) = *(const f32x4*)(a.in[I_BIM] + o4); }
        {   const int dn = tid & 127, d = dn >> 6, n = dn & 63; const size_t o = (((size_t)l * 2 + d) * SG + g) * SN + n;
            const float are = a.in[I_ARE][o], aim = a.in[I_AIM][o], dt = expf(a.in[I_LDT][((size_t)l * 2 + d) * SG + g]);
            const float th = aim * dt;
            if (tid < 128) { const float mag = expf(are * dt), abr = mag * cosf(th), abi = mag * sinf(th);
                const float den = are * are + aim * aim, nr = abr - 1.0f, ni = abi;
                kr[tid] = (nr * are + ni * aim) / den; ki[tid] = (ni * are - nr * aim) / den; }
#pragma unroll
            for (int ii = 0; ii < 2; ++ii) { const int i = (tid >> 7) + 4 * ii, dl = -31 + 8 * oc + i; const int e = dl < 0 ? -dl : dl;
                const bool on = (dl == 0) || (dl > 0 && d == 0) || (dl < 0 && d == 1);
                const float mg = expf((float)e * are * dt), ph = (float)e * th;
                ErT[dn * 8 + i] = (on && dl <= 31) ? mg * cosf(ph) : 0.f; EiT[dn * 8 + i] = (on && dl <= 31) ? mg * sinf(ph) : 0.f; }
        }
        {
            const int q4 = tid >> 7, d = (tid >> 6) & 1, n = tid & 63; const size_t o = (((size_t)l * 2 + d) * SG + g) * SN + n;
            const float are = a.in[I_ARE][o], aim = a.in[I_AIM][o], dt = expf(a.in[I_LDT][((size_t)l * 2 + d) * SG + g]);
            const int t = 4 * oc + q4;
            const int e2 = d == 0 ? t + 1 : ST - t;
            const int e3 = d == 0 ? ST - 1 - t : t;
            const float m2 = expf((float)e2 * are * dt), p2 = (float)e2 * aim * dt, m3 = expf((float)e3 * are * dt), p3 = (float)e3 * aim * dt;
            E2r[tid] = m2 * cosf(p2); E2i[tid] = m2 * sinf(p2); E3r[tid] = m3 * cosf(p3); E3i[tid] = m3 * sinf(p3);
        }
        __syncthreads();
        { const int dn = tid >> 2; const float k_r = kr[dn], k_i = ki[dn];
          const f32x4 br = *(LAS f32x4*)(kBr + tid * 4), bi = *(LAS f32x4*)(kBi + tid * 4);
          *(LAS f32x4*)(kBr + tid * 4) = k_r * br - k_i * bi; *(LAS f32x4*)(kBi + tid * 4) = k_r * bi + k_i * br; }
        __syncthreads();
        {
            const int pq = tid & 255, p = pq >> 4, q = pq & 15, nh = tid >> 8;
            float acc[8];
#pragma unroll
            for (int i = 0; i < 8; ++i) acc[i] = 0.f;
            for (int d = 0; d < 2; ++d) {
#pragma unroll 4
                for (int n = nh * 32; n < nh * 32 + 32; ++n) {
                    const float cr = Cr[d * 1024 + p * 64 + n], ci = Ci[d * 1024 + p * 64 + n], Br = kBr[d * 1024 + n * 16 + q], Bi = kBi[d * 1024 + n * 16 + q];
                    const float xr = cr * Br - ci * Bi, xi = cr * Bi + ci * Br;
                    const f32x4 e0 = *(LAS f32x4*)(ErT + (d * 64 + n) * 8), e1 = *(LAS f32x4*)(ErT + (d * 64 + n) * 8 + 4), f0 = *(LAS f32x4*)(EiT + (d * 64 + n) * 8), f1 = *(LAS f32x4*)(EiT + (d * 64 + n) * 8 + 4);
#pragma unroll
                    for (int i = 0; i < 4; ++i) { acc[i] += xr * e0[i] - xi * f0[i]; acc[4 + i] += xr * e1[i] - xi * f1[i]; }
                }
            }
            if (nh == 1) {
#pragma unroll
                for (int i = 0; i < 8; ++i) red[i * 256 + pq] = acc[i]; }
            __syncthreads();
            if (nh == 0) {
#pragma unroll
                for (int i = 0; i < 8; ++i) red[i * 256 + pq] += acc[i]; }
            __syncthreads();
            for (int idx = tid; idx < 8 * 32 * 32; idx += 512) {
                const int i = idx >> 10, j = (idx >> 5) & 31, p2 = (idx >> 1) & 15, qh = idx & 1, dl = -31 + 8 * oc + i;
                if (dl > 31) continue;
                const int ad = dl < 0 ? -dl : dl; if (j >= ST - ad) continue;
                const int t = (dl > 0 ? dl : 0) + j, s = t - dl;
                const f32x4 v0 = *(LAS f32x4*)(red + i * 256 + p2 * 16 + qh * 8), v1 = *(LAS f32x4*)(red + i * 256 + p2 * 16 + qh * 8 + 4);
                *(u32x4*)(WCAT + ((size_t)g * 512 + t * SP + p2) * KCAT + s * SP + qh * 8) = pack8(v0, v1);
            }
        }
        for (int idx = tid; idx < 4 * 16 * 32; idx += 512) {
            const int kk8 = idx & 31, rp = idx >> 5, q4 = rp >> 4, p = rp & 15, d = kk8 >> 4, part = (kk8 >> 3) & 1, n0 = (kk8 & 7) * 8, t = 4 * oc + q4;
            f32x4 o0, o1;
#pragma unroll
            for (int e = 0; e < 8; ++e) { const int n = n0 + e; const float cr = Cr[d * 1024 + p * 64 + n], ci = Ci[d * 1024 + p * 64 + n], er = E2r[q4 * 128 + d * 64 + n], ei = E2i[q4 * 128 + d * 64 + n];
                const float v = part == 0 ? (cr * er - ci * ei) : -(cr * ei + ci * er); if (e < 4) o0[e] = v; else o1[e - 4] = v; }
            *(u32x4*)(WCAT + ((size_t)g * 512 + t * SP + p) * KCAT + 512 + kk8 * 8) = pack8(o0, o1);
        }
        for (int idx = tid; idx < 256 * 8; idx += 512) {
            const int c8 = idx & 7, j = idx >> 3, q4 = c8 >> 1, q0 = (c8 & 1) * 8, d = j >> 7, part = (j >> 6) & 1, n = j & 63, s = 4 * oc + q4;
            const float er = E3r[q4 * 128 + d * 64 + n], ei = E3i[q4 * 128 + d * 64 + n];
            f32x4 o0, o1;
#pragma unroll
            for (int e = 0; e < 8; ++e) { const float Br = kBr[d * 1024 + n * 16 + q0 + e], Bi = kBi[d * 1024 + n * 16 + q0 + e];
                const float v = part == 0 ? (er * Br - ei * Bi) : (er * Bi + ei * Br); if (e < 4) o0[e] = v; else o1[e - 4] = v; }
            *(u32x4*)(WST + ((size_t)g * 256 + j) * 512 + s * SP + q0) = pack8(o0, o1);
        }
    }
    __syncthreads();
}

__device__ __forceinline__ void ssm_carry(const Args& a, int l, int vb, int tid) {
    const int idx = vb * 512 + tid, n = idx & 63, d = (idx >> 6) & 1, g = (idx >> 7) & 31, b = idx >> 12;
    const size_t o = (((size_t)l * 2 + d) * SG + g) * SN + n;
    const float are = a.in[I_ARE][o], aim = a.in[I_AIM][o], dt = expf(a.in[I_LDT][((size_t)l * 2 + d) * SG + g]);
    const float mg = expf((float)ST * are * dt), ph = (float)ST * aim * dt, pr = mg * cosf(ph), pi = mg * sinf(ph);
    const float* SX = (const float*)(a.ws + WS_SX) + (size_t)g * NCOLP * 256 + d * 128 + n;
    bf16_t* UC = (bf16_t*)(a.ws + WS_UCAT) + (size_t)g * NCOLP * KCAT + 512 + d * 128 + n;
    float hr = 0.f, hi = 0.f;
#pragma unroll 1
    for (int st0 = 0; st0 < NCH; st0 += 34) {
        float xr[34], xi[34];
#pragma unroll
        for (int k = 0; k < 34; ++k) { const int st = st0 + k; int c;
            if (d == 0) c = st < 8 ? NCHL + st : st - 8; else c = st < 8 ? NCHL + 7 - st : NCHL - 1 - (st - 8);
            const int col = c * 8 + b; xr[k] = SX[(size_t)col * 256]; xi[k] = SX[(size_t)col * 256 + 64]; }
#pragma unroll
        for (int k = 0; k < 34; ++k) { const int st = st0 + k; int c;
            if (d == 0) c = st < 8 ? NCHL + st : st - 8; else c = st < 8 ? NCHL + 7 - st : NCHL - 1 - (st - 8);
            const int col = c * 8 + b;
            UC[(size_t)col * KCAT] = (bf16_t)f2bf(hr); UC[(size_t)col * KCAT + 64] = (bf16_t)f2bf(hi);
            const float nr = pr * hr - pi * hi + xr[k], ni = pr * hi + pi * hr + xi[k]; hr = nr; hi = ni; }
    }
}

#define DPPX(v, ctrl) __builtin_bit_cast(float, __builtin_amdgcn_update_dpp(0, __builtin_bit_cast(int, (v)), (ctrl), 0xf, 0xf, false))
__device__ __forceinline__ void qk_head_rows(bf16_t* p, const float* gain, const float* rope, int lpos  , int lane, const float osc, unsigned char* k8 = nullptr  ) {
    const int sub = lane & 7;
    u32x4 w0 = *(const u32x4*)p, w1 = *(const u32x4*)(p + 8);
    float x[16]; { f32x4 a0, a1, b0, b1; unpack8(w0, a0, a1); unpack8(w1, b0, b1);
#pragma unroll
        for (int i = 0; i < 4; ++i) { x[i] = a0[i]; x[4 + i] = a1[i]; x[8 + i] = b0[i]; x[12 + i] = b1[i]; } }
    float ss = 0.f;
#pragma unroll
    for (int i = 0; i < 16; ++i) ss += x[i] * x[i];
    ss += DPPX(ss, 0xB1);
    ss += DPPX(ss, 0x4E);
    ss += DPPX(ss, 0x141);
    const float rstd = osc * __builtin_amdgcn_rsqf(ss * (1.0f / HD) + EPS);
    const f32x4* g4 = (const f32x4*)(gain + sub * 16);
#pragma unroll
    for (int j = 0; j < 4; ++j) { const f32x4 gg = g4[j];
#pragma unroll
        for (int i = 0; i < 4; ++i) x[4 * j + i] = x[4 * j + i] * rstd * gg[i]; }
    float y[16];
    if (lpos >= 0) {
        const int axis = sub >> 2, posi = axis == 0 ? (lpos >> 6) : (lpos & 63), f0 = (sub & 1) * 16;
        const float sgn = (sub & 2) ? 1.0f : -1.0f;
        const f32x4* c4 = (const f32x4*)(rope + posi * 32 + f0); const f32x4* s4 = (const f32x4*)(rope + 2048 + posi * 32 + f0);
#pragma unroll
        for (int j = 0; j < 4; ++j) { const f32x4 cs = c4[j], sn = s4[j];
#pragma unroll
            for (int i = 0; i < 4; ++i) { const float other = DPPX(x[4 * j + i], 0x4E);
                y[4 * j + i] = x[4 * j + i] * cs[i] + sgn * other * sn[i]; } }
    } else {
#pragma unroll
        for (int i = 0; i < 16; ++i) y[i] = x[i];
    }
    if (k8) {
        int w[4];
#pragma unroll
        for (int j = 0; j < 4; ++j) { int v = 0; v = __builtin_amdgcn_cvt_pk_fp8_f32(y[4 * j], y[4 * j + 1], v, false); v = __builtin_amdgcn_cvt_pk_fp8_f32(y[4 * j + 2], y[4 * j + 3], v, true); w[j] = v; }
        *(u32x4*)(k8 + (sub >> 2) * 64 + (sub & 1) * 32 + ((sub >> 1) & 1) * 16) = (u32x4){(unsigned)w[0], (unsigned)w[1], (unsigned)w[2], (unsigned)w[3]};
        return; }
    f32x4 o0 = {y[0], y[1], y[2], y[3]}, o1 = {y[4], y[5], y[6], y[7]}, o2 = {y[8], y[9], y[10], y[11]}, o3 = {y[12], y[13], y[14], y[15]};
    *(u32x4*)p = pack8(o0, o1); *(u32x4*)(p + 8) = pack8(o2, o3);
}
__device__ __forceinline__ void v8t_pass(const Args& a, LAS unsigned char* lds, int gw, int NGW, int lane, int wave) {
    const bf16_t* VB = (const bf16_t*)(a.ws + WS_VB); unsigned char* V8T = a.ws + WS_V8T;
    LAS unsigned char* img = lds + wave * 16384;
    for (int tb = gw; tb < NB * NKVH * (KVLEN / 64); tb += NGW) {
        const int tile = tb % (KVLEN / 64), bh = tb / (KVLEN / 64), kvh = bh % NKVH, b = bh / NKVH;
        const int kk = lane, k5 = kk & 31, kgp = (k5 >> 2) & 1, sl = (k5 & 3) + 4 * (k5 >> 3) + 16 * (kk >> 5), pos = kgp * 32 + sl;
        const bf16_t* src = VB + ((size_t)b * KVLEN + tile * 64 + kk) * KVW + kvh * HD;
#pragma unroll
        for (int c = 0; c < 16; ++c) { const u32x4 w = *(const u32x4*)(src + c * 8); f32x4 v0, v1; unpack8(w, v0, v1);
            int p01 = 0, p23 = 0; p01 = __builtin_amdgcn_cvt_pk_fp8_f32(v0[0], v0[1], p01, false); p01 = __builtin_amdgcn_cvt_pk_fp8_f32(v0[2], v0[3], p01, true);
            p23 = __builtin_amdgcn_cvt_pk_fp8_f32(v1[0], v1[1], p23, false); p23 = __builtin_amdgcn_cvt_pk_fp8_f32(v1[2], v1[3], p23, true);
#pragma unroll
            for (int e = 0; e < 8; ++e) { const int d = c * 8 + e; unsigned byte = ((unsigned)(e < 4 ? p01 : p23) >> (8 * (e & 3))) & 0xFFu;
#ifdef CHECK_PK_ORDER
                { const float xv = e < 4 ? v0[e & 3] : v1[e & 3]; const unsigned single = (unsigned)__builtin_amdgcn_cvt_pk_fp8_f32(xv, xv, 0, false) & 0xFFu; if (single != byte) byte = 0x7Fu;
                  const unsigned b8p = (unsigned)__builtin_amdgcn_cvt_pk_bf8_f32(xv, 2.0f * xv, 0, false), b8lo = (unsigned)__builtin_amdgcn_cvt_pk_bf8_f32(xv, xv, 0, false) & 0xFFu; if ((b8p & 0xFFu) != b8lo) byte = 0x7Fu; }
#endif
                img[d * 64 + ((((pos >> 4) ^ ((d >> 2) & 3)) << 4) | (pos & 15))] = (unsigned char)byte; } }
        asm volatile("s_waitcnt lgkmcnt(0)" ::: "memory");
#pragma unroll
        for (int c = 0; c < 8; ++c) *(u32x4*)(V8T + (size_t)tb * 8192 + (c * 64 + lane) * 16) = *(const LAS u32x4*)(img + (c * 64 + lane) * 16);
        asm volatile("s_waitcnt lgkmcnt(0)" ::: "memory");
    }
}
__device__ __forceinline__ void qk_pass(const Args& a, int l, int gw, int NGW, int lane) {
    bf16_t* Q = (bf16_t*)(a.ws + WS_Q); bf16_t* KB = (bf16_t*)(a.ws + WS_KB); const float* rope = (const float*)(a.ws + WS_ROPE);
    const float* qg = a.in[I_QNG] + (size_t)l * HD; const float* kg = a.in[I_KNG] + (size_t)l * HD;
    (void)Q; (void)qg;
    for (int it = gw; it < NTOK / 4; it += NGW) { const int r = it * 4 + (lane >> 4);
        qk_head_rows(KB + (size_t)kvrow_of(r) * KVW + (lane & 15) * 16, kg, rope, r < NLAT ? (r & 4095) : -1, lane, 1.0f, (unsigned char*)(a.ws + WS_K8) + (size_t)kvrow_of(r) * KVW + ((lane & 15) >> 3) * 128); }
}

__host__ __device__ constexpr int cand_off(int i) { int o = 0; for (int k = 0; k < i; ++k) o += 16 / (k + 1); return o; }
__device__ __forceinline__ void gather_token(const Args& a, int l, int tok, const LAS unsigned* sid, const LAS float* sw, int lane, const bool dry);
__device__ __forceinline__ void peer_topk(const Args& a, int l, LAS unsigned char* lds, int gw, int NGW, int tid, int nrows, const bool dry) {
    const int wave = tid >> 6;
    const bf16_t* keys = (const bf16_t*)(a.ws + WS_KEYS) + (size_t)l * 2 * PKEYS * 128;
    const bf16_t* PQ = (const bf16_t*)(a.ws + WS_GA);
    __syncthreads();
    for (int c = tid; c < 4096; c += 512) { const int p = c >> 11, key = (c >> 4) & 127, cc = c & 15;
        *(LAS u32x4*)(lds + p * 32768 + KSWZ(key, cc * 16)) = *(const u32x4*)(keys + ((size_t)p * PKEYS + key) * 128 + cc * 8); }
    __syncthreads();
    LAS unsigned* xs = (LAS unsigned*)(lds + 65536 + wave * 2048);
    LAS unsigned* sid = (LAS unsigned*)(lds + 81920 + wave * 4096);
    LAS float* sw = (LAS float*)(lds + 81920 + wave * 4096 + 2048);
    const int T = (nrows + NGW - 1) / NGW, tbeg = gw * T, tend = (tbeg + T < nrows) ? tbeg + T : nrows;
#pragma unroll 1
    for (int t0 = tbeg; t0 < tend; t0 += 4) {
        const int ntb = (tend - t0 < 4) ? tend - t0 : 4;
        int lane_ = tid & 63; asm volatile("" : "+v"(lane_));
        const int lane = lane_, r32 = lane & 31, hi = lane >> 5;
        const int rv = (r32 >> 3) < ntb ? r32 : (ntb * 8 - 1);
        const size_t R = (size_t)t0 * 8 + rv;
        float a12[2][16];
#pragma unroll
        for (int p = 0; p < 2; ++p) {
            bf16x8 qv[8];
#pragma unroll
            for (int ds = 0; ds < 8; ++ds) qv[ds] = *(const bf16x8*)(PQ + R * 256 + p * 128 + ds * 16 + hi * 8);
            f32x16 acc[4];
#pragma unroll
            for (int kb = 0; kb < 4; ++kb) acc[kb] = f32x16{};
#pragma unroll
            for (int ds = 0; ds < 8; ++ds)
#pragma unroll
                for (int kb = 0; kb < 4; ++kb) { const bf16x8 ka = *(const LAS bf16x8*)(lds + p * 32768 + KSWZ(kb * 32 + r32, ds * 32 + hi * 16));
                    acc[kb] = __builtin_amdgcn_mfma_f32_32x32x16_bf16(ka, qv[ds], acc[kb], 0, 0, 0); }
            __builtin_amdgcn_sched_barrier(0);
            float top[16]; peer::top16_of_acc(acc, hi, top);
            __builtin_amdgcn_sched_barrier(0);
#pragma unroll
            for (int j = 0; j < 16; ++j) a12[p][j] = peer::vmax(top[j], shflx(top[15 - j], 32, lane));
            peer::bmerge16(a12[p]);
            __builtin_amdgcn_sched_barrier(0);
        }
        float cd[64];
#pragma unroll
        for (int i = 0; i < 16; ++i)
#pragma unroll
            for (int j = 0; j < 16; ++j) if ((i + 1) * (j + 1) <= 16) cd[cand_off(i) + j] = peer::setlow(a12[0][i] + a12[1][j], 0xFFu, (unsigned)(i * 16 + j));
#pragma unroll
        for (int n = 50; n < 64; ++n) cd[n] = -3.0e38f;
        __builtin_amdgcn_sched_barrier(0);
        float best[16], t[16];
#pragma unroll
        for (int blk = 0; blk < 4; ++blk) {
#pragma unroll
            for (int r = 0; r < 16; ++r) { if (blk == 0) best[r] = cd[r]; else t[r] = cd[blk * 16 + r]; }
            if (blk == 0) {   }
            else if (blk < 3) { peer::sort16(t); peer::merge_top16(best, t); }
            else { peer::sort16(t);
#pragma unroll
                for (int i = 0; i < 16; ++i) best[i] = peer::vmax(best[i], t[15 - i]); }
            __builtin_amdgcn_sched_barrier(0);
        }
#pragma unroll
        for (int p = 0; p < 2; ++p)
#pragma unroll
            for (int q = 0; q < 4; ++q) { unsigned w = 0;
#pragma unroll
                for (int e = 0; e < 4; ++e) w |= (__float_as_uint(a12[p][4 * q + e]) & 0x7Fu) << (8 * e);
                xs[(p * 4 + q) * 64 + lane] = w; }
        const float mx = cd[0]; float ex[16], sum = 0.f;
#pragma unroll
        for (int k = 0; k < 16; ++k) { ex[k] = __expf(best[k] - mx); sum += ex[k]; }
        const float inv = __builtin_amdgcn_rcpf(sum);
        unsigned ids[8]; float wts[8]; const unsigned him = 0u - (unsigned)hi;
#pragma unroll
        for (int k = 0; k < 8; ++k) { const float bsel = __uint_as_float((__float_as_uint(best[8 + k]) & him) | (__float_as_uint(best[k]) & ~him)); const float esel = __uint_as_float((__float_as_uint(ex[8 + k]) & him) | (__float_as_uint(ex[k]) & ~him));
            const unsigned code = __float_as_uint(bsel) & 0xFFu, ii = code >> 4, jj = code & 15u;
            const unsigned w1 = xs[(ii >> 2) * 64 + lane], w2 = xs[(4 + (jj >> 2)) * 64 + lane];
            const unsigned i1 = (w1 >> (8 * (ii & 3))) & 0x7Fu, i2 = (w2 >> (8 * (jj & 3))) & 0x7Fu;
            ids[k] = i1 * PKEYS + i2; wts[k] = esel * inv; }
        LAS unsigned* di = sid + r32 * 16 + hi * 8; LAS float* dw = sw + r32 * 16 + hi * 8;
        *(LAS u32x4*)di = (u32x4){ids[0], ids[1], ids[2], ids[3]}; *(LAS u32x4*)(di + 4) = (u32x4){ids[4], ids[5], ids[6], ids[7]};
        *(LAS f32x4*)dw = (f32x4){wts[0], wts[1], wts[2], wts[3]}; *(LAS f32x4*)(dw + 4) = (f32x4){wts[4], wts[5], wts[6], wts[7]};
        asm volatile("s_waitcnt lgkmcnt(0)" ::: "memory");
#pragma unroll 1
        for (int t4 = 0; t4 < ntb; ++t4) gather_token(a, l, t0 + t4, sid + t4 * 128, sw + t4 * 128, lane, dry);
    }
    __syncthreads();
}

typedef float f32x2v __attribute__((ext_vector_type(2)));
typedef float v32f __attribute__((ext_vector_type(32)));
typedef int v6i __attribute__((ext_vector_type(6)));
typedef unsigned u32x3 __attribute__((ext_vector_type(3)));
__device__ __forceinline__ float dpp_sum63(float v) {
#define DPP_ADD(ctrl, rmask) v += __builtin_bit_cast(float, __builtin_amdgcn_update_dpp(0, __builtin_bit_cast(int, v), ctrl, rmask, 0xf, false))
    DPP_ADD(0x111, 0xf); DPP_ADD(0x112, 0xf); DPP_ADD(0x114, 0xf); DPP_ADD(0x118, 0xf);
    DPP_ADD(0x142, 0xa); DPP_ADD(0x143, 0xc);
#undef DPP_ADD
    return v;
}
__device__ __forceinline__ void fp8x16(const u32x4 w, float (&f)[16]) {
#pragma unroll
    for (int j = 0; j < 4; ++j) { const f32x2v lo = __builtin_amdgcn_cvt_pk_f32_fp8((int)w[j], false), hi = __builtin_amdgcn_cvt_pk_f32_fp8((int)w[j], true);
        f[4 * j] = lo[0]; f[4 * j + 1] = lo[1]; f[4 * j + 2] = hi[0]; f[4 * j + 3] = hi[1]; }
}
__device__ __forceinline__ float reduce8(const float (&d)[8], int lane) {
    const bool b0 = lane & 1, b1 = lane & 2, b2 = lane & 4;
    float r1[4], r2[2];
#pragma unroll
    for (int p = 0; p < 4; ++p) { const float t = b0 ? d[2 * p + 1] : d[2 * p], u = b0 ? d[2 * p] : d[2 * p + 1]; r1[p] = t + DPPX(u, 0xB1); }
#pragma unroll
    for (int p = 0; p < 2; ++p) { const float t = b1 ? r1[2 * p + 1] : r1[2 * p], u = b1 ? r1[2 * p] : r1[2 * p + 1]; r2[p] = t + DPPX(u, 0x4E); }
    float r;
    { const float t = b2 ? r2[1] : r2[0], u = b2 ? r2[0] : r2[1];
      int x = __builtin_amdgcn_update_dpp(0, __builtin_bit_cast(int, u), 0x104, 0xf, 0x5, false);
      x = __builtin_amdgcn_update_dpp(x, __builtin_bit_cast(int, u), 0x114, 0xf, 0xa, false);
      r = t + __builtin_bit_cast(float, x); }
    r += DPPX(r, 0x128);
    r += __builtin_bit_cast(float, __builtin_amdgcn_ds_swizzle(__builtin_bit_cast(int, r), 0x401F));
    { auto rr = __builtin_amdgcn_permlane32_swap(__float_as_uint(r), __float_as_uint(r), false, false); r = __uint_as_float(rr[0]) + __uint_as_float(rr[1]); }
    return r;
}
__device__ __forceinline__ void gather_token(const Args& a, int l, int tok, const LAS unsigned* sid, const LAS float* sw, int lane, const bool dry) {
    const bf16_t* XN2 = (const bf16_t*)(a.ws + WS_XN2);
    const unsigned char* PU = a.ws + WS_PU + (size_t)l * PEXP * PROW; const unsigned char* PV = a.ws + WS_PV + (size_t)l * PEXP * PROW;
    const float* SU = (const float*)(a.ws + WS_PSU) + (size_t)l * PEXP; const float* SV = (const float*)(a.ws + WS_PSV) + (size_t)l * PEXP;
    const float* mod = (const float*)(a.ws + WS_MOD) + (size_t)l * 9 * MODW;
    float* hctx = (float*)(a.ws + WS_HCTX);
    {
        float x[16];
        { const u32x4 x0 = *(const u32x4*)(XN2 + (size_t)tok * DM + lane * 16), x1 = *(const u32x4*)(XN2 + (size_t)tok * DM + lane * 16 + 8);
#pragma unroll
          for (int i = 0; i < 4; ++i) { x[2 * i] = bflo(x0[i]); x[2 * i + 1] = bfhi(x0[i]); x[8 + 2 * i] = bflo(x1[i]); x[8 + 2 * i + 1] = bfhi(x1[i]); } }
        float out[16];
#pragma unroll
        for (int i = 0; i < 16; ++i) out[i] = 0.f;
#pragma unroll 1
        for (int half = 0; half < 2; ++half) {
            const unsigned id = sid[half * 64 + lane]; const float w = sw[half * 64 + lane];
            const float su = SU[id], sv = SV[id];
            float dotv = 0.f;
#if PEER_FP4
            typedef unsigned u32x2 __attribute__((ext_vector_type(2)));
            u32x2 b0[8], b1[8];
            const unsigned lo8 = (unsigned)lane * 8u;
#define PG_LOAD(dst, TAB, e0) _Pragma("unroll") for (int q = 0; q < 8; ++q) { const unsigned idq = (unsigned)__builtin_amdgcn_readlane((int)id, (e0) + q); dst[q] = *(const u32x2*)(TAB + (idq * 512u + lo8)); }
#define PG_CVT(src, q) const f32x2 f[8] = {__builtin_amdgcn_cvt_scalef32_pk_f32_fp4(src[q][0], 1.0f, 0), __builtin_amdgcn_cvt_scalef32_pk_f32_fp4(src[q][0], 1.0f, 1), __builtin_amdgcn_cvt_scalef32_pk_f32_fp4(src[q][0], 1.0f, 2), __builtin_amdgcn_cvt_scalef32_pk_f32_fp4(src[q][0], 1.0f, 3), \
                __builtin_amdgcn_cvt_scalef32_pk_f32_fp4(src[q][1], 1.0f, 0), __builtin_amdgcn_cvt_scalef32_pk_f32_fp4(src[q][1], 1.0f, 1), __builtin_amdgcn_cvt_scalef32_pk_f32_fp4(src[q][1], 1.0f, 2), __builtin_amdgcn_cvt_scalef32_pk_f32_fp4(src[q][1], 1.0f, 3)};
#define PG_DOT(src, e0) { float d8[8]; _Pragma("unroll") for (int q = 0; q < 8; ++q) { PG_CVT(src, q) f32x2 a0 = {0.f, 0.f}; \
                _Pragma("unroll") for (int i = 0; i < 8; ++i) { const f32x2 xx = {x[2 * i], x[2 * i + 1]}; a0 += f[i] * xx; } d8[q] = a0[0] + a0[1]; } \
                const float tot = reduce8(d8, lane); dotv = ((lane >> 3) == ((e0) >> 3)) ? tot : dotv; }
#define PG_ACC(src, e0) _Pragma("unroll") for (int q = 0; q < 8; ++q) { PG_CVT(src, q) \
                const float c0 = __builtin_bit_cast(float, __builtin_amdgcn_readlane(__builtin_bit_cast(int, coef), (e0) + q)); const f32x2 cc0 = {c0, c0}; \
                _Pragma("unroll") for (int i = 0; i < 8; ++i) { f32x2 o2 = {out[2 * i], out[2 * i + 1]}; o2 += cc0 * f[i]; out[2 * i] = o2[0]; out[2 * i + 1] = o2[1]; } }
#else
            u32x3 b0[8], b1[8];
            const unsigned lo12 = (unsigned)lane * 12u;
#define PG_LOAD(dst, TAB, e0) _Pragma("unroll") for (int q = 0; q < 8; ++q) { const unsigned idq = (unsigned)__builtin_amdgcn_readlane((int)id, (e0) + q); dst[q] = *(const u32x3*)(TAB + (idq * 768u + lo12)); }
#define PG_CVT(src, q) const v6i pk_ = {(int)src[q][0], (int)src[q][1], (int)src[q][2], (int)src[(q) + 1][0], (int)src[(q) + 1][1], (int)src[(q) + 1][2]}; const v32f f = __builtin_amdgcn_cvt_scalef32_pk32_f32_fp6(pk_, 1.0f);
#define F2(i) ((f32x2){f[2 * (i)], f[2 * (i) + 1]})
#define PG_DOT(src, e0) { float d8[8]; _Pragma("unroll") for (int q = 0; q < 8; q += 2) { PG_CVT(src, q) f32x2 a0 = {0.f, 0.f}, a1 = {0.f, 0.f}; \
                _Pragma("unroll") for (int i = 0; i < 8; ++i) { const f32x2 xx = {x[2 * i], x[2 * i + 1]}; a0 += F2(i) * xx; a1 += F2(8 + i) * xx; } d8[q] = a0[0] + a0[1]; d8[q + 1] = a1[0] + a1[1]; } \
                const float tot = reduce8(d8, lane); dotv = ((lane >> 3) == ((e0) >> 3)) ? tot : dotv; }
#define PG_ACC(src, e0) _Pragma("unroll") for (int q = 0; q < 8; q += 2) { PG_CVT(src, q) \
                const float c0 = __builtin_bit_cast(float, __builtin_amdgcn_readlane(__builtin_bit_cast(int, coef), (e0) + q)), c1 = __builtin_bit_cast(float, __builtin_amdgcn_readlane(__builtin_bit_cast(int, coef), (e0) + q + 1)); \
                const f32x2 cc0 = {c0, c0}, cc1 = {c1, c1}; \
                _Pragma("unroll") for (int i = 0; i < 8; ++i) { f32x2 o2 = {out[2 * i], out[2 * i + 1]}; o2 += cc0 * F2(i); o2 += cc1 * F2(8 + i); out[2 * i] = o2[0]; out[2 * i + 1] = o2[1]; } }
#endif
#if PEER_FP4
            u32x2 b2[8];
#else
            u32x3 b2[8];
#endif
#define PG_STEPA(cur, nxt, kb) { const int kl_ = (kb) + 2; if (kl_ < 8) { PG_LOAD(nxt, PU, kl_ * 8) } else { PG_LOAD(nxt, PV, (kl_ - 8) * 8) } PG_DOT(cur, (kb) * 8) }
#define PG_STEPB(cur, nxt, kb) { const int kl_ = (kb) + 2; if (kl_ < 8) { PG_LOAD(nxt, PV, kl_ * 8) } PG_ACC(cur, (kb) * 8) }
            PG_LOAD(b0, PU, 0) PG_LOAD(b1, PU, 8)
#pragma unroll 1
            for (int kb = 0; kb < 6; kb += 3) { PG_STEPA(b0, b2, kb) PG_STEPA(b1, b0, kb + 1) PG_STEPA(b2, b1, kb + 2) }
            PG_STEPA(b0, b2, 6) PG_STEPA(b1, b0, 7)
            const float coef = w * gelu_tanh(dotv * su) * sv;
#pragma unroll 1
            for (int kb = 0; kb < 6; kb += 3) { PG_STEPB(b2, b1, kb) PG_STEPB(b0, b2, kb + 1) PG_STEPB(b1, b0, kb + 2) }
            PG_STEPB(b2, b1, 6) PG_STEPB(b0, b2, 7)
#undef PG_STEPA
#undef PG_STEPB
#undef PG_LOAD
#undef PG_CVT
#undef PG_DOT
#undef PG_ACC
        }
        if (dry) { float sink = 0.f;
#pragma unroll
            for (int i = 0; i < 16; ++i) sink += out[i];
            asm volatile("" :: "v"(sink)); return; }
        float* hr = hrow_m(a.out, hctx, tok) + lane * 16;
        const float* gt = mod + (size_t)modrow_of(tok) * MODW + 5 * DM + lane * 16;
        f32x4 hv[4]; float ss = 0.f;
#pragma unroll
        for (int j = 0; j < 4; ++j) { hv[j] = *(const f32x4*)(hr + 4 * j); const f32x4 g4 = *(const f32x4*)(gt + 4 * j);
#pragma unroll
            for (int i = 0; i < 4; ++i) hv[j][i] += g4[i] * out[4 * j + i];
            *(f32x4*)(hr + 4 * j) = hv[j];
            ss += (hv[j][0] * hv[j][0] + hv[j][1] * hv[j][1]) + (hv[j][2] * hv[j][2] + hv[j][3] * hv[j][3]); }
        if (l + 1 < DEPTH) {
            ss = wave_sum(ss, lane);
            const float rstd = __builtin_amdgcn_rsqf(ss * (1.0f / DM) + EPS);
            const float* g = a.in[I_NMG] + (size_t)(l + 1) * DM + lane * 16; const float* mr = mod + 9 * MODW + (size_t)modrow_of(tok) * MODW + lane * 16;
            bf16_t* orow = (bf16_t*)(a.ws + WS_XN) + (size_t)tok * DM + lane * 16;
            f32x4 o[4];
#pragma unroll
            for (int j = 0; j < 4; ++j) { const f32x4 gg = *(const f32x4*)(g + 4 * j), s1 = *(const f32x4*)(mr + DM + 4 * j), s0 = *(const f32x4*)(mr + 4 * j);
                o[j] = hv[j] * rstd * gg * (1.0f + s1) + s0; }
            *(u32x4*)orow = pack8(o[0], o[1]); *(u32x4*)(orow + 8) = pack8(o[2], o[3]);
        }
    }
}

constexpr int NPH_LAYER = 10, NPHASE = 2 + NPH_LAYER * DEPTH;
__global__ void __launch_bounds__(512, 2) mega_fwd(Args a_in) {
    extern __shared__ __attribute__((aligned(16))) unsigned char lds_[];
    LAS unsigned char* lds = (LAS unsigned char*)lds_;
    const int bx = blockIdx.x, G = gridDim.x, NGW = G * 8;
#define PHASE_IDS const int lane = lane_id_now(), wave = wave_s, tid = wave_s * 64 + lane, gw = bx * 8 + wave; (void)lane; (void)gw; (void)tid; \
    const __attribute__((address_space(4))) Args* ap_ = (const __attribute__((address_space(4))) Args*)__builtin_amdgcn_kernarg_segment_ptr(); asm volatile("" : "+s"(ap_)); const Args& a = *(const Args*)ap_; \
    unsigned char* ws = a.ws; (void)ws;
    const int wave_s = __builtin_amdgcn_readfirstlane(threadIdx.x >> 6);
    volatile LAS unsigned* MISC = (volatile LAS unsigned*)(lds + MISC_OFF);
    if (threadIdx.x < 32) MISC[threadIdx.x] = 0u;
    __syncthreads();
    unsigned* ctl = (unsigned*)(a_in.ws + WS_CTL);
    XcdBarrier bar; bar.bar = ctl + CW_BAR; bar.x = 0; bar.st = MISC + 8;
    if (!MK_MULTI) bar = xcd_barrier_post(ctl + CW_BAR, MISC + 8);
    int lo = a_in.ph_lo, hi = a_in.ph_hi;
#define IN(k) (lo <= (k) && (k) < hi)
#define SEAM(k) do { if (!MK_MULTI && IN(k) && IN((k) + 1)) xcd_barrier(bar, wave_s == 0 && lane_id_now() == 0); } while (0)
#define XN ((bf16_t*)(ws + WS_XN))
#define XN2 ((bf16_t*)(ws + WS_XN2))
#define Qb ((bf16_t*)(ws + WS_Q))
#define KB ((bf16_t*)(ws + WS_KB))
#define VB ((bf16_t*)(ws + WS_VB))
#define UCAT ((bf16_t*)(ws + WS_UCAT))
#define GA ((bf16_t*)(ws + WS_GA))
#define GBb ((bf16_t*)(ws + WS_GB))
#define YG ((bf16_t*)(ws + WS_YG))
#define SSMO ((bf16_t*)(ws + WS_SSMO))
#define Y XN
#define PQ GA
#define hctx ((float*)(ws + WS_HCTX))
#define wl (ws + WS_WT + (size_t)l * WT_LAYER)
#define mod ((const float*)(ws + WS_MOD) + (size_t)l * 9 * MODW)

    if (DG(0) && IN(0)) REPS(0) { PHASE_IDS p0a(a, lds, bx, G, tid); }
    SEAM(0);
    if (DG(1) && IN(1)) { PHASE_IDS norm_pass(a, 0, 0, XN, gw, NGW, lane, NTOK, a.in[I_X]); }
    SEAM(1);

    for (int l = 0; l < DEPTH; ++l) {
        const int pb = 2 + NPH_LAYER * l;
        asm volatile("" : "+s"(lo), "+s"(hi));
        const int MR = (l + 1 < DEPTH) ? NTOK : NLAT;
        if (DG(2) && IN(pb + 0)) REPS(2) { PHASE_IDS
            ssm_tables(a, l, lds, bx, G, tid);
            pg8::Gemm g{XN, (const bf16_t*)(wl + WT_IN)}; pg8::SplitOrder S; S.init(NTOK, INW, G, bx);
            pg8::EpiIn E{ws};
            pg8::gemm_phase<DM, DM, DM, 0, 0>(lds, g, S, E, tid);
        }
        SEAM(pb + 0);
        if (DG(3) && IN(pb + 1)) REPS(3) { PHASE_IDS
            qk_pass(a, l, gw, NGW, lane);
            v8t_pass(a, lds, gw, NGW, lane, wave);
            __syncthreads();
            pg8::Gemm g{UCAT, (const bf16_t*)(ws + WS_WSTATE)}; pg8::BatchOrder S; S.init(NCOLP / 256, 1, SG, G, (G % 8 == 0) ? (bx % 8) * (G / 8) + bx / 8 : bx);
            pg8::EpiSX E{(float*)(ws + WS_SX)};
            pg8::gemm_phase<512, KCAT, 512, (size_t)NCOLP * KCAT * 2, (size_t)256 * 512 * 2>(lds, g, S, E, tid);
        }
        SEAM(pb + 1);
        if (DG(4) && IN(pb + 2)) REPS(4) { PHASE_IDS
            float nm0;
            { float gq = fmaxf(fabsf(a.in[I_QNG][(size_t)l * HD + lane]), fabsf(a.in[I_QNG][(size_t)l * HD + 64 + lane])), gk = fmaxf(fabsf(a.in[I_KNG][(size_t)l * HD + lane]), fabsf(a.in[I_KNG][(size_t)l * HD + 64 + lane]));
#pragma unroll
              for (int o = 1; o < 64; o <<= 1) { gq = fmaxf(gq, shflx(gq, o, lane)); gk = fmaxf(gk, shflx(gk, o, lane)); }
              nm0 = -(float)HD * gq * gk * att::SCALE * 1.4426950408889634f * 1.01f; }
            for (int vb = G - 1 - bx; vb < 64; vb += G) ssm_carry(a, l, vb, tid);
            __syncthreads();
            const int x8 = bx & 7, j32 = bx >> 3;
            const int nlat = (G == 256) ? 4 : (bx < NB * NQH * 16 ? (NB * NQH * 16 - 1 - bx) / G + 1 : 0);
            const int nctx = (l + 1 < DEPTH && bx < NB * NQH) ? (NB * NQH - 1 - bx) / G + 1 : 0;
#pragma unroll 1
            for (int i = 0; i < nlat + nctx; ++i) {
                size_t qoff, koff; int seq, lpos0;
                if (i < nlat) {
                    int b, h, qb;
                    if (G == 256) { const int combo = x8 + 8 * (i >> 1), un = (i & 1) * 32 + j32; b = combo >> 1; h = (combo & 1) * 4 + (un >> 4); qb = un & 15; }
                    else { const int u = bx + i * G; b = u >> 7; h = (u >> 4) & 7; qb = u & 15; }
                    qoff = ((size_t)b * SEQ + qb * 256) * DM + h * HD; koff = (size_t)b * KVLEN * KVW + (h >> 2) * HD; seq = KVLEN; lpos0 = qb * 256;
                } else {
                    const int u = bx + (i - nlat) * G, b = u >> 3, h = u & 7;
                    qoff = ((size_t)NLAT + b * CTXL) * DM + h * HD; koff = ((size_t)b * KVLEN + SEQ) * KVW + (h >> 2) * HD; seq = CTXL; lpos0 = -1;
                }
                att::attn_dense_body_dma(Qb + qoff, KB + koff, seq, (char*)lds_, lds, wave_s * 64 + lane_id_now(), (PROBE_PHASE == 4 && rep_ + 1 < PROBE_REPS) ? (long)WS_YG - (long)WS_Q : 0L, nm0,
                                         a.in[I_QNG] + (size_t)l * HD, (const float*)(ws + WS_ROPE), lpos0, (const unsigned char*)(ws + WS_K8) + koff, (const unsigned char*)(ws + WS_V8T) + (((size_t)(koff / ((size_t)KVLEN * KVW)) * NKVH + (koff % KVW) / HD) * (KVLEN / 64) + (seq == KVLEN ? 0 : SEQ / 64)) * 8192);
            }
        }
        SEAM(pb + 2);
        if (DG(5) && IN(pb + 3)) REPS(5) { PHASE_IDS
            pg8::Gemm g{UCAT, (const bf16_t*)(ws + WS_WCAT)}; pg8::BatchOrder S; S.init(l + 1 < DEPTH ? NCOLP / 256 : NCOLP / 256 - 1, 2, SG, G, (G % 8 == 0) ? (bx % 8) * (G / 8) + bx / 8 : bx, l + 1 < DEPTH ? NCOLP / 256 - 1 : -1);
            pg8::EpiS3 E{UCAT, a.in[I_SD] + (size_t)l * SSMW, YG};
            pg8::gemm_phase<KCAT, KCAT, KCAT, (size_t)NCOLP * KCAT * 2, (size_t)512 * KCAT * 2>(lds, g, S, E, tid);
        }
        SEAM(pb + 3);
        if (DG(6) && IN(pb + 4)) REPS(6) { PHASE_IDS
            pg8::Gemm g{YG, (const bf16_t*)(wl + WT_GLU)}; pg8::SplitOrder S; S.init(MR, SSMW, G, bx);
            pg8::EpiGlu E{YG, a.in[I_BGLU] + (size_t)l * SSMW, SSMO};
            pg8::gemm_phase<SSMW, SSMW, SSMW, 0, 0>(lds, g, S, E, tid);
        }
        SEAM(pb + 4);
        if (DG(7) && IN(pb + 5)) REPS(7) { PHASE_IDS
            pg8::SplitOrder S; S.init(MR, DM, G, bx);
            { pg8::Gemm g{Qb, (const bf16_t*)(wl + WT_BA)}; pg8::EpiMerge<false> E{GA, Y}; pg8::gemm_phase<DM, DM, DM, 0, 0>(lds, g, S, E, tid); }
            { pg8::Gemm g{SSMO, (const bf16_t*)(wl + WT_BS)}; pg8::EpiMerge<true> E{GBb, Y}; pg8::gemm_phase<SSMW, SSMW, SSMW, 0, 0>(lds, g, S, E, tid); }
        }
        SEAM(pb + 5);
        if (DG(8) && IN(pb + 6)) REPS(8) { PHASE_IDS
            pg8::Gemm g{Y, (const bf16_t*)(wl + WT_O)}; pg8::SplitOrder S; S.init(MR, DM, G, bx);
            pg8::EpiWo E{l == 0 ? a.in[I_X] : (const float*)a.out, a.out, hctx, mod + 2 * DM};
            pg8::gemm_phase<DM, DM, DM, 0, 0>(lds, g, S, E, tid);
        }
        SEAM(pb + 6);
        if (DG(9) && IN(pb + 7)) REPS(9) { PHASE_IDS norm_pass(a, l, 1, XN2, gw, NGW, lane, MR, a.out); }
        SEAM(pb + 7);
        if (DG(10) && IN(pb + 8)) REPS(10) { PHASE_IDS
            pg8::Gemm g{XN2, (const bf16_t*)(wl + WT_Q)}; pg8::SplitOrder S; S.init(MR, PQW, G, bx);
            pg8::EpiBf16 E{PQ, PQW};
            pg8::gemm_phase<DM, DM, DM, 0, 0>(lds, g, S, E, tid);
        }
        SEAM(pb + 8);
        if (DG(11) && IN(pb + 9)) REPS(11) { PHASE_IDS peer_topk(a, l, lds, gw, NGW, tid, MR, PROBE_PHASE == 11 && rep_ + 1 < PROBE_REPS); }
        SEAM(pb + 9);
    }
#undef IN
#undef SEAM
}

extern "C" void kernel_launch(void* const* d_in, const int* in_sizes, int n_in, void* d_out, int out_size, void* d_ws, size_t ws_size, hipStream_t stream) {
    static int grid = 0;
    if (grid == 0) {
        if (n_in != 28 || out_size != NLAT * DM || ws_size < WS_END) { fprintf(stderr, "kernel_launch: unexpected shapes (n_in %d out %d ws %zu, need ws >= %zu)\n", n_in, out_size, ws_size, (size_t)WS_END); grid = -1; return; }
        int dev = 0, cus = 0;
        if (hipGetDevice(&dev) != hipSuccess || hipDeviceGetAttribute(&cus, hipDeviceAttributeMultiprocessorCount, dev) != hipSuccess) { grid = -1; return; }
        if (hipFuncSetAttribute((const void*)mega_fwd, hipFuncAttributeMaxDynamicSharedMemorySize, LDS_BYTES) != hipSuccess) { fprintf(stderr, "kernel_launch: hipFuncSetAttribute failed\n"); grid = -1; return; }
        int per_cu = 0;
        if (hipOccupancyMaxActiveBlocksPerMultiprocessor(&per_cu, (const void*)mega_fwd, 512, LDS_BYTES) != hipSuccess || per_cu < 1) fprintf(stderr, "kernel_launch: occupancy query reports %d\n", per_cu);
        (void)hipGetLastError();
        grid = cus;
    }
    if (grid < 0) return;
    (void)hipMemsetAsync((char*)d_ws + WS_CTL, 0, CTL_ZERO_BYTES, stream);
    Args a{};
    for (int i = 0; i < 28; ++i) a.in[i] = (const float*)d_in[i];
    a.out = (float*)d_out; a.ws = (unsigned char*)d_ws;
#if MK_MULTI
    for (int p = 0; p < NPHASE; ++p) { a.ph_lo = p; a.ph_hi = p + 1; hipLaunchKernelGGL(mega_fwd, dim3(grid), dim3(512), LDS_BYTES, stream, a); }
#else
    a.ph_lo = 0; a.ph_hi = NPHASE;
    hipLaunchKernelGGL(mega_fwd, dim3(grid), dim3(512), LDS_BYTES, stream, a);
#endif
    const hipError_t le = hipPeekAtLastError();
    if (le != hipSuccess) fprintf(stderr, "kernel_launch: launch failed: %s\n", hipGetErrorName(le));
}
```

```cpp
#include <hip/hip_runtime.h>
#include <cstdio>
#include <cstdint>

#define GAS __attribute__((address_space(1)))
#define LAS __attribute__((address_space(3)))
typedef unsigned short bf16_t;
typedef short bf16x8 __attribute__((ext_vector_type(8)));
typedef short s16x4 __attribute__((ext_vector_type(4)));
typedef float f32x2 __attribute__((ext_vector_type(2)));
typedef float f32x4 __attribute__((ext_vector_type(4)));
typedef float f32x16 __attribute__((ext_vector_type(16)));
typedef unsigned u32x2 __attribute__((ext_vector_type(2)));
typedef unsigned u32x4 __attribute__((ext_vector_type(4)));

#ifndef MK_MULTI
#define MK_MULTI 0
#endif
#ifndef DIAG_MASK
#define DIAG_MASK 0xFFFF
#endif
#define DG(k) ((DIAG_MASK >> (k)) & 1)
#ifndef PEER_FP4
#define PEER_FP4 1
#endif
#ifndef PROBE_PHASE
#define PROBE_PHASE -1
#endif
#ifndef PROBE_REPS
#define PROBE_REPS 1
#endif
#define REPS(k) _Pragma("unroll 1") for (int rep_ = 0; rep_ < ((PROBE_PHASE == (k)) ? PROBE_REPS : 1); ++rep_)
#ifndef EN_ATTN
#define EN_ATTN 1
#endif
#ifndef EN_SSM
#define EN_SSM 1
#endif
#ifndef EN_PEER
#define EN_PEER 1
#endif

constexpr int DM = 1024, NB = 8, SEQ = 4096, DEPTH = 4, CTXL = 256;
constexpr int NLAT = NB * SEQ, NCTX = NB * CTXL, NTOK = NLAT + NCTX;
constexpr int HD = 128, NQH = 8, NKVH = 2, KVW = NKVH * HD, KVLEN = SEQ + CTXL;
constexpr int SSMW = 512, SG = 32, SP = 16, SN = 64, ST = 32;
constexpr int NCH = KVLEN / ST, NCHL = SEQ / ST, NCOL = NB * NCH, NCOLP = 1280, KCAT = 768;
constexpr int INW = 4096, NMOD = 6, MODW = NMOD * DM;
constexpr int PH = 8, PKEYS = 128, PEXP = PKEYS * PKEYS, PQW = 2048, PTOPK = 16;
constexpr float EPS = 1e-6f;

constexpr size_t MiB = 1u << 20;
constexpr size_t WS_CTL = 0, CTL_ZERO_BYTES = 64 * 1024;
constexpr size_t WS_MOD = 1 * MiB;
constexpr size_t WS_ROPE = 2 * MiB;
constexpr size_t WS_KEYS = 3 * MiB;
constexpr size_t WS_HCTX = 4 * MiB;
constexpr size_t WS_WT = 12 * MiB;
constexpr size_t WT_IN = 0, WT_BA = 8 * MiB, WT_BS = 10 * MiB, WT_O = 11 * MiB, WT_GLU = 13 * MiB, WT_Q = 13 * MiB + 512 * 1024, WT_LAYER = 17 * MiB + 512 * 1024;
constexpr size_t WS_WCAT = 82 * MiB;
constexpr size_t WS_WSTATE = 106 * MiB;
constexpr size_t WS_UCAT = 114 * MiB;
constexpr size_t WS_SX = 174 * MiB;
constexpr size_t WS_XN = 214 * MiB;
constexpr size_t WS_XN2 = 282 * MiB;
constexpr size_t WS_Q = 350 * MiB;
constexpr size_t WS_KB = 418 * MiB, WS_VB = 435 * MiB;
constexpr size_t WS_GA = 452 * MiB, WS_GB = 520 * MiB;
constexpr size_t WS_YG = 588 * MiB, WS_SSMO = 622 * MiB;
constexpr size_t WS_WIN8 = 722 * MiB;
constexpr float WSCALE8 = 32.0f;
constexpr float HSC8 = 16.0f, TSC8 = 1024.0f, WOSC8 = 64.0f;
constexpr size_t W8_GLU = 26 * MiB;
constexpr size_t W8_MIX = 16 * MiB, W8_MIX_LAYER = 2 * MiB + 512 * 1024, W8_BA = 0, W8_BS = 1 * MiB, W8_O = 1 * MiB + 512 * 1024;
constexpr size_t WS_V8T = 672 * MiB;
constexpr size_t WS_K8 = 656 * MiB;
constexpr size_t WS_PU = 690 * MiB, WS_PV = 754 * MiB;
constexpr int PROW = PEER_FP4 ? 512 : 768;
constexpr float QMAX = PEER_FP4 ? 6.0f : 7.5f;
constexpr size_t WS_PSU = 818 * MiB, WS_PSV = 819 * MiB;
constexpr size_t WS_HB = 820 * MiB;
constexpr size_t WS_END = 888 * MiB;
constexpr int CW_BAR = 1024;

constexpr int RING_BYTES = 131072;
constexpr int MISC_OFF = RING_BYTES;
constexpr int LDS_BYTES = 147456;

__device__ __forceinline__ unsigned f2bf(float f) { unsigned u = __builtin_bit_cast(unsigned, f); return (u + 0x7fffu + ((u >> 16) & 1u)) >> 16; }
__device__ __forceinline__ unsigned pk2(float lo, float hi) { return f2bf(lo) | (f2bf(hi) << 16); }
__device__ __forceinline__ unsigned cvt_pk_bf16(float lo, float hi) { unsigned r; asm volatile("v_cvt_pk_bf16_f32 %0, %1, %2" : "=v"(r) : "v"(lo), "v"(hi)); return r; }
__device__ __forceinline__ float bflo(unsigned w) { return __builtin_bit_cast(float, w << 16); }
__device__ __forceinline__ float bfhi(unsigned w) { return __builtin_bit_cast(float, w & 0xffff0000u); }
__device__ __forceinline__ int lane_id_now() { int l_; asm volatile("v_mbcnt_lo_u32_b32 %0, -1, 0\n\tv_mbcnt_hi_u32_b32 %0, -1, %0" : "=v"(l_)); return l_; }
__device__ __forceinline__ float shflx(float v, int o, int lane) { return __builtin_bit_cast(float, __builtin_amdgcn_ds_bpermute((lane ^ o) << 2, __builtin_bit_cast(int, v))); }
__device__ __forceinline__ float wave_sum(float v, int lane) {
#pragma unroll
    for (int o = 1; o < 64; o <<= 1) v += shflx(v, o, lane);
    return v;
}
__device__ __forceinline__ float sigmoidf_(float x) { return __builtin_amdgcn_rcpf(1.0f + __builtin_amdgcn_exp2f(-1.4426950408889634f * x)); }
__device__ __forceinline__ float gelu_tanh(float x) {
    const float z = 0.7978845608028654f * (x + 0.044715f * x * x * x);
    const float t = 1.0f - 2.0f * __builtin_amdgcn_rcpf(__builtin_amdgcn_exp2f(2.0f * 1.4426950408889634f * z) + 1.0f);
    return 0.5f * x * (1.0f + t);
}
__device__ __forceinline__ u32x4 pack8(const f32x4 a, const f32x4 b) {
    u32x4 w; w.x = cvt_pk_bf16(a[0], a[1]); w.y = cvt_pk_bf16(a[2], a[3]); w.z = cvt_pk_bf16(b[0], b[1]); w.w = cvt_pk_bf16(b[2], b[3]); return w;
}
__device__ __forceinline__ void unpack8(const u32x4 w, f32x4& a, f32x4& b) {
    a[0] = bflo(w.x); a[1] = bfhi(w.x); a[2] = bflo(w.y); a[3] = bfhi(w.y); b[0] = bflo(w.z); b[1] = bfhi(w.z); b[2] = bflo(w.w); b[3] = bfhi(w.w);
}
__device__ __forceinline__ u32x2 pack8_fp8(const f32x4 a, const f32x4 b) {
    int w0 = 0, w1 = 0;
    w0 = __builtin_amdgcn_cvt_pk_fp8_f32(a[0], a[1], w0, false); w0 = __builtin_amdgcn_cvt_pk_fp8_f32(a[2], a[3], w0, true);
    w1 = __builtin_amdgcn_cvt_pk_fp8_f32(b[0], b[1], w1, false); w1 = __builtin_amdgcn_cvt_pk_fp8_f32(b[2], b[3], w1, true);
    return (u32x2){(unsigned)w0, (unsigned)w1};
}
__device__ __forceinline__ void unpack8_fp8(const u32x2 w, f32x4& a, f32x4& b) {
    const f32x2 a0 = __builtin_amdgcn_cvt_pk_f32_fp8((int)w.x, false), a1 = __builtin_amdgcn_cvt_pk_f32_fp8((int)w.x, true), b0 = __builtin_amdgcn_cvt_pk_f32_fp8((int)w.y, false), b1 = __builtin_amdgcn_cvt_pk_f32_fp8((int)w.y, true);
    a = (f32x4){a0[0], a0[1], a1[0], a1[1]}; b = (f32x4){b0[0], b0[1], b1[0], b1[1]};
}
__device__ __forceinline__ int modrow_of(int r) { return r < NLAT ? (r >> 12) : NB; }
__device__ __forceinline__ int kvrow_of(int r) { if (r < NLAT) return (r >> 12) * KVLEN + (r & 4095); const int q = r - NLAT; return (q >> 8) * KVLEN + SEQ + (q & 255); }

#define XB_TMO      128
#define XB_XCNT(j)  (256  + 64 * (j))
#define XB_XSUB(j)  (1280 + 64 * (j))
#define XB_XGEN(j)  (2304 + 64 * (j))
#define XB_TOP      3328
#define XB_TOPGEN   3392
#define XCD_BAR_WORDS 3456
#define XB_SPIN_CAP (1u << 18)
__device__ __forceinline__ unsigned xb_ld(unsigned* p)              { return __hip_atomic_load(p, __ATOMIC_RELAXED, __HIP_MEMORY_SCOPE_AGENT); }
__device__ __forceinline__ unsigned xb_add(unsigned* p, unsigned v) { return __hip_atomic_fetch_add(p, v, __ATOMIC_RELAXED, __HIP_MEMORY_SCOPE_AGENT); }
__device__ __forceinline__ unsigned xb_xcc_id() { return (unsigned)__builtin_amdgcn_s_getreg((3 << 11) | 20) & 0xFu; }
#define XB_SPIN(cond, bar) do { unsigned _sp = 0; while (cond) { __builtin_amdgcn_s_sleep(1); \
    if ((++_sp & 255u) == 0u) { if (xb_ld(&(bar)[XB_TMO])) break; if (_sp > XB_SPIN_CAP) { atomicAdd(&(bar)[XB_TMO], 1u); break; } } } } while (0)
struct XcdBarrier { unsigned* bar; unsigned x; volatile LAS unsigned* st; };
__device__ __forceinline__ XcdBarrier xcd_barrier_post(unsigned* bar, volatile LAS unsigned* st) {
    XcdBarrier b; b.bar = bar; b.x = xb_xcc_id(); b.st = st;
    if (threadIdx.x == 0) (void)xb_add(&bar[XB_XCNT(b.x)], 1u);
    return b;
}
__device__ __forceinline__ void xcd_barrier_complete(unsigned* bar, unsigned x, unsigned& nloc, unsigned& nx) {
    const unsigned G = gridDim.x * gridDim.y * gridDim.z;
    unsigned sum, cnt, mine, sp = 0u;
    for (;;) {
        sum = 0u; cnt = 0u; mine = 0u;
#pragma unroll
        for (unsigned j = 0; j < 16; ++j) { const unsigned c = xb_ld(&bar[XB_XCNT(j)]); sum += c; cnt += (c > 0u) ? 1u : 0u; mine = (j == x) ? c : mine; }
        if (sum == G) break;
        __builtin_amdgcn_s_sleep(1);
        if ((++sp & 255u) == 0u) { if (xb_ld(&bar[XB_TMO])) break; if (sp > XB_SPIN_CAP) { atomicAdd(&bar[XB_TMO], 1u); break; } }
    }
    nloc = mine > 0u ? mine : 1u; nx = cnt > 0u ? cnt : 1u;
}
__device__ __forceinline__ void xcd_barrier(const XcdBarrier& b, const bool t0  ) {
    asm volatile("s_waitcnt vmcnt(0)" ::: "memory");
    __syncthreads();
    if (t0) {
        unsigned* bar = b.bar;
        __builtin_amdgcn_s_waitcnt(0);
        unsigned nloc = b.st[0], nx = b.st[1];
        if (nloc == 0u) { unsigned x_ = b.x; asm volatile("" : "+s"(x_));
            xcd_barrier_complete(bar, x_, nloc, nx); b.st[0] = nloc; b.st[1] = nx; }
        const unsigned old = xb_add(&bar[XB_XSUB(b.x)], 1u);
        const unsigned gen = old / nloc;
        if (old + 1u == (gen + 1u) * nloc) {
            __builtin_amdgcn_fence(__ATOMIC_RELEASE, "agent");
            asm volatile("s_waitcnt vmcnt(0)" ::: "memory");
            const unsigned og = xb_add(&bar[XB_TOP], 1u);
            const unsigned tg = og / nx;
            if (og + 1u == (tg + 1u) * nx) xb_add(&bar[XB_TOPGEN], 1u);
            else XB_SPIN(xb_ld(&bar[XB_TOPGEN]) == tg, bar);
            __builtin_amdgcn_fence(__ATOMIC_ACQUIRE, "agent");
            xb_add(&bar[XB_XGEN(b.x)], 1u);
            asm volatile("s_waitcnt vmcnt(0)" ::: "memory");
        } else {
            XB_SPIN(xb_ld(&bar[XB_XGEN(b.x)]) == gen, bar);
            __builtin_amdgcn_fence(__ATOMIC_ACQUIRE, "agent");
            asm volatile("s_waitcnt vmcnt(0)" ::: "memory");
        }
    }
    __syncthreads();
}

namespace pg8 {
constexpr int BM = 256, BK = 64, HALF = 128, HTB = HALF * BK * 2, STAGE_BYTES = 8 * HTB, NXCD = 8, WGM = 8;
__host__ __device__ __forceinline__ int lds_byte(int r, int c) { const int st = (r >> 4) * 2 + (c >> 5), rr = r & 15, cc = c & 31, ob = rr * 64 + cc * 2; return st * 1024 + (ob ^ (((ob >> 9) & 1) << 5)); }
__host__ __device__ __forceinline__ void stage_rc(int b, int& R, int& C) { const int st = b / 1024, sb = b % 1024, swz = sb ^ (((sb >> 9) & 1) << 5); R = (st >> 1) * 16 + swz / 64; C = (st & 1) * 32 + (swz % 64) / 2; }
__host__ __device__ __forceinline__ int perm32(int rho) { const int n = rho >> 4, i = rho & 15; return 8 * (i >> 2) + 4 * n + (i & 3); }

struct Unit { int pm, pn, pb, hm; };
struct Gemm { const bf16_t* A; const bf16_t* Bt; };

struct StaticOrder {
    int nM, nN, nwg, G, c;
    __device__ void init(int M, int N, int G_, int c_) { nM = M / BM; nN = N / BM; nwg = nM * nN; G = G_; c = c_; }
    __device__ void map(int wgid, int& pm, int& pn) const {
        { const int q = nwg / NXCD, r = nwg % NXCD, xcd = wgid % NXCD, off = wgid / NXCD; wgid = (xcd < r ? xcd * (q + 1) : r * (q + 1) + (xcd - r) * q) + off; }
        const int nig = WGM * nN, gid = wgid / nig, fm = gid * WGM, gsz = (nM - fm) < WGM ? (nM - fm) : WGM;
        pm = fm + ((wgid % nig) % gsz); pn = (wgid % nig) / gsz;
    }
    __device__ bool next(int i, Unit& u) const {
        const long L = (long)i * G + c; if (L >= nwg) return false;
        int pm, pn; map((int)L, pm, pn); u.pm = pm; u.pn = pn; u.pb = 0; u.hm = -1; return true;
    }
};
struct SplitOrder {
    StaticOrder lat; int nN, nLat, nH, G, c;
    __device__ void init(int M, int N, int G_, int c_) { lat.init(NLAT, N, G_, c_); nN = N / BM; nLat = lat.nwg; nH = M > NLAT ? ((M - NLAT) / HALF) * nN : 0; G = G_; c = c_; }
    __device__ bool next(int i, Unit& u) const {
        const long L = (long)i * G + c; if (L >= (long)nLat + nH) return false;
        const bool isl = L < nLat;
        int pmL, pnL; lat.map(isl ? (int)L : 0, pmL, pnL);
        const int h = isl ? 0 : (int)(L - nLat);
        const int per = 2 * nN, hu = (nH % NXCD == 0) ? (h % NXCD) * (nH / NXCD) + h / NXCD : h, t = hu / per, j = hu - t * per;
        u.pm = isl ? pmL : NLAT / BM + t; u.pn = isl ? pnL : (j >> 1); u.pb = 0; u.hm = isl ? -1 : (j & 1); return true;
    }
};
struct BatchOrder {
    int nM, nN, nb, G, c, tailM;
    __device__ void init(int nM_, int nN_, int nb_, int G_, int c_, int tailM_ = -1) { nM = nM_; nN = nN_; nb = nb_; G = G_; c = c_; tailM = tailM_; }
    __device__ bool next(int i, Unit& u) const {
        const long L = (long)i * G + c; if (L >= (long)nM * nN * nb) return false;
        const int nMf = tailM >= 0 ? nM - 1 : nM, per = nMf * nN, nfull = per * nb, l = (int)L; const bool full = l < nfull;
        const int lf = full ? l : 0, pbF = lf / per, rF = lf - pbF * per, pnF = rF / nMf, pmF = rF - pnF * nMf;
        const int rT = full ? 0 : l - nfull, pbT = rT / nN, pnT = rT - pbT * nN;
        u.pb = full ? pbF : pbT; u.pn = full ? pnF : pnT; u.pm = full ? pmF : tailM; u.hm = full ? -1 : 0; return true;
    }
};

template <int K, int LDA, int LDB, size_t SA, size_t SB, bool F8 = false, class Epi, class Sched>
__device__ __forceinline__ void gemm_phase(LAS unsigned char* lds, const Gemm g, const Sched& S, const Epi& E, const int tid) {
    static_assert(Epi::PERM, "all epilogues here use the permuted column map");
    const int wid = __builtin_amdgcn_readfirstlane(tid >> 6), lane = tid & 63, wr = wid >> 2, wc = wid & 3, fr = lane & 15, fq = lane >> 4;
    constexpr int nt = K / BK;
    unsigned voffA[2], voffB[2];
#pragma unroll
    for (int i = 0; i < 2; ++i) { int R, C; stage_rc(tid * 16 + i * 8192, R, C); const int Rb = (R & ~31) + perm32(R & 31);
        voffA[i] = (unsigned)(R * LDA + C) * 2u; voffB[i] = (unsigned)(Rb * LDB + C) * 2u; }
    constexpr size_t kstep = (size_t)(BK * 2);
    constexpr size_t hstepA = (size_t)HALF * LDA * 2, hstepB = (size_t)HALF * LDB * 2;
    constexpr size_t tstepA = 2 * hstepA, tstepB = 2 * hstepB;
    const unsigned ldsw = (unsigned)wid * 1024u;
    const int aoff = lds_byte(wr * 64 + fr, fq * 8), boff = lds_byte(wc * 32 + fr, fq * 8);
#define PG8_SA(b, h) (((b) * 2 + (h)) * HTB)
#define PG8_SB(b, h) ((4 + (b) * 2 + (h)) * HTB)
#define PG8_STAGE(bufoff, gbase, voff) do { _Pragma("unroll") for (int _i = 0; _i < 2; ++_i) \
        __builtin_amdgcn_global_load_lds((const unsigned*)((const char*)(gbase) + (voff)[_i]), (LAS unsigned*)(lds + (bufoff) + ldsw + _i * 8192), 16, 0, 0); } while (0)
#define PG8_LDA8(dst, b, h) do { _Pragma("unroll") for (int m = 0; m < 4; ++m) dst[m] = __builtin_shufflevector(*(const LAS v4i_*)(lds + PG8_SA(b, h) + aoff + m * 2048), *(const LAS v4i_*)(lds + PG8_SA(b, h) + aoff + m * 2048 + 1024), 0, 1, 2, 3, 4, 5, 6, 7); } while (0)
#define PG8_LDB8(dst, b, h) do { _Pragma("unroll") for (int n = 0; n < 2; ++n) dst[n] = __builtin_shufflevector(*(const LAS v4i_*)(lds + PG8_SB(b, h) + boff + n * 2048), *(const LAS v4i_*)(lds + PG8_SB(b, h) + boff + n * 2048 + 1024), 0, 1, 2, 3, 4, 5, 6, 7); } while (0)
#define PG8_LDA(dst, b, h) do { _Pragma("unroll") for (int m = 0; m < 4; ++m) _Pragma("unroll") for (int k = 0; k < 2; ++k) dst[m][k] = *(const LAS bf16x8*)(lds + PG8_SA(b, h) + aoff + m * 2048 + k * 1024); } while (0)
#define PG8_LDB(dst, b, h) do { _Pragma("unroll") for (int n = 0; n < 2; ++n) _Pragma("unroll") for (int k = 0; k < 2; ++k) dst[n][k] = *(const LAS bf16x8*)(lds + PG8_SB(b, h) + boff + n * 2048 + k * 1024); } while (0)
#define PG8_MMA(ai, bj, At, Bt) do { __builtin_amdgcn_s_setprio(1); _Pragma("unroll") for (int m = 0; m < 4; ++m) _Pragma("unroll") for (int n = 0; n < 2; ++n) { \
        if (F8) { asm volatile("v_mfma_scale_f32_16x16x128_f8f6f4 %0, %1, %2, %0, %3, %3 op_sel_hi:[0,0,0]" : "+v"(acc[ai][bj][m][n]) : "v"(Bt##8[n]), "v"(At##8[m]), "v"(sc1_)); } \
        else { _Pragma("unroll") for (int k = 0; k < 2; ++k) acc[ai][bj][m][n] = __builtin_amdgcn_mfma_f32_16x16x32_bf16(Bt[n][k], At[m][k], acc[ai][bj][m][n], 0, 0, 0); } } \
        __builtin_amdgcn_s_setprio(0); } while (0)
#define PG8_WAIT_V(n) asm volatile("s_waitcnt vmcnt(" #n ")" ::: "memory")
#define PG8_WAIT_L(n) asm volatile("s_waitcnt lgkmcnt(" #n ")" ::: "memory")
#define PG8_BAR __builtin_amdgcn_s_barrier()
#define PG8_SCHED __builtin_amdgcn_sched_barrier(0)
    Unit cur, nxt; int ui = 0;
    if (!S.next(0, cur)) return;
    f32x4 acc[2][2][4][2];
#pragma unroll
    for (int a = 0; a < 2; ++a)
#pragma unroll
        for (int b = 0; b < 2; ++b)
#pragma unroll
            for (int m = 0; m < 4; ++m)
#pragma unroll
                for (int n = 0; n < 2; ++n) acc[a][b][m][n] = (f32x4){0.f, 0.f, 0.f, 0.f};
    typedef int v8i_ __attribute__((ext_vector_type(8))); typedef int v4i_ __attribute__((ext_vector_type(4)));
    bf16x8 At[4][2], B0[2][2], B1[2][2]; v8i_ At8[4], B08[2], B18[2];
    const unsigned sc1_ = 0x7F7F7F7Fu;
    const char* cA = (const char*)g.A + (size_t)cur.pb * SA + (size_t)cur.pm * tstepA + (cur.hm > 0 ? hstepA : (size_t)0); const char* cB = (const char*)g.Bt + (size_t)cur.pb * SB + (size_t)cur.pn * tstepB;
    unsigned cH = cur.hm < 0 ? (unsigned)hstepA : 0u;
    PG8_STAGE(PG8_SB(0, 0), cB, voffB); PG8_STAGE(PG8_SB(0, 1), cB + hstepB, voffB); PG8_STAGE(PG8_SA(0, 0), cA, voffA); PG8_STAGE(PG8_SA(0, 1), cA + cH, voffA);
    if (wr == 1) PG8_BAR;
    PG8_WAIT_V(2); PG8_BAR;
    PG8_STAGE(PG8_SB(1, 0), cB + kstep, voffB); PG8_STAGE(PG8_SA(1, 0), cA + kstep, voffA); PG8_STAGE(PG8_SB(1, 1), cB + hstepB + kstep, voffB);
    PG8_WAIT_V(6); PG8_BAR;
    for (;;) {
        const bool has_next = S.next(ui + 1, nxt);
        const char* nA = has_next ? (const char*)g.A + (size_t)nxt.pb * SA + (size_t)nxt.pm * tstepA + (nxt.hm > 0 ? hstepA : (size_t)0) : cA; const char* nB = has_next ? (const char*)g.Bt + (size_t)nxt.pb * SB + (size_t)nxt.pn * tstepB : cB;
        const unsigned nH = has_next ? (nxt.hm < 0 ? (unsigned)hstepA : 0u) : cH;
        const bool whole = cur.hm < 0;
#pragma unroll 1
        for (int t = 0; t < nt; t += 2) {
            const bool last = (t == nt - 2);
            const char* a1 = cA + (size_t)(t + 1) * kstep;
            const char* a2 = last ? nA : cA + (size_t)(t + 2) * kstep; const char* b2 = last ? nB : cB + (size_t)(t + 2) * kstep; const unsigned h2 = last ? nH : cH;
            const char* a3 = a2 + kstep; const char* b3 = b2 + kstep;
            if (F8) { PG8_LDB8(B08, 0, 0); PG8_LDB8(B18, 0, 1); } else { PG8_LDB(B0, 0, 0); PG8_LDB(B1, 0, 1); } PG8_SCHED; if (F8) PG8_LDA8(At8, 0, 0); else PG8_LDA(At, 0, 0); PG8_STAGE(PG8_SA(1, 1), a1 + cH, voffA);
            PG8_WAIT_V(8); PG8_WAIT_L(0); PG8_BAR; PG8_MMA(0, 0, At, B0); PG8_MMA(0, 1, At, B1); PG8_BAR; PG8_SCHED;
            if (F8) PG8_LDA8(At8, 0, 1); else PG8_LDA(At, 0, 1); PG8_STAGE(PG8_SB(0, 0), b2, voffB); PG8_STAGE(PG8_SB(0, 1), b2 + hstepB, voffB); PG8_STAGE(PG8_SA(0, 0), a2, voffA);
            PG8_WAIT_V(8); PG8_WAIT_L(0); PG8_BAR; if (whole) { PG8_MMA(1, 0, At, B0); PG8_MMA(1, 1, At, B1); } PG8_BAR; PG8_SCHED;
            if (F8) { PG8_LDB8(B08, 1, 0); PG8_LDB8(B18, 1, 1); } else { PG8_LDB(B0, 1, 0); PG8_LDB(B1, 1, 1); } PG8_SCHED; if (F8) PG8_LDA8(At8, 1, 0); else PG8_LDA(At, 1, 0); PG8_STAGE(PG8_SA(0, 1), a2 + h2, voffA);
            PG8_WAIT_V(8); PG8_WAIT_L(0); PG8_BAR; PG8_MMA(0, 0, At, B0); PG8_MMA(0, 1, At, B1); PG8_BAR; PG8_SCHED;
            if (F8) PG8_LDA8(At8, 1, 1); else PG8_LDA(At, 1, 1); PG8_STAGE(PG8_SB(1, 0), b3, voffB); PG8_STAGE(PG8_SB(1, 1), b3 + hstepB, voffB); PG8_STAGE(PG8_SA(1, 0), a3, voffA);
            PG8_WAIT_V(8); PG8_WAIT_L(0); PG8_BAR; if (whole) { PG8_MMA(1, 0, At, B0); PG8_MMA(1, 1, At, B1); } PG8_BAR; PG8_SCHED;
        }
        if (wr == 0) PG8_BAR;
        E(acc, cur, wr, wc, fr, fq);
        if (!has_next) break;
#pragma unroll
        for (int a = 0; a < 2; ++a)
#pragma unroll
            for (int b = 0; b < 2; ++b)
#pragma unroll
                for (int m = 0; m < 4; ++m)
#pragma unroll
                    for (int n = 0; n < 2; ++n) acc[a][b][m][n] = (f32x4){0.f, 0.f, 0.f, 0.f};
        cur = nxt; cA = nA; cB = nB; cH = nH; ++ui;
        if (wr == 1) PG8_BAR;
    }
    PG8_WAIT_V(0);
    PG8_BAR;
#undef PG8_SA
#undef PG8_SB
#undef PG8_STAGE
#undef PG8_LDA
#undef PG8_LDA8
#undef PG8_LDB8
#undef PG8_LDB
#undef PG8_MMA
#undef PG8_WAIT_V
#undef PG8_WAIT_L
#undef PG8_BAR
#undef PG8_SCHED
}

#define EPI_ON (uhm_ < 0 || ai == uhm_)
#define EPI_ACC(k_) ((ai == 1 && uhm_ >= 0) ? acc[0][bj][m][k_] : acc[ai][bj][m][k_])
#define EPI_FOR _Pragma("unroll") for (int ai = 0; ai < 2; ++ai) if (EPI_ON) _Pragma("unroll") for (int m = 0; m < 4; ++m) _Pragma("unroll") for (int bj = 0; bj < 2; ++bj)
#define EPI_COORDS const int ln_ = lane_id_now(), wr = wr_, wc = wc_, fr = ln_ & 15, fq = ln_ >> 4, uhm_ = u.hm;
#define EPI_V const f32x4 v0 = EPI_ACC(0), v1 = EPI_ACC(1);

struct EpiIn {
    static constexpr bool PERM = true;
    unsigned char* ws; float osc;
    __device__ __forceinline__ void operator()(const f32x4 (&acc)[2][2][4][2], const Unit& u, int wr_, int wc_, int fr_, int fq_) const {
        EPI_COORDS
        const int pn = u.pn, r0 = u.pm * BM, rl = wr * 64 + fr, cl0 = wc * 32 + 8 * fq;
        size_t boff; long sA, sM1, sM0, sB;
        if (pn == 4 || pn == 5) {
            int kv0; if (r0 < NLAT) kv0 = (r0 >> 12) * KVLEN + (r0 & 4095); else kv0 = ((r0 - NLAT) >> 8) * KVLEN + SEQ;
            boff = WS_KB + (size_t)(pn - 4) * (WS_VB - WS_KB) + ((size_t)(kv0 + rl) * KVW + cl0); sA = 128 * KVW; sM1 = 32 * KVW; sM0 = 16 * KVW; sB = 128;
            unsigned char* base8 = ws + boff;
            EPI_FOR { EPI_V *(u32x2*)(base8 + ai * sA + (m >> 1) * sM1 + (m & 1) * sM0 + bj * sB) = pack8_fp8(v0 * osc, v1 * osc); }
            return;
        } else if (pn == 6 || pn == 7) {
            int col0; if (r0 < NLAT) col0 = ((r0 & 4095) >> 5) * 8 + (r0 >> 12); else col0 = NCHL * 8 + ((r0 - NLAT) >> 8);
            boff = WS_UCAT + ((size_t)(((pn - 6) * 16 + wc * 2 + (fq >> 1)) * NCOLP + col0 + wr * 16) * KCAT + fr * SP + (fq & 1) * 8);
            sA = (long)32 * KCAT; sM1 = (long)8 * KCAT; sM0 = 16 * SP; sB = (long)8 * NCOLP * KCAT;
            unsigned char* base8 = ws + boff;
            EPI_FOR { EPI_V *(u32x2*)(base8 + ai * sA + (m >> 1) * sM1 + (m & 1) * sM0 + bj * sB) = pack8_fp8(v0 * osc, v1 * osc); }
            return;
        } else {
            const int grp = pn < 4 ? 0 : (pn < 12 ? 1 : 2), pc = pn - (grp == 0 ? 0 : (grp == 1 ? 8 : 12));
            const size_t tb = WS_Q + (size_t)grp * (WS_GA - WS_Q) - (grp == 2 ? (size_t)((WS_GA - WS_Q) - (WS_GB - WS_GA)) : 0);
            boff = tb + ((size_t)(r0 + rl) * DM + pc * 256 + cl0); sA = 128 * DM; sM1 = 32 * DM; sM0 = 16 * DM; sB = 128;
            unsigned char* base8 = ws + boff;
            EPI_FOR { EPI_V *(u32x2*)(base8 + ai * sA + (m >> 1) * sM1 + (m & 1) * sM0 + bj * sB) = pack8_fp8(v0 * osc, v1 * osc); }
            return;
        }
        bf16_t* base = (bf16_t*)(ws + boff);
        EPI_FOR { EPI_V *(u32x4*)(base + ai * sA + (m >> 1) * sM1 + (m & 1) * sM0 + bj * sB) = pack8(v0 * osc, v1 * osc); }
    }
};
struct EpiBf16 {
    static constexpr bool PERM = true;
    bf16_t* O; int ldc;
    __device__ __forceinline__ void operator()(const f32x4 (&acc)[2][2][4][2], const Unit& u, int wr_, int wc_, int fr_, int fq_) const {
        EPI_COORDS
        bf16_t* base = O + (size_t)(u.pm * BM + wr * 64 + fr) * ldc + u.pn * BM + wc * 32 + 8 * fq; const long sR = (long)16 * ldc;
        EPI_FOR { EPI_V *(u32x4*)(base + (ai * 8 + m) * sR + bj * 128) = pack8(v0, v1); }
    }
};
struct EpiSX {
    static constexpr bool PERM = true;
    float* SX;
    __device__ __forceinline__ void operator()(const f32x4 (&acc)[2][2][4][2], const Unit& u, int wr_, int wc_, int fr_, int fq_) const {
        EPI_COORDS
        bf16_t* base = (bf16_t*)SX + ((size_t)(u.pb * NCOLP + u.pm * BM + wr * 64 + fr) * 256 + wc * 32 + 8 * fq);
        const bool tail = (u.pm == 4);
        EPI_FOR { EPI_V if (!tail || (ai == 0 && wr == 0)) { *(u32x4*)(base + (ai * 8 + m) * (16 * 256) + bj * 128) = pack8(v0 * (1.0f / TSC8), v1 * (1.0f / TSC8)); } }
    }
};
#define EPI_GROUPS _Pragma("unroll") for (int ai = 0; ai < 2; ++ai) if (EPI_ON) _Pragma("unroll") for (int mh = 0; mh < 2; ++mh)
#define EPI_IN_GROUP _Pragma("unroll") for (int e_ = 0; e_ < 4; ++e_)
#define EPI_GIDX const int m = 2 * mh + (e_ >> 1), bj = e_ & 1; (void)m; (void)bj;
struct EpiS3 {
    static constexpr bool PERM = true;
    const bf16_t* UCAT; const float* dsk; bf16_t* YG;
    __device__ __forceinline__ void operator()(const f32x4 (&acc)[2][2][4][2], const Unit& u, int wr_, int wc_, int fr_, int fq_) const {
        EPI_COORDS
        const int gg = u.pb, b = fr & 7, p0 = (fq & 1) * 8, tl = u.pn * 16 + wc * 2 + (fq >> 1);
        const bool tail = (u.pm == 4);
        const int tok0 = tail ? NLAT + b * CTXL + (fr >> 3) * ST + tl : b * SEQ + (u.pm * 32 + wr * 8 + (fr >> 3)) * ST + tl;
        const unsigned char* ub = (const unsigned char*)UCAT + ((size_t)(gg * NCOLP + u.pm * BM + wr * 64 + fr) * KCAT + tl * SP + p0);
        unsigned char* yb = (unsigned char*)YG + (size_t)tok0 * SSMW + gg * SP + p0;
        const f32x4 d0 = *(const f32x4*)(dsk + gg * SP + p0), d1 = *(const f32x4*)(dsk + gg * SP + p0 + 4);
        EPI_GROUPS { if (!tail || (ai == 0 && wr == 0)) {
            u32x2 uw[4];
            EPI_IN_GROUP { EPI_GIDX uw[e_] = *(const u32x2*)(ub + (size_t)(ai * 128 + m * 16) * KCAT + bj * 8 * SP); }
            EPI_IN_GROUP { EPI_GIDX const f32x4 v0 = EPI_ACC(0), v1 = EPI_ACC(1);
                f32x4 u0, u1; unpack8_fp8(uw[e_], u0, u1);
                f32x4 y0 = v0 * (1.0f / TSC8) + d0 * u0, y1 = v1 * (1.0f / TSC8) + d1 * u1;
#pragma unroll
                for (int i = 0; i < 4; ++i) { y0[i] = gelu_tanh(y0[i]); y1[i] = gelu_tanh(y1[i]); }
                *(u32x2*)(yb + (size_t)((ai * 16 + m * 2) * ST + bj * 8) * SSMW) = pack8_fp8(y0, y1); } } }
    }
};
struct EpiGlu {
    static constexpr bool PERM = true;
    const bf16_t* YG; const float* bias; bf16_t* O;
    __device__ __forceinline__ void operator()(const f32x4 (&acc)[2][2][4][2], const Unit& u, int wr_, int wc_, int fr_, int fq_) const {
        EPI_COORDS
        const int c0 = u.pn * BM + wc * 32 + 8 * fq; const size_t off = (size_t)(u.pm * BM + wr * 64 + fr) * SSMW + c0;
        f32x4 bb[2][2];
#pragma unroll
        for (int bj = 0; bj < 2; ++bj) { bb[bj][0] = *(const f32x4*)(bias + c0 + bj * 128); bb[bj][1] = *(const f32x4*)(bias + c0 + bj * 128 + 4); }
        EPI_GROUPS {
            u32x2 yw[4];
            EPI_IN_GROUP { EPI_GIDX yw[e_] = *(const u32x2*)((const unsigned char*)YG + off + (size_t)(ai * 128 + m * 16) * SSMW + bj * 128); }
            EPI_IN_GROUP { EPI_GIDX const f32x4 v0 = EPI_ACC(0), v1 = EPI_ACC(1);
                f32x4 y0, y1; unpack8_fp8(yw[e_], y0, y1);
                f32x4 o0, o1;
#pragma unroll
                for (int i = 0; i < 4; ++i) { o0[i] = y0[i] * sigmoidf_(v0[i] * (1.0f / WSCALE8) + bb[bj][0][i]); o1[i] = y1[i] * sigmoidf_(v1[i] * (1.0f / WSCALE8) + bb[bj][1][i]); }
                *(u32x2*)((unsigned char*)O + off + (size_t)(ai * 128 + m * 16) * SSMW + bj * 128) = pack8_fp8(o0, o1); } }
    }
};
template <bool ADD> struct EpiMerge {
    static constexpr bool PERM = true;
    const bf16_t* G; bf16_t* Y; unsigned char* Y8; float osc;
    __device__ __forceinline__ void operator()(const f32x4 (&acc)[2][2][4][2], const Unit& u, int wr_, int wc_, int fr_, int fq_) const {
        EPI_COORDS
        const size_t off = (size_t)(u.pm * BM + wr * 64 + fr) * DM + u.pn * BM + wc * 32 + 8 * fq;
        EPI_GROUPS {
            u32x2 gw[4], yw[4];
            EPI_IN_GROUP { EPI_GIDX const size_t o = off + (size_t)(ai * 128 + m * 16) * DM + bj * 128; gw[e_] = *(const u32x2*)((const unsigned char*)G + o); if (ADD) yw[e_] = *(const u32x2*)(Y8 + o); }
            EPI_IN_GROUP { EPI_GIDX const size_t o = off + (size_t)(ai * 128 + m * 16) * DM + bj * 128; const f32x4 v0 = EPI_ACC(0), v1 = EPI_ACC(1);
                f32x4 g0, g1; unpack8_fp8(gw[e_], g0, g1);
                f32x4 o0, o1;
#pragma unroll
                for (int i = 0; i < 4; ++i) { o0[i] = sigmoidf_(g0[i]) * (v0[i] * osc); o1[i] = sigmoidf_(g1[i]) * (v1[i] * osc); }
                if (ADD) { f32x4 y0, y1; unpack8_fp8(yw[e_], y0, y1); o0 += y0; o1 += y1; }
                *(u32x2*)(Y8 + o) = pack8_fp8(o0, o1); } }
    }
};
struct EpiWo {
    static constexpr bool PERM = true;
    const float* xsrc; bf16_t* HB; const float* gate;
    __device__ __forceinline__ void operator()(const f32x4 (&acc)[2][2][4][2], const Unit& u, int wr_, int wc_, int fr_, int fq_) const {
        EPI_COORDS
        const int r0 = u.pm * BM, c0 = u.pn * BM + wc * 32 + 8 * fq;
        const size_t roff = (size_t)r0 * DM + (size_t)(wr * 64 + fr) * DM + c0;
        const bool fx = xsrc != nullptr && r0 < NLAT;
        const float* sb = xsrc + roff; bf16_t* hb = HB + roff;
        const float* gr = gate + (size_t)(r0 < NLAT ? (r0 >> 12) : NB) * MODW + c0;
        f32x4 gg[2][2];
#pragma unroll
        for (int bj = 0; bj < 2; ++bj) { gg[bj][0] = *(const f32x4*)(gr + bj * 128) * (1.0f / WSCALE8); gg[bj][1] = *(const f32x4*)(gr + bj * 128 + 4) * (1.0f / WSCALE8); }
        EPI_GROUPS {
            f32x4 h0[4], h1[4];
            if (fx) { EPI_IN_GROUP { EPI_GIDX const size_t o = (size_t)(ai * 128 + m * 16) * DM + bj * 128; h0[e_] = *(const f32x4*)(sb + o); h1[e_] = *(const f32x4*)(sb + o + 4); } }
            else { u32x4 hw[4];
                EPI_IN_GROUP { EPI_GIDX const size_t o = (size_t)(ai * 128 + m * 16) * DM + bj * 128; hw[e_] = *(const u32x4*)(hb + o); }
                EPI_IN_GROUP { unpack8(hw[e_], h0[e_], h1[e_]); } }
            EPI_IN_GROUP { EPI_GIDX const size_t o = (size_t)(ai * 128 + m * 16) * DM + bj * 128; const f32x4 v0 = EPI_ACC(0), v1 = EPI_ACC(1);
                *(u32x4*)(hb + o) = pack8(h0[e_] + gg[bj][0] * v0, h1[e_] + gg[bj][1] * v1); } }
    }
};
#undef EPI_GROUPS
#undef EPI_IN_GROUP
#undef EPI_GIDX
}

namespace att {
constexpr int D = 128, NW = 8, QBLK = 32, KVBLK = 64;
constexpr float SCALE = 0.088388347648318440f;
constexpr float THR = 8.f;
#ifndef ATT_SDEPTH
#define ATT_SDEPTH 1
#endif
constexpr int SDEPTH = ATT_SDEPTH;
constexpr int LDQ = DM, LDK = KVW, LDO = DM;
constexpr size_t SHM_V = KVBLK * D * 2, SHM_K = KVBLK * D * 2, SHM_ATTN = 2 * SHM_V + 2 * SHM_K + NW * 64 * 4;
#define KSWZ(row, colB) ((row) * 256 + ((colB) ^ (((row) & 7) << 4)))
#define SBAR() __builtin_amdgcn_sched_barrier(0)
__device__ __forceinline__ int crow(int r, int hi) { return (r & 3) + 8 * (r >> 2) + 4 * hi; }
__device__ __forceinline__ unsigned cvtpk(float lo, float hi) { unsigned r; asm volatile("v_cvt_pk_bf16_f32 %0, %1, %2" : "=v"(r) : "v"(lo), "v"(hi)); return r; }
__device__ __forceinline__ void partialSM(f32x16& p0) {
  for (int r = 0; r < 16; ++r) p0[r] = __builtin_amdgcn_exp2f(p0[r]);
}
__device__ __forceinline__ void finishSM(f32x16& p0, f32x16& p1, float& l_reg, bf16x8& pa0, bf16x8& pa1, bf16x8& pa2, bf16x8& pa3) {
  for (int r = 0; r < 16; ++r) p1[r] = __builtin_amdgcn_exp2f(p1[r]);
  float ps = 0; for (int r = 0; r < 16; ++r) ps += p0[r]; for (int r = 0; r < 16; ++r) ps += p1[r];
  l_reg += ps;
#define PK4(P, BASE, OUT) do { unsigned a0 = cvtpk(P[BASE + 0], P[BASE + 1]), a1 = cvtpk(P[BASE + 2], P[BASE + 3]);   \
    unsigned b0 = cvtpk(P[BASE + 4], P[BASE + 5]), b1 = cvtpk(P[BASE + 6], P[BASE + 7]);                              \
    auto r0 = __builtin_amdgcn_permlane32_swap(a0, b0, false, false); auto r1 = __builtin_amdgcn_permlane32_swap(a1, b1, false, false); \
    u32x4 w = {r0[0], r1[0], r0[1], r1[1]}; OUT = *reinterpret_cast<bf16x8*>(&w); } while (0)
  PK4(p0, 0, pa0); PK4(p0, 8, pa1); PK4(p1, 0, pa2); PK4(p1, 8, pa3);
#undef PK4
}
__device__ __forceinline__ void qkt(f32x16& p0, f32x16& p1, const bf16_t* Ks, const bf16x8* qr, int r32, int hi, float nm0) {
#pragma unroll
  for (int r = 0; r < 16; ++r) { p0[r] = nm0; p1[r] = nm0; }
  const char* kb0 = (const char*)Ks + r32 * 256; const char* kb1 = kb0 + 32 * 256; const int swz = (r32 & 7) << 4;
#define KFRAG(base, d0) (*reinterpret_cast<const bf16x8*>((base) + ((((d0) * 32) + hi * 16) ^ swz)))
  bf16x8 fa0 = KFRAG(kb0, 0), fa1 = KFRAG(kb1, 0), fb0 = KFRAG(kb0, 1), fb1 = KFRAG(kb1, 1);
#pragma unroll
  for (int d0 = 0; d0 < 8; d0 += 2) {
    bf16x8 na0 = fa0, na1 = fa1, nb0 = fb0, nb1 = fb1;
    if (d0 + 2 < 8) { na0 = KFRAG(kb0, d0 + 2); na1 = KFRAG(kb1, d0 + 2); }
    p0 = __builtin_amdgcn_mfma_f32_32x32x16_bf16(fa0, qr[d0], p0, 0, 0, 0);
    p1 = __builtin_amdgcn_mfma_f32_32x32x16_bf16(fa1, qr[d0], p1, 0, 0, 0);
    __builtin_amdgcn_sched_group_barrier(0x100, 2, 0); __builtin_amdgcn_sched_group_barrier(0x008, 2, 0);
    if (d0 + 3 < 8) { nb0 = KFRAG(kb0, d0 + 3); nb1 = KFRAG(kb1, d0 + 3); }
    p0 = __builtin_amdgcn_mfma_f32_32x32x16_bf16(fb0, qr[d0 + 1], p0, 0, 0, 0);
    p1 = __builtin_amdgcn_mfma_f32_32x32x16_bf16(fb1, qr[d0 + 1], p1, 0, 0, 0);
    __builtin_amdgcn_sched_group_barrier(0x100, 2, 0); __builtin_amdgcn_sched_group_barrier(0x008, 2, 0);
    fa0 = na0; fa1 = na1; fb0 = nb0; fb1 = nb1;
  }
#undef KFRAG
}
typedef int v8i __attribute__((ext_vector_type(8)));
__device__ __forceinline__ void finishSM8(f32x16& p0, f32x16& p1, float& l_reg, v8i& pa) {
  for (int r = 0; r < 16; ++r) p1[r] = __builtin_amdgcn_exp2f(p1[r]);
  float ps = 0; for (int r = 0; r < 16; ++r) ps += p0[r]; for (int r = 0; r < 16; ++r) ps += p1[r];
  l_reg += ps;
#pragma unroll
  for (int j = 0; j < 4; ++j) { int v = 0, w = 0;
    v = __builtin_amdgcn_cvt_pk_bf8_f32(p0[4 * j], p0[4 * j + 1], v, false); v = __builtin_amdgcn_cvt_pk_bf8_f32(p0[4 * j + 2], p0[4 * j + 3], v, true);
    w = __builtin_amdgcn_cvt_pk_bf8_f32(p1[4 * j], p1[4 * j + 1], w, false); w = __builtin_amdgcn_cvt_pk_bf8_f32(p1[4 * j + 2], p1[4 * j + 3], w, true);
    pa[j] = v; pa[4 + j] = w; }
}
__device__ __forceinline__ void pv8(f32x16* o, const char* Vs, const v8i pa, int r32, int hi) {
  const int sw = (r32 >> 2) & 3;
#pragma unroll
  for (int db = 0; db < 4; ++db) { const char* row = Vs + (db * 32 + r32) * 64;
    const u32x4 lo = *reinterpret_cast<const u32x4*>(row + (((hi * 2) ^ sw) << 4)), hh = *reinterpret_cast<const u32x4*>(row + (((hi * 2 + 1) ^ sw) << 4));
    const v8i vb = {(int)lo.x, (int)lo.y, (int)lo.z, (int)lo.w, (int)hh.x, (int)hh.y, (int)hh.z, (int)hh.w};
    o[db] = __builtin_amdgcn_mfma_scale_f32_32x32x64_f8f6f4(pa, vb, o[db], 1  , 0  , 0, 0x7F7F7F7F, 0, 0x7F7F7F7F); }
}
__device__ __forceinline__ void qkt8(f32x16& p0, f32x16& p1, const char* Ks, const v8i* q8, int r32, int hi, const float NM  ) {
#pragma unroll
  for (int r = 0; r < 16; ++r) { p0[r] = NM; p1[r] = NM; }
  const int sw = (r32 >> 1) & 7;
  const char* k0 = Ks + r32 * 128; const char* k1 = k0 + 32 * 128;
#define K8FRAG(base, ks) ({ const u32x4 lo_ = *reinterpret_cast<const u32x4*>((base) + ((((ks) * 4 + hi * 2) ^ sw) << 4)), hi_ = *reinterpret_cast<const u32x4*>((base) + ((((ks) * 4 + hi * 2 + 1) ^ sw) << 4)); \
    (v8i){(int)lo_.x, (int)lo_.y, (int)lo_.z, (int)lo_.w, (int)hi_.x, (int)hi_.y, (int)hi_.z, (int)hi_.w}; })
  const v8i a00 = K8FRAG(k0, 0), a10 = K8FRAG(k1, 0), a01 = K8FRAG(k0, 1), a11 = K8FRAG(k1, 1);
  p0 = __builtin_amdgcn_mfma_scale_f32_32x32x64_f8f6f4(a00, q8[0], p0, 0, 0, 0, 0x7F7F7F7F, 0, 0x7F7F7F7F);
  p1 = __builtin_amdgcn_mfma_scale_f32_32x32x64_f8f6f4(a10, q8[0], p1, 0, 0, 0, 0x7F7F7F7F, 0, 0x7F7F7F7F);
  p0 = __builtin_amdgcn_mfma_scale_f32_32x32x64_f8f6f4(a01, q8[1], p0, 0, 0, 0, 0x7F7F7F7F, 0, 0x7F7F7F7F);
  p1 = __builtin_amdgcn_mfma_scale_f32_32x32x64_f8f6f4(a11, q8[1], p1, 0, 0, 0, 0x7F7F7F7F, 0, 0x7F7F7F7F);
#undef K8FRAG
}
__device__ __forceinline__ int v_st(int k, int c) { const int kk = (k & ~0xC) | ((k & 4) << 1) | ((k & 8) >> 1); return ((kk >> 3) * 4 + (c >> 5)) * 512 + ((kk & 7) * 32 + (c & 31)) * 2; }
__device__ __forceinline__ int v_rd_base(int lane) { return ((lane & 3) << 3) | (((lane >> 2) & 3) << 6) | (((lane >> 4) & 1) << 5) | (((lane >> 5) & 1) << 8); }
constexpr int v_rd_off(int d0, int ks, int half) { return d0 * 512 + ks * 4096 + half * 2048; }
template <int OFF> __device__ __forceinline__ s16x4 tr_read(int vb) {
  s16x4 r; asm volatile("ds_read_b64_tr_b16 %0, %1 offset:%2" : "=&v"(r) : "v"(vb), "i"(OFF) : "memory"); return r;
}
template <int D0> __device__ __forceinline__ void pv_one(f32x16& od, int vb, bf16x8 pa0, bf16x8 pa1, bf16x8 pa2, bf16x8 pa3) {
  const s16x4 l0 = tr_read<v_rd_off(D0, 0, 0)>(vb), h0 = tr_read<v_rd_off(D0, 0, 1)>(vb), l1 = tr_read<v_rd_off(D0, 1, 0)>(vb), h1 = tr_read<v_rd_off(D0, 1, 1)>(vb);
  const s16x4 l2 = tr_read<v_rd_off(D0, 2, 0)>(vb), h2 = tr_read<v_rd_off(D0, 2, 1)>(vb), l3 = tr_read<v_rd_off(D0, 3, 0)>(vb), h3 = tr_read<v_rd_off(D0, 3, 1)>(vb);
  asm volatile("s_waitcnt lgkmcnt(0)" ::: "memory"); SBAR();
#define PK(L, H) (bf16x8){L[0], L[1], L[2], L[3], H[0], H[1], H[2], H[3]}
  od = __builtin_amdgcn_mfma_f32_32x32x16_bf16(pa0, PK(l0, h0), od, 0, 0, 0);
  od = __builtin_amdgcn_mfma_f32_32x32x16_bf16(pa1, PK(l1, h1), od, 0, 0, 0);
  od = __builtin_amdgcn_mfma_f32_32x32x16_bf16(pa2, PK(l2, h2), od, 0, 0, 0);
  od = __builtin_amdgcn_mfma_f32_32x32x16_bf16(pa3, PK(l3, h3), od, 0, 0, 0);
#undef PK
}
__device__ __forceinline__ void pv_d0(f32x16* o, int vb, bf16x8 pa0, bf16x8 pa1, bf16x8 pa2, bf16x8 pa3) {
  pv_one<0>(o[0], vb, pa0, pa1, pa2, pa3); pv_one<1>(o[1], vb, pa0, pa1, pa2, pa3); pv_one<2>(o[2], vb, pa0, pa1, pa2, pa3); pv_one<3>(o[3], vb, pa0, pa1, pa2, pa3);
}
__device__ __forceinline__ void attn_dense_body(bf16_t* Qb, const bf16_t* Kh, int seq, char* lds, const int tid, const long odelta, const float nm0) {
  const bf16_t* Vh = (const bf16_t*)((const char*)Kh + (WS_VB - WS_KB)); bf16_t* Ob = (bf16_t*)((char*)Qb + odelta);
  const int wid = tid >> 6, lane = tid & 63, r32 = lane & 31, hi = lane >> 5;
  bf16_t* V_lds = (bf16_t*)lds; bf16_t* K_lds = (bf16_t*)(lds + 2 * SHM_V);
  float* ws = (float*)(lds + 2 * SHM_V + 2 * SHM_K) + wid * 64; float* li_l = ws;
  float l_reg = 0; f32x16 o[4] = {}; bf16x8 qr[8];
  const bf16_t* Qw = Qb + (long)(wid * QBLK + r32) * LDQ + hi * 8;
#pragma unroll
  for (int d0 = 0; d0 < 8; ++d0) qr[d0] = *reinterpret_cast<const bf16x8*>(Qw + d0 * 16);
  const int sr = tid >> 4, sc = (tid & 15) * 8, vst0 = v_st(sr, sc), vst1 = v_st(32 + sr, sc);
  const int vb0 = (int)(uintptr_t)V_lds + v_rd_base(lane);
  struct { bf16x8 vs0, vs1, ks0, ks1; } sr_[SDEPTH];
#define LD8(p) (*reinterpret_cast<const bf16x8*>(p))
#define SLOAD(i, k0) do { sr_[i].vs0 = LD8(&Vh[(long)((k0) + sr) * LDK + sc]); sr_[i].vs1 = LD8(&Vh[(long)((k0) + 32 + sr) * LDK + sc]); \
    sr_[i].ks0 = LD8(&Kh[(long)((k0) + sr) * LDK + sc]); sr_[i].ks1 = LD8(&Kh[(long)((k0) + 32 + sr) * LDK + sc]); } while (0)
#define SWRITE(b, i) do { *(bf16x8*)((char*)V_lds + (b) * SHM_V + vst0) = sr_[i].vs0;          \
    *(bf16x8*)((char*)V_lds + (b) * SHM_V + vst1) = sr_[i].vs1; int kc = sc * 2;               \
    *(bf16x8*)((char*)K_lds + (b) * SHM_K + KSWZ(sr, kc)) = sr_[i].ks0;                       \
    *(bf16x8*)((char*)K_lds + (b) * SHM_K + KSWZ(32 + sr, kc)) = sr_[i].ks1; } while (0)
#define SWAIT() do { if constexpr (SDEPTH == 2) asm volatile("s_waitcnt vmcnt(4)" ::: "memory"); else asm volatile("s_waitcnt vmcnt(0)" ::: "memory"); } while (0)
  f32x16 pA0, pA1, pB0, pB1; bf16x8 pa0, pa1, pa2, pa3; const int NT = seq / KVBLK;
  constexpr int SE = 0, SO = SDEPTH - 1;
  SLOAD(SE, 0); asm volatile("s_waitcnt vmcnt(0)" ::: "memory"); SWRITE(0, SE); __syncthreads();
  qkt(pA0, pA1, K_lds, qr, r32, hi, nm0); partialSM(pA0);
  SLOAD(SO, KVBLK); if constexpr (SDEPTH == 2) { if (2 < NT) SLOAD(SE, 2 * KVBLK); }
  SWAIT(); SWRITE(1, SO); __syncthreads();
  for (int j = 1; j + 1 < NT; j += 2) {
    SBAR(); qkt(pB0, pB1, (bf16_t*)((char*)K_lds + SHM_K), qr, r32, hi, nm0);
    finishSM(pA0, pA1, l_reg, pa0, pa1, pa2, pa3); SBAR();
    SLOAD(SO, (j + SDEPTH) * KVBLK); SBAR();
    pv_d0(o, vb0, pa0, pa1, pa2, pa3); partialSM(pB0);
    __syncthreads(); SWAIT(); SWRITE(0, SE);
    __syncthreads();
    SBAR(); qkt(pA0, pA1, K_lds, qr, r32, hi, nm0);
    finishSM(pB0, pB1, l_reg, pa0, pa1, pa2, pa3); SBAR();
    if (SDEPTH == 1 || j + 3 < NT) SLOAD(SE, (j + 1 + SDEPTH) * KVBLK); SBAR();
    pv_d0(o, vb0 + (int)SHM_V, pa0, pa1, pa2, pa3); partialSM(pA0);
    __syncthreads(); SWAIT(); SWRITE(1, SO);
    __syncthreads();
  }
  SBAR(); qkt(pB0, pB1, (bf16_t*)((char*)K_lds + SHM_K), qr, r32, hi, nm0);
  finishSM(pA0, pA1, l_reg, pa0, pa1, pa2, pa3); SBAR();
  pv_d0(o, vb0, pa0, pa1, pa2, pa3); partialSM(pB0);
  __syncthreads();
  finishSM(pB0, pB1, l_reg, pa0, pa1, pa2, pa3); SBAR();
  pv_d0(o, vb0 + (int)SHM_V, pa0, pa1, pa2, pa3);
  { auto rr = __builtin_amdgcn_permlane32_swap(__float_as_uint(l_reg), __float_as_uint(l_reg), false, false); l_reg = __uint_as_float(rr[0]) + __uint_as_float(rr[1]); }
  if (hi == 0) li_l[r32] = l_reg; asm volatile("s_waitcnt lgkmcnt(0)" ::: "memory");
  float rli[16];
#pragma unroll
  for (int r = 0; r < 16; ++r) rli[r] = __builtin_amdgcn_rcpf(li_l[crow(r, hi)]);
  bf16_t* Ow = Ob + (long)(wid * QBLK) * LDO;
#pragma unroll
  for (int r = 0; r < 16; ++r) { int orow = crow(r, hi);
    for (int d0 = 0; d0 < 4; ++d0) Ow[(long)orow * LDO + d0 * 32 + r32] = (bf16_t)f2bf(o[d0][r] * rli[r]); }
  __syncthreads();
#undef LD8
#undef SLOAD
#undef SWRITE
#undef SWAIT
}
constexpr int SLOT = 32768, SLOT8 = 16384;
__device__ __forceinline__ void attn_dense_body_dma(bf16_t* Qb, const bf16_t* Kh, int seq, char* lds, LAS unsigned char* ldsl, const int tid, const long odelta, const float nm0,
                                                    const float* qgain, const float* rope, const int lpos0, const unsigned char* K8h  , const unsigned char* V8h  , unsigned char* O8  ) {
  const bf16_t* Vh = (const bf16_t*)((const char*)Kh + (WS_VB - WS_KB)); bf16_t* Ob = (bf16_t*)((char*)Qb + odelta);
  const int wid = __builtin_amdgcn_readfirstlane(tid >> 6), lane = tid & 63, r32 = lane & 31, hi = lane >> 5;
  float* li_l = (float*)(lds + 3 * SLOT) + wid * 64;
  float l_reg = 0; f32x16 o[4] = {}; v8i q8[2];
  { const unsigned char* Qw = (const unsigned char*)Qb + (long)(wid * QBLK + r32) * DM + hi * 16;
    f32x4 x[2][2][4]; float ss = 0.f;
#pragma unroll
    for (int ks = 0; ks < 2; ++ks)
#pragma unroll
      for (int t = 0; t < 2; ++t) { const u32x4 w = *reinterpret_cast<const u32x4*>(Qw + ks * 64 + t * 32);
        unpack8_fp8((u32x2){w.x, w.y}, x[ks][t][0], x[ks][t][1]); unpack8_fp8((u32x2){w.z, w.w}, x[ks][t][2], x[ks][t][3]);
#pragma unroll
        for (int j = 0; j < 4; ++j)
#pragma unroll
          for (int i = 0; i < 4; ++i) ss += x[ks][t][j][i] * x[ks][t][j][i]; }
    { auto rr = __builtin_amdgcn_permlane32_swap(__float_as_uint(ss), __float_as_uint(ss), false, false); ss = __uint_as_float(rr[0]) + __uint_as_float(rr[1]); }
    const float rstd = (SCALE * 1.4426950408889634f) * __builtin_amdgcn_rsqf(ss * (1.0f / D) + EPS);
#pragma unroll
    for (int ks = 0; ks < 2; ++ks)
#pragma unroll
      for (int t = 0; t < 2; ++t)
#pragma unroll
        for (int j = 0; j < 4; ++j) x[ks][t][j] = x[ks][t][j] * rstd * *(const f32x4*)(qgain + ks * 64 + t * 32 + hi * 16 + 4 * j);
    if (lpos0 >= 0) { const int lpos = lpos0 + wid * QBLK + r32;
#pragma unroll
      for (int ks = 0; ks < 2; ++ks) { const int posi = ks == 0 ? (lpos >> 6) : (lpos & 63); const float* cp = rope + posi * 32 + hi * 16;
#pragma unroll
        for (int j = 0; j < 4; ++j) { const f32x4 cs = *(const f32x4*)(cp + 4 * j), sn = *(const f32x4*)(cp + 2048 + 4 * j); const f32x4 x1 = x[ks][0][j], x2 = x[ks][1][j];
          x[ks][0][j] = x1 * cs - x2 * sn; x[ks][1][j] = x1 * sn + x2 * cs; } } }
#pragma unroll
    for (int ks = 0; ks < 2; ++ks)
#pragma unroll
      for (int t = 0; t < 2; ++t)
#pragma unroll
        for (int j = 0; j < 4; ++j) { int v = 0; v = __builtin_amdgcn_cvt_pk_fp8_f32(x[ks][t][j][0], x[ks][t][j][1], v, false); v = __builtin_amdgcn_cvt_pk_fp8_f32(x[ks][t][j][2], x[ks][t][j][3], v, true); q8[ks][t * 4 + j] = v; } }
  unsigned ksrc;
  { const int b = wid * 1024 + lane * 16, row = b >> 7, g = ((b & 127) >> 4) ^ ((row >> 1) & 7); ksrc = (unsigned)(row * KVW + g * 16); }
  const unsigned vlin = (unsigned)(wid * 1024 + lane * 16);
#define ADMA(tile, s) do { const char* kb_ = (const char*)K8h + (size_t)(tile) * (KVBLK * KVW); const char* vb_ = (const char*)V8h + (size_t)(tile) * 8192; \
    __builtin_amdgcn_global_load_lds((const unsigned*)(kb_ + ksrc), (LAS unsigned*)(ldsl + (s) * SLOT8 + wid * 1024), 16, 0, 0); \
    __builtin_amdgcn_global_load_lds((const unsigned*)(vb_ + vlin), (LAS unsigned*)(ldsl + (s) * SLOT8 + 8192 + wid * 1024), 16, 0, 0); } while (0)
#define KSLOT(s) ((const char*)(lds + (s) * SLOT8))
#define VBASE(s) ((const char*)(lds + 8192 + (s) * SLOT8))
#define NEXT6(s) ((s) == 5 ? 0 : (s) + 1)
#define PREV6(s) ((s) == 0 ? 5 : (s) - 1)
#define WAITBAR_N(n) do { if ((n) >= 3) asm volatile("s_waitcnt vmcnt(6) lgkmcnt(0)" ::: "memory"); else if ((n) == 1) asm volatile("s_waitcnt vmcnt(2) lgkmcnt(0)" ::: "memory"); \
    else asm volatile("s_waitcnt vmcnt(0) lgkmcnt(0)" ::: "memory"); __builtin_amdgcn_s_barrier(); asm volatile("" ::: "memory"); } while (0)
  f32x16 pA0, pA1, pB0, pB1; v8i pa; const int NT = seq / KVBLK; const float NM = nm0 + 15.8f;
  ADMA(0, 0); ADMA(1, 1); ADMA(2, 2); ADMA(3, 3);
  WAITBAR_N(3);
  qkt8(pA0, pA1, KSLOT(0), q8, r32, hi, NM); partialSM(pA0);
  int sj = 1, sd = 4;
  for (int j = 1; j + 1 < NT; j += 2) {
    WAITBAR_N(j + 2 < NT ? 1 : 0);
    if (j + 3 < NT) ADMA(j + 3, sd);
    if (j + 4 < NT) ADMA(j + 4, NEXT6(sd));
    { const int sp = PREV6(sj);
      SBAR(); qkt8(pB0, pB1, KSLOT(sj), q8, r32, hi, NM);
      finishSM8(pA0, pA1, l_reg, pa); SBAR();
      pv8(o, VBASE(sp), pa, r32, hi); partialSM(pB0);
      sj = NEXT6(sj); }
    { const int sp = PREV6(sj);
      asm volatile("s_waitcnt lgkmcnt(0)" ::: "memory");
      SBAR(); qkt8(pA0, pA1, KSLOT(sj), q8, r32, hi, NM);
      finishSM8(pB0, pB1, l_reg, pa); SBAR();
      pv8(o, VBASE(sp), pa, r32, hi); partialSM(pA0);
      sj = NEXT6(sj); }
    sd = NEXT6(NEXT6(sd));
  }
  { const int sp = PREV6(sj);
    WAITBAR_N(0);
    SBAR(); qkt8(pB0, pB1, KSLOT(sj), q8, r32, hi, NM);
    finishSM8(pA0, pA1, l_reg, pa); SBAR();
    pv8(o, VBASE(sp), pa, r32, hi); partialSM(pB0);
    finishSM8(pB0, pB1, l_reg, pa); SBAR();
    pv8(o, VBASE(sj), pa, r32, hi); }
  { auto rr = __builtin_amdgcn_permlane32_swap(__float_as_uint(l_reg), __float_as_uint(l_reg), false, false); l_reg = __uint_as_float(rr[0]) + __uint_as_float(rr[1]); }
  if (hi == 0) li_l[r32] = l_reg; asm volatile("s_waitcnt lgkmcnt(0)" ::: "memory");
  float rli[16];
#pragma unroll
  for (int r = 0; r < 16; ++r) rli[r] = __builtin_amdgcn_rcpf(li_l[crow(r, hi)]);
  unsigned char* Ow = O8 + (long)(wid * QBLK) * DM; (void)Ob;
#pragma unroll
  for (int r = 0; r < 16; ++r) { int orow = crow(r, hi);
    for (int d0 = 0; d0 < 4; ++d0) { const float x_ = o[d0][r] * rli[r]; Ow[(long)orow * DM + d0 * 32 + r32] = (unsigned char)(__builtin_amdgcn_cvt_pk_fp8_f32(x_, x_, 0, false) & 0xFF); } }
  __syncthreads();
#undef ADMA
#undef KSLOT
#undef VBASE
#undef NEXT6
#undef PREV6
#undef WAITBAR_N
}
}

namespace peer {
__device__ __forceinline__ float vmax(float a, float b) { float r; asm("v_max_f32 %0, %1, %2" : "=v"(r) : "v"(a), "v"(b)); return r; }
__device__ __forceinline__ float vmin(float a, float b) { float r; asm("v_min_f32 %0, %1, %2" : "=v"(r) : "v"(a), "v"(b)); return r; }
__device__ __forceinline__ void cswap(float& hi_, float& lo_) { const float mx = vmax(hi_, lo_), mn = vmin(hi_, lo_); hi_ = mx; lo_ = mn; }
__device__ __forceinline__ void sort16(float (&v)[16]) {
    constexpr int NET[63][2] = {{0,1},{2,3},{0,2},{1,3},{1,2},{4,5},{6,7},{4,6},{5,7},{5,6},{0,4},{2,6},{2,4},{1,5},{3,7},{3,5},{1,2},{3,4},{5,6},{8,9},{10,11},{8,10},{9,11},{9,10},{12,13},{14,15},{12,14},{13,15},{13,14},
        {8,12},{10,14},{10,12},{9,13},{11,15},{11,13},{9,10},{11,12},{13,14},{0,8},{4,12},{4,8},{2,10},{6,14},{6,10},{2,4},{6,8},{10,12},{1,9},{5,13},{5,9},{3,11},{7,15},{7,11},{3,5},{7,9},{11,13},{1,2},{3,4},{5,6},{7,8},{9,10},{11,12},{13,14}};
#pragma unroll
    for (int k = 0; k < 63; ++k) cswap(v[NET[k][0]], v[NET[k][1]]);
}
__device__ __forceinline__ void bmerge16(float (&v)[16]) {
#pragma unroll
    for (int j = 8; j > 0; j >>= 1)
#pragma unroll
        for (int i = 0; i < 16; ++i) { const int l = i ^ j; if (l > i) cswap(v[i], v[l]); }
}
__device__ __forceinline__ void merge_top16(float (&a)[16], const float (&b)[16]) {
#pragma unroll
    for (int i = 0; i < 16; ++i) a[i] = vmax(a[i], b[15 - i]);
    bmerge16(a);
}
__device__ __forceinline__ float setlow(float v, unsigned mask, unsigned bits) { return __uint_as_float((__float_as_uint(v) & ~mask) | bits); }
__device__ __forceinline__ void top16_of_acc(const f32x16 (&acc)[4], int hi, float (&out)[16]) {
    float t[16];
#pragma unroll
    for (int blk = 0; blk < 4; ++blk) {
#pragma unroll
        for (int r = 0; r < 16; ++r) { const unsigned key = (unsigned)(32 * blk + (r & 3) + 8 * (r >> 2)) | ((unsigned)hi << 2); if (blk == 0) out[r] = setlow(acc[blk][r], 0x7Fu, key); else t[r] = setlow(acc[blk][r], 0x7Fu, key); }
        if (blk == 0) sort16(out); else { sort16(t); merge_top16(out, t); }
    }
}
}

struct Args { const float* in[28]; float* out; unsigned char* ws; int ph_lo, ph_hi; };
enum { I_X = 0, I_C, I_CTX, I_CCTX, I_WMOD, I_BMOD, I_NMG, I_WIN, I_QNG, I_KNG, I_ARE, I_AIM, I_LDT, I_BRE, I_BIM, I_CRE, I_CIM, I_SD, I_WGLU, I_BGLU, I_WBA, I_WBS, I_WO, I_NFG, I_PWQ, I_PKEYS, I_PU, I_PV };

template <bool F8 = false> __device__ __forceinline__ void transpose_item(const float* W, int K, int N, bf16_t* WT, LAS float* scr, int item, int lane) {
    const int nblk = N / 32, kb = item / nblk, nb = item % nblk, k0 = 64 * kb, n0 = 32 * nb;
    { f32x4 t[8]; const int kr = lane >> 3, nq = (lane & 7) * 4;
#pragma unroll
      for (int i = 0; i < 8; ++i) t[i] = *(const f32x4*)(W + (size_t)(k0 + 8 * i + kr) * N + n0 + nq);
#pragma unroll
      for (int i = 0; i < 8; ++i) { LAS float* d = scr + (8 * i + kr) * 33 + nq; d[0] = t[i][0]; d[1] = t[i][1]; d[2] = t[i][2]; d[3] = t[i][3]; } }
    asm volatile("s_waitcnt lgkmcnt(0)" ::: "memory");
    const int c = lane & 7;
#pragma unroll
    for (int j = 0; j < 4; ++j) { const int n = (lane >> 3) + 8 * j; const LAS float* s = scr + (8 * c) * 33 + n;
        if (F8) { const f32x4 a4 = {s[0 * 33] * WSCALE8, s[1 * 33] * WSCALE8, s[2 * 33] * WSCALE8, s[3 * 33] * WSCALE8}, b4 = {s[4 * 33] * WSCALE8, s[5 * 33] * WSCALE8, s[6 * 33] * WSCALE8, s[7 * 33] * WSCALE8};
            *(u32x2*)((unsigned char*)WT + (size_t)(n0 + n) * K + k0 + 8 * c) = pack8_fp8(a4, b4); }
        else { u32x4 o; o.x = pk2(s[0 * 33], s[1 * 33]); o.y = pk2(s[2 * 33], s[3 * 33]); o.z = pk2(s[4 * 33], s[5 * 33]); o.w = pk2(s[6 * 33], s[7 * 33]);
            *(u32x4*)(WT + (size_t)(n0 + n) * K + k0 + 8 * c) = o; } }
    asm volatile("s_waitcnt lgkmcnt(0)" ::: "memory");
}

template <bool F8 = false, bool SRC16 = false> __device__ __forceinline__ void norm_mod_row(const float* hr, const float* g, const float* sh, const float* sc, bf16_t* orow, int lane) {
    f32x4 v[4]; float ss = 0.f;
    if (SRC16) { unpack8(*(const u32x4*)((const bf16_t*)hr + lane * 8), v[0], v[1]); unpack8(*(const u32x4*)((const bf16_t*)hr + 512 + lane * 8), v[2], v[3]); }
#pragma unroll
    for (int j = 0; j < 4; ++j) { if (!SRC16) v[j] = *(const f32x4*)(hr + (j >> 1) * 512 + lane * 8 + (j & 1) * 4); ss += (v[j][0] * v[j][0] + v[j][1] * v[j][1]) + (v[j][2] * v[j][2] + v[j][3] * v[j][3]); }
    ss = wave_sum(ss, lane);
    const float rstd = __builtin_amdgcn_rsqf(ss * (1.0f / DM) + EPS);
#pragma unroll
    for (int hh = 0; hh < 2; ++hh) {
        const int c0 = hh * 512 + lane * 8; f32x4 o[2];
#pragma unroll
        for (int j = 0; j < 2; ++j) { const f32x4 gg = *(const f32x4*)(g + c0 + 4 * j), s1 = *(const f32x4*)(sc + c0 + 4 * j), s0 = *(const f32x4*)(sh + c0 + 4 * j);
            o[j] = v[hh * 2 + j] * rstd * gg * (1.0f + s1) + s0; }
        if (F8) *(u32x2*)((unsigned char*)orow + c0) = pack8_fp8(o[0], o[1]); else *(u32x4*)(orow + c0) = pack8(o[0], o[1]);
    }
}
__device__ __forceinline__ const float* hrow_c(const float* hlat, const float* hctx, int r) { return r < NLAT ? hlat + (size_t)r * DM : hctx + (size_t)(r - NLAT) * DM; }
__device__ __forceinline__ float* hrow_m(float* hlat, float* hctx, int r) { return r < NLAT ? hlat + (size_t)r * DM : hctx + (size_t)(r - NLAT) * DM; }

__device__ __forceinline__ void p0a(const Args& a, LAS unsigned char* lds, int bx, int G, int tid) {
    const int lane = tid & 63, wave = tid >> 6, gw = bx * 8 + wave, NGW = G * 8;
    unsigned char* ws = a.ws;
    { LAS float* scr = (LAS float*)(lds + wave * 16384);
      constexpr int I_IN = 16 * 128, I_BA = 16 * 32, I_BS = 8 * 32, I_OO = 16 * 32, I_GL = 8 * 16, I_QQ = 16 * 64, PER = I_IN + I_BA + I_BS + I_OO + I_GL + I_QQ;
      for (int it = gw; it < PER * DEPTH; it += NGW) {
          const int l = it / PER; int r = it - l * PER; bf16_t* base = (bf16_t*)(ws + WS_WT + (size_t)l * WT_LAYER);
          if (r < I_IN) { transpose_item<true>(a.in[I_WIN] + (size_t)l * DM * INW, DM, INW, (bf16_t*)(ws + WS_WIN8 + (size_t)l * INW * DM), scr, r, lane); continue; } r -= I_IN;
          if (r < I_BA) { transpose_item<true>(a.in[I_WBA] + (size_t)l * DM * DM, DM, DM, (bf16_t*)(ws + WS_WIN8 + W8_MIX + (size_t)l * W8_MIX_LAYER + W8_BA), scr, r, lane); continue; } r -= I_BA;
          if (r < I_BS) { transpose_item<true>(a.in[I_WBS] + (size_t)l * SSMW * DM, SSMW, DM, (bf16_t*)(ws + WS_WIN8 + W8_MIX + (size_t)l * W8_MIX_LAYER + W8_BS), scr, r, lane); continue; } r -= I_BS;
          if (r < I_OO) { transpose_item<true>(a.in[I_WO] + (size_t)l * DM * DM, DM, DM, (bf16_t*)(ws + WS_WIN8 + W8_MIX + (size_t)l * W8_MIX_LAYER + W8_O), scr, r, lane); continue; } r -= I_OO;
          if (r < I_GL) { transpose_item<true>(a.in[I_WGLU] + (size_t)l * SSMW * SSMW, SSMW, SSMW, (bf16_t*)(ws + WS_WIN8 + W8_GLU + (size_t)l * SSMW * SSMW), scr, r, lane); continue; } r -= I_GL;
          transpose_item(a.in[I_PWQ] + (size_t)l * DM * PQW, DM, PQW, (bf16_t*)((char*)base + WT_Q), scr, r, lane);
      } }
    { const size_t gt = (size_t)bx * 512 + tid, GT = (size_t)G * 512;
      { typedef float v16f_ __attribute__((ext_vector_type(16))); typedef int v6i_ __attribute__((ext_vector_type(6)));
        constexpr int NROWS = 2 * DEPTH * PEXP;
        f32x4 cur[2][4];
#define P0A_TLOAD(dst, r0_) do { _Pragma("unroll") for (int rr = 0; rr < 2; ++rr) { const int row = ((r0_) + rr * NGW < NROWS) ? (r0_) + rr * NGW : (r0_); const bool isU = row < DEPTH * PEXP; const int idx = isU ? row : row - DEPTH * PEXP; \
            const float* src = (isU ? a.in[I_PU] : a.in[I_PV]) + (size_t)idx * DM + lane * 16; _Pragma("unroll") for (int j = 0; j < 4; ++j) dst[rr][j] = *(const f32x4*)(src + 4 * j); } } while (0)
        if (gw < NROWS) P0A_TLOAD(cur, gw);
        for (int row0 = gw; row0 < NROWS; row0 += 2 * NGW) {
          f32x4 nx[2][4];
          if (row0 + 2 * NGW < NROWS) P0A_TLOAD(nx, row0 + 2 * NGW);
          float v[2][16]; float sc[2], inv[2];
#pragma unroll
          for (int rr = 0; rr < 2; ++rr)
#pragma unroll
              for (int j = 0; j < 4; ++j) { v[rr][4 * j] = cur[rr][j][0]; v[rr][4 * j + 1] = cur[rr][j][1]; v[rr][4 * j + 2] = cur[rr][j][2]; v[rr][4 * j + 3] = cur[rr][j][3]; }
#pragma unroll
          for (int rr = 0; rr < 2; ++rr) { float mx = 0.f;
#pragma unroll
              for (int j = 0; j < 16; ++j) mx = fmaxf(mx, fabsf(v[rr][j]));
#pragma unroll
              for (int o = 1; o < 64; o <<= 1) mx = fmaxf(mx, shflx(mx, o, lane));
              sc[rr] = mx > 0.f ? QMAX / mx : 1.0f; inv[rr] = mx > 0.f ? mx * (1.0f / QMAX) : 1.0f; }
#if PEER_FP4
#pragma unroll
          for (int rr = 0; rr < 2; ++rr) { const int row = row0 + rr * NGW; if (row < NROWS) { const bool isU = row < DEPTH * PEXP; const int idx = isU ? row : row - DEPTH * PEXP;
              unsigned w0 = 0u, w1 = 0u;
#define P0A_PK(b) w0 = __builtin_amdgcn_cvt_scalef32_pk_fp4_f32(w0, v[rr][2 * b] * sc[rr], v[rr][2 * b + 1] * sc[rr], 1.0f, b); w1 = __builtin_amdgcn_cvt_scalef32_pk_fp4_f32(w1, v[rr][8 + 2 * b] * sc[rr], v[rr][8 + 2 * b + 1] * sc[rr], 1.0f, b);
              P0A_PK(0) P0A_PK(1) P0A_PK(2) P0A_PK(3)
#undef P0A_PK
              unsigned* dst = (unsigned*)(ws + (isU ? WS_PU : WS_PV) + (size_t)idx * PROW + lane * 8);
              dst[0] = w0; dst[1] = w1;
              if (lane == 0) ((float*)(ws + (isU ? WS_PSU : WS_PSV)))[idx] = inv[rr]; } }
#else
          v16f_ ga, gb;
#pragma unroll
          for (int j = 0; j < 8; ++j) { ga[j] = v[0][2 * j] * sc[0]; gb[j] = v[0][2 * j + 1] * sc[0]; ga[8 + j] = v[1][2 * j] * sc[1]; gb[8 + j] = v[1][2 * j + 1] * sc[1]; }
          const v6i_ pk = __builtin_amdgcn_cvt_scalef32_2xpk16_fp6_f32(ga, gb, 1.0f);
#pragma unroll
          for (int rr = 0; rr < 2; ++rr) { const int row = row0 + rr * NGW; if (row < NROWS) { const bool isU = row < DEPTH * PEXP; const int idx = isU ? row : row - DEPTH * PEXP;
              unsigned* dst = (unsigned*)(ws + (isU ? WS_PU : WS_PV) + (size_t)idx * 768 + lane * 12);
              dst[0] = (unsigned)pk[3 * rr]; dst[1] = (unsigned)pk[3 * rr + 1]; dst[2] = (unsigned)pk[3 * rr + 2];
              if (lane == 0) ((float*)(ws + (isU ? WS_PSU : WS_PSV)))[idx] = inv[rr]; } }
#endif
#pragma unroll
          for (int rr = 0; rr < 2; ++rr)
#pragma unroll
              for (int j = 0; j < 4; ++j) cur[rr][j] = nx[rr][j];
        } }
#undef P0A_TLOAD
      const size_t k8 = (size_t)DEPTH * 2 * PKEYS * 128 / 8;
      for (size_t i = gt; i < k8; i += GT) { const float* src = a.in[I_PKEYS] + i * 8; const f32x4 x0 = *(const f32x4*)src, x1 = *(const f32x4*)(src + 4);
          u32x4 o; o.x = pk2(x0[0], x0[1]); o.y = pk2(x0[2], x0[3]); o.z = pk2(x1[0], x1[1]); o.w = pk2(x1[2], x1[3]);
          *(u32x4*)((bf16_t*)(ws + WS_KEYS) + i * 8) = o; }
      const size_t nc8 = (size_t)NCTX * DM / 8;
      for (size_t i = gt; i < nc8; i += GT) { const f32x4 c0 = ((const f32x4*)a.in[I_CTX])[2 * i], c1 = ((const f32x4*)a.in[I_CTX])[2 * i + 1]; ((u32x4*)(ws + WS_HB + (size_t)NLAT * DM * 2))[i] = pack8(c0, c1); }
      if (bx == 0) { float* ct = (float*)(ws + WS_ROPE); for (int i = tid; i < 64 * 32; i += 512) { const int pos = i >> 5, f = i & 31;
          const float invf = (float)pow(10000.0, -(double)f / 32.0); const float ang = (float)pos * invf; ct[i] = (float)cos((double)ang); ct[2048 + i] = (float)sin((double)ang); } }
    }
    { __syncthreads();
      LAS float* sv = (LAS float*)lds;
      LAS float* part = (LAS float*)(lds + 9 * 1024 * 4);
      for (int i = tid; i < 9 * DM; i += 512) { const int m = i >> 10, k = i & 1023; const float c = m < NB ? a.in[I_C][m * DM + k] : a.in[I_CCTX][k]; sv[i] = c / (1.0f + __expf(-c)); }
      __syncthreads();
      for (int it = bx; it < DEPTH * (MODW / 32); it += G) {
          const int l = it / (MODW / 32), jb = it % (MODW / 32), kh = lane >> 5, j = jb * 32 + (lane & 31), kb = wave * 128 + kh * 64;
          const float* w = a.in[I_WMOD] + ((size_t)l * DM + kb) * MODW + j;
          float acc[9];
#pragma unroll
          for (int m = 0; m < 9; ++m) acc[m] = 0.f;
#pragma unroll 1
          for (int k0 = 0; k0 < 64; k0 += 16) { float wv[16];
#pragma unroll
              for (int i = 0; i < 16; ++i) wv[i] = w[(size_t)(k0 + i) * MODW];
#pragma unroll
              for (int i = 0; i < 16; ++i)
#pragma unroll
                  for (int m = 0; m < 9; ++m) acc[m] += sv[m * DM + kb + k0 + i] * wv[i]; }
#pragma unroll
          for (int m = 0; m < 9; ++m) part[(wave * 9 + m) * 64 + lane] = acc[m];
          __syncthreads();
          for (int i = tid; i < 9 * 32; i += 512) { const int m = i >> 5, jj = i & 31; float s = 0.f;
#pragma unroll
              for (int w8 = 0; w8 < 8; ++w8) s += part[(w8 * 9 + m) * 64 + jj] + part[(w8 * 9 + m) * 64 + 32 + jj];
              ((float*)(ws + WS_MOD))[((size_t)l * 9 + m) * MODW + jb * 32 + jj] = s + a.in[I_BMOD][(size_t)l * MODW + jb * 32 + jj]; }
          __syncthreads();
      }
    }
}

__device__ __forceinline__ void norm_pass(const Args& a, int l, int sel, bf16_t* dst, int gw, int NGW, int lane, int nrows, const float* hlat) {
    const float* mod = (const float*)(a.ws + WS_MOD) + (size_t)l * 9 * MODW;
    const float* g = a.in[sel ? I_NFG : I_NMG] + (size_t)l * DM;
    const bf16_t* HB = (const bf16_t*)(a.ws + WS_HB);
    for (int r = gw; r < nrows; r += NGW) { const float* mr = mod + (size_t)modrow_of(r) * MODW + sel * 3 * DM;
        if (sel == 0) norm_mod_row<true>(hrow_c(hlat, a.in[I_CTX], r), g, mr, mr + DM, (bf16_t*)((unsigned char*)dst + (size_t)r * DM), lane);
        else norm_mod_row<false, true>((const float*)(HB + (size_t)r * DM), g, mr, mr + DM, dst + (size_t)r * DM, lane); }
}

__device__ __forceinline__ void ssm_tables(const Args& a, int l, LAS unsigned char* lds, int bx, int G, int tid) {
    LAS float* ErT = (LAS float*)lds;
    LAS float* EiT = ErT + 1024;
    LAS float* kr = EiT + 1024;
    LAS float* ki = kr + 128;
    LAS float* red = ki + 128;
    LAS float* E2r = red + 2048;
    LAS float* E2i = E2r + 512;
    LAS float* E3r = E2i + 512;
    LAS float* E3i = E3r + 512;
    LAS float* Cr = E3i + 512;
    LAS float* Ci = Cr + 2048;
    LAS float* kBr = Ci + 2048;
    LAS float* kBi = kBr + 2048;
    bf16_t* WCAT = (bf16_t*)(a.ws + WS_WCAT); bf16_t* WST = (bf16_t*)(a.ws + WS_WSTATE);
    for (int unit = bx; unit < SG * 8; unit += G) {
        const int g = unit >> 3, oc = unit & 7;
        __syncthreads();
        { const int d = tid >> 8, v = tid & 255; const size_t o4 = (((size_t)l * 2 + d) * SG + g) * (SP * SN) + v * 4;
          *(LAS f32x4*)(Cr + tid * 4) = *(const f32x4*)(a.in[I_CRE] + o4); *(LAS f32x4*)(Ci + tid * 4) = *(const f32x4*)(a.in[I_CIM] + o4);
          *(LAS f32x4*)(kBr + tid * 4) = *(const f32x4*)(a.in[I_BRE] + o4); *(LAS f32x4*)(kBi + tid * 4) = *(const f32x4*)(a.in[I_BIM] + o4); }
        {   const int dn = tid & 127, d = dn >> 6, n = dn & 63; const size_t o = (((size_t)l * 2 + d) * SG + g) * SN + n;
            const float are = a.in[I_ARE][o], aim = a.in[I_AIM][o], dt = expf(a.in[I_LDT][((size_t)l * 2 + d) * SG + g]);
            const float th = aim * dt;
            if (tid < 128) { const float mag = expf(are * dt), abr = mag * cosf(th), abi = mag * sinf(th);
                const float den = are * are + aim * aim, nr = abr - 1.0f, ni = abi;
                kr[tid] = (nr * are + ni * aim) / den; ki[tid] = (ni * are - nr * aim) / den; }
#pragma unroll
            for (int ii = 0; ii < 2; ++ii) { const int i = (tid >> 7) + 4 * ii, dl = -31 + 8 * oc + i; const int e = dl < 0 ? -dl : dl;
                const bool on = (dl == 0) || (dl > 0 && d == 0) || (dl < 0 && d == 1);
                const float mg = expf((float)e * are * dt), ph = (float)e * th;
                ErT[dn * 8 + i] = (on && dl <= 31) ? mg * cosf(ph) : 0.f; EiT[dn * 8 + i] = (on && dl <= 31) ? mg * sinf(ph) : 0.f; }
        }
        {
            const int q4 = tid >> 7, d = (tid >> 6) & 1, n = tid & 63; const size_t o = (((size_t)l * 2 + d) * SG + g) * SN + n;
            const float are = a.in[I_ARE][o], aim = a.in[I_AIM][o], dt = expf(a.in[I_LDT][((size_t)l * 2 + d) * SG + g]);
            const int t = 4 * oc + q4;
            const int e2 = d == 0 ? t + 1 : ST - t;
            const int e3 = d == 0 ? ST - 1 - t : t;
            const float m2 = expf((float)e2 * are * dt), p2 = (float)e2 * aim * dt, m3 = expf((float)e3 * are * dt), p3 = (float)e3 * aim * dt;
            E2r[tid] = m2 * cosf(p2); E2i[tid] = m2 * sinf(p2); E3r[tid] = m3 * cosf(p3); E3i[tid] = m3 * sinf(p3);
        }
        __syncthreads();
        { const int dn = tid >> 2; const float k_r = kr[dn], k_i = ki[dn];
          const f32x4 br = *(LAS f32x4*)(kBr + tid * 4), bi = *(LAS f32x4*)(kBi + tid * 4);
          *(LAS f32x4*)(kBr + tid * 4) = k_r * br - k_i * bi; *(LAS f32x4*)(kBi + tid * 4) = k_r * bi + k_i * br; }
        __syncthreads();
        {
            const int pq = tid & 255, p = pq >> 4, q = pq & 15, nh = tid >> 8;
            float acc[8];
#pragma unroll
            for (int i = 0; i < 8; ++i) acc[i] = 0.f;
            for (int d = 0; d < 2; ++d) {
#pragma unroll 4
                for (int n = nh * 32; n < nh * 32 + 32; ++n) {
                    const float cr = Cr[d * 1024 + p * 64 + n], ci = Ci[d * 1024 + p * 64 + n], Br = kBr[d * 1024 + n * 16 + q], Bi = kBi[d * 1024 + n * 16 + q];
                    const float xr = cr * Br - ci * Bi, xi = cr * Bi + ci * Br;
                    const f32x4 e0 = *(LAS f32x4*)(ErT + (d * 64 + n) * 8), e1 = *(LAS f32x4*)(ErT + (d * 64 + n) * 8 + 4), f0 = *(LAS f32x4*)(EiT + (d * 64 + n) * 8), f1 = *(LAS f32x4*)(EiT + (d * 64 + n) * 8 + 4);
#pragma unroll
                    for (int i = 0; i < 4; ++i) { acc[i] += xr * e0[i] - xi * f0[i]; acc[4 + i] += xr * e1[i] - xi * f1[i]; }
                }
            }
            if (nh == 1) {
#pragma unroll
                for (int i = 0; i < 8; ++i) red[i * 256 + pq] = acc[i]; }
            __syncthreads();
            if (nh == 0) {
#pragma unroll
                for (int i = 0; i < 8; ++i) red[i * 256 + pq] += acc[i]; }
            __syncthreads();
            for (int idx = tid; idx < 8 * 32 * 32; idx += 512) {
                const int i = idx >> 10, j = (idx >> 5) & 31, p2 = (idx >> 1) & 15, qh = idx & 1, dl = -31 + 8 * oc + i;
                if (dl > 31) continue;
                const int ad = dl < 0 ? -dl : dl; if (j >= ST - ad) continue;
                const int t = (dl > 0 ? dl : 0) + j, s = t - dl;
                const f32x4 v0 = *(LAS f32x4*)(red + i * 256 + p2 * 16 + qh * 8), v1 = *(LAS f32x4*)(red + i * 256 + p2 * 16 + qh * 8 + 4);
                *(u32x2*)((unsigned char*)WCAT + ((size_t)g * 512 + t * SP + p2) * KCAT + s * SP + qh * 8) = pack8_fp8(v0 * TSC8, v1 * TSC8);
            }
        }
        for (int idx = tid; idx < 4 * 16 * 32; idx += 512) {
            const int kk8 = idx & 31, rp = idx >> 5, q4 = rp >> 4, p = rp & 15, d = kk8 >> 4, part = (kk8 >> 3) & 1, n0 = (kk8 & 7) * 8, t = 4 * oc + q4;
            f32x4 o0, o1;
#pragma unroll
            for (int e = 0; e < 8; ++e) { const int n = n0 + e; const float cr = Cr[d * 1024 + p * 64 + n], ci = Ci[d * 1024 + p * 64 + n], er = E2r[q4 * 128 + d * 64 + n], ei = E2i[q4 * 128 + d * 64 + n];
                const float v = part == 0 ? (cr * er - ci * ei) : -(cr * ei + ci * er); if (e < 4) o0[e] = v; else o1[e - 4] = v; }
            *(u32x2*)((unsigned char*)WCAT + ((size_t)g * 512 + t * SP + p) * KCAT + 512 + kk8 * 8) = pack8_fp8(o0 * WOSC8, o1 * WOSC8);
        }
        for (int idx = tid; idx < 256 * 8; idx += 512) {
            const int c8 = idx & 7, j = idx >> 3, q4 = c8 >> 1, q0 = (c8 & 1) * 8, d = j >> 7, part = (j >> 6) & 1, n = j & 63, s = 4 * oc + q4;
            const float er = E3r[q4 * 128 + d * 64 + n], ei = E3i[q4 * 128 + d * 64 + n];
            f32x4 o0, o1;
#pragma unroll
            for (int e = 0; e < 8; ++e) { const float Br = kBr[d * 1024 + n * 16 + q0 + e], Bi = kBi[d * 1024 + n * 16 + q0 + e];
                const float v = part == 0 ? (er * Br - ei * Bi) : (er * Bi + ei * Br); if (e < 4) o0[e] = v; else o1[e - 4] = v; }
            *(u32x2*)((unsigned char*)WST + ((size_t)g * 256 + j) * 512 + s * SP + q0) = pack8_fp8(o0 * TSC8, o1 * TSC8);
        }
    }
    __syncthreads();
}

__device__ __forceinline__ void ssm_carry(const Args& a, int l, int vb, int tid) {
    const int idx = vb * 512 + tid, n = idx & 63, d = (idx >> 6) & 1, g = (idx >> 7) & 31, b = idx >> 12;
    const size_t o = (((size_t)l * 2 + d) * SG + g) * SN + n;
    const float are = a.in[I_ARE][o], aim = a.in[I_AIM][o], dt = expf(a.in[I_LDT][((size_t)l * 2 + d) * SG + g]);
    const float mg = expf((float)ST * are * dt), ph = (float)ST * aim * dt, pr = mg * cosf(ph), pi = mg * sinf(ph);
    const bf16_t* SX = (const bf16_t*)(a.ws + WS_SX) + (size_t)g * NCOLP * 256 + d * 128 + n;
    unsigned char* UC = a.ws + WS_UCAT + (size_t)g * NCOLP * KCAT + 512 + d * 128 + n;
    float hr = 0.f, hi = 0.f;
#pragma unroll 1
    for (int st0 = 0; st0 < NCH; st0 += 34) {
        float xr[34], xi[34];
#pragma unroll
        for (int k = 0; k < 34; ++k) { const int st = st0 + k; int c;
            if (d == 0) c = st < 8 ? NCHL + st : st - 8; else c = st < 8 ? NCHL + 7 - st : NCHL - 1 - (st - 8);
            const int col = c * 8 + b; xr[k] = bflo((unsigned)SX[(size_t)col * 256]); xi[k] = bflo((unsigned)SX[(size_t)col * 256 + 64]); }
#pragma unroll
        for (int k = 0; k < 34; ++k) { const int st = st0 + k; int c;
            if (d == 0) c = st < 8 ? NCHL + st : st - 8; else c = st < 8 ? NCHL + 7 - st : NCHL - 1 - (st - 8);
            const int col = c * 8 + b;
            { const float h0_ = hr * HSC8, h1_ = hi * HSC8; UC[(size_t)col * KCAT] = (unsigned char)(__builtin_amdgcn_cvt_pk_fp8_f32(h0_, h0_, 0, false) & 0xFF); UC[(size_t)col * KCAT + 64] = (unsigned char)(__builtin_amdgcn_cvt_pk_fp8_f32(h1_, h1_, 0, false) & 0xFF); }
            const float nr = pr * hr - pi * hi + xr[k], ni = pr * hi + pi * hr + xi[k]; hr = nr; hi = ni; }
    }
}

#define DPPX(v, ctrl) __builtin_bit_cast(float, __builtin_amdgcn_update_dpp(0, __builtin_bit_cast(int, (v)), (ctrl), 0xf, 0xf, false))
__device__ __forceinline__ void qk_head_rows(bf16_t* p, const float* gain, const float* rope, int lpos  , int lane, const float osc, unsigned char* k8 = nullptr  ) {
    const int sub = lane & 7;
    float x[16]; { f32x4 a0, a1, b0, b1;
        if (k8) { const u32x4 w = *(const u32x4*)p; unpack8_fp8((u32x2){w.x, w.y}, a0, a1); unpack8_fp8((u32x2){w.z, w.w}, b0, b1); }
        else { const u32x4 w0 = *(const u32x4*)p, w1 = *(const u32x4*)(p + 8); unpack8(w0, a0, a1); unpack8(w1, b0, b1); }
#pragma unroll
        for (int i = 0; i < 4; ++i) { x[i] = a0[i]; x[4 + i] = a1[i]; x[8 + i] = b0[i]; x[12 + i] = b1[i]; } }
    float ss = 0.f;
#pragma unroll
    for (int i = 0; i < 16; ++i) ss += x[i] * x[i];
    ss += DPPX(ss, 0xB1);
    ss += DPPX(ss, 0x4E);
    ss += DPPX(ss, 0x141);
    const float rstd = osc * __builtin_amdgcn_rsqf(ss * (1.0f / HD) + EPS);
    const f32x4* g4 = (const f32x4*)(gain + sub * 16);
#pragma unroll
    for (int j = 0; j < 4; ++j) { const f32x4 gg = g4[j];
#pragma unroll
        for (int i = 0; i < 4; ++i) x[4 * j + i] = x[4 * j + i] * rstd * gg[i]; }
    float y[16];
    if (lpos >= 0) {
        const int axis = sub >> 2, posi = axis == 0 ? (lpos >> 6) : (lpos & 63), f0 = (sub & 1) * 16;
        const float sgn = (sub & 2) ? 1.0f : -1.0f;
        const f32x4* c4 = (const f32x4*)(rope + posi * 32 + f0); const f32x4* s4 = (const f32x4*)(rope + 2048 + posi * 32 + f0);
#pragma unroll
        for (int j = 0; j < 4; ++j) { const f32x4 cs = c4[j], sn = s4[j];
#pragma unroll
            for (int i = 0; i < 4; ++i) { const float other = DPPX(x[4 * j + i], 0x4E);
                y[4 * j + i] = x[4 * j + i] * cs[i] + sgn * other * sn[i]; } }
    } else {
#pragma unroll
        for (int i = 0; i < 16; ++i) y[i] = x[i];
    }
    if (k8) {
        int w[4];
#pragma unroll
        for (int j = 0; j < 4; ++j) { int v = 0; v = __builtin_amdgcn_cvt_pk_fp8_f32(y[4 * j], y[4 * j + 1], v, false); v = __builtin_amdgcn_cvt_pk_fp8_f32(y[4 * j + 2], y[4 * j + 3], v, true); w[j] = v; }
        *(u32x4*)(k8 + (sub >> 2) * 64 + (sub & 1) * 32 + ((sub >> 1) & 1) * 16) = (u32x4){(unsigned)w[0], (unsigned)w[1], (unsigned)w[2], (unsigned)w[3]};
        return; }
    f32x4 o0 = {y[0], y[1], y[2], y[3]}, o1 = {y[4], y[5], y[6], y[7]}, o2 = {y[8], y[9], y[10], y[11]}, o3 = {y[12], y[13], y[14], y[15]};
    *(u32x4*)p = pack8(o0, o1); *(u32x4*)(p + 8) = pack8(o2, o3);
}
__device__ __forceinline__ void v8t_pass(const Args& a, LAS unsigned char* lds, int gw, int NGW, int lane, int wave) {
    const bf16_t* VB = (const bf16_t*)(a.ws + WS_VB); unsigned char* V8T = a.ws + WS_V8T;
    LAS unsigned char* img = lds + wave * 16384;
    for (int tb = gw; tb < NB * NKVH * (KVLEN / 64); tb += NGW) {
        const int tile = tb % (KVLEN / 64), bh = tb / (KVLEN / 64), kvh = bh % NKVH, b = bh / NKVH;
        const int kk = lane, k5 = kk & 31, kgp = (k5 >> 2) & 1, sl = (k5 & 3) + 4 * (k5 >> 3) + 16 * (kk >> 5), pos = kgp * 32 + sl;
        const unsigned char* src = (const unsigned char*)VB + ((size_t)b * KVLEN + tile * 64 + kk) * KVW + kvh * HD;
#pragma unroll
        for (int c = 0; c < 8; ++c) { const u32x4 w = *(const u32x4*)(src + c * 16);
#pragma unroll
            for (int e = 0; e < 16; ++e) { const int d = c * 16 + e; const unsigned byte = ((e < 4 ? w.x : e < 8 ? w.y : e < 12 ? w.z : w.w) >> (8 * (e & 3))) & 0xFFu;
                img[d * 64 + ((((pos >> 4) ^ ((d >> 2) & 3)) << 4) | (pos & 15))] = (unsigned char)byte; } }
        asm volatile("s_waitcnt lgkmcnt(0)" ::: "memory");
#pragma unroll
        for (int c = 0; c < 8; ++c) *(u32x4*)(V8T + (size_t)tb * 8192 + (c * 64 + lane) * 16) = *(const LAS u32x4*)(img + (c * 64 + lane) * 16);
        asm volatile("s_waitcnt lgkmcnt(0)" ::: "memory");
    }
}
__device__ __forceinline__ void qk_pass(const Args& a, int l, int gw, int NGW, int lane) {
    bf16_t* Q = (bf16_t*)(a.ws + WS_Q); bf16_t* KB = (bf16_t*)(a.ws + WS_KB); const float* rope = (const float*)(a.ws + WS_ROPE);
    const float* qg = a.in[I_QNG] + (size_t)l * HD; const float* kg = a.in[I_KNG] + (size_t)l * HD;
    (void)Q; (void)qg;
    for (int it = gw; it < NTOK / 4; it += NGW) { const int r = it * 4 + (lane >> 4);
        qk_head_rows((bf16_t*)((unsigned char*)KB + (size_t)kvrow_of(r) * KVW + (lane & 15) * 16), kg, rope, r < NLAT ? (r & 4095) : -1, lane, 1.0f, (unsigned char*)(a.ws + WS_K8) + (size_t)kvrow_of(r) * KVW + ((lane & 15) >> 3) * 128); }
}

__host__ __device__ constexpr int cand_off(int i) { int o = 0; for (int k = 0; k < i; ++k) o += 16 / (k + 1); return o; }
__device__ __forceinline__ void gather_token(const Args& a, int l, int tok, const LAS unsigned* sid, const LAS float* sw, int lane, const bool dry);
__device__ __forceinline__ void peer_topk(const Args& a, int l, LAS unsigned char* lds, int gw, int NGW, int tid, int nrows, const bool dry) {
    const int wave = tid >> 6;
    const bf16_t* keys = (const bf16_t*)(a.ws + WS_KEYS) + (size_t)l * 2 * PKEYS * 128;
    const bf16_t* PQ = (const bf16_t*)(a.ws + WS_GA);
    __syncthreads();
    for (int c = tid; c < 4096; c += 512) { const int p = c >> 11, key = (c >> 4) & 127, cc = c & 15;
        *(LAS u32x4*)(lds + p * 32768 + KSWZ(key, cc * 16)) = *(const u32x4*)(keys + ((size_t)p * PKEYS + key) * 128 + cc * 8); }
    __syncthreads();
    LAS unsigned* xs = (LAS unsigned*)(lds + 65536 + wave * 2048);
    LAS unsigned* sid = (LAS unsigned*)(lds + 81920 + wave * 4096);
    LAS float* sw = (LAS float*)(lds + 81920 + wave * 4096 + 2048);
    const int T = (nrows + NGW - 1) / NGW, tbeg = gw * T, tend = (tbeg + T < nrows) ? tbeg + T : nrows;
#pragma unroll 1
    for (int t0 = tbeg; t0 < tend; t0 += 4) {
        const int ntb = (tend - t0 < 4) ? tend - t0 : 4;
        int lane_ = tid & 63; asm volatile("" : "+v"(lane_));
        const int lane = lane_, r32 = lane & 31, hi = lane >> 5;
        const int rv = (r32 >> 3) < ntb ? r32 : (ntb * 8 - 1);
        const size_t R = (size_t)t0 * 8 + rv;
        float a12[2][16];
#pragma unroll
        for (int p = 0; p < 2; ++p) {
            bf16x8 qv[8];
#pragma unroll
            for (int ds = 0; ds < 8; ++ds) qv[ds] = *(const bf16x8*)(PQ + R * 256 + p * 128 + ds * 16 + hi * 8);
            f32x16 acc[4];
#pragma unroll
            for (int kb = 0; kb < 4; ++kb) acc[kb] = f32x16{};
#pragma unroll
            for (int ds = 0; ds < 8; ++ds)
#pragma unroll
                for (int kb = 0; kb < 4; ++kb) { const bf16x8 ka = *(const LAS bf16x8*)(lds + p * 32768 + KSWZ(kb * 32 + r32, ds * 32 + hi * 16));
                    acc[kb] = __builtin_amdgcn_mfma_f32_32x32x16_bf16(ka, qv[ds], acc[kb], 0, 0, 0); }
            __builtin_amdgcn_sched_barrier(0);
            float top[16]; peer::top16_of_acc(acc, hi, top);
            __builtin_amdgcn_sched_barrier(0);
#pragma unroll
            for (int j = 0; j < 16; ++j) a12[p][j] = peer::vmax(top[j], shflx(top[15 - j], 32, lane));
            peer::bmerge16(a12[p]);
            __builtin_amdgcn_sched_barrier(0);
        }
        float cd[64];
#pragma unroll
        for (int i = 0; i < 16; ++i)
#pragma unroll
            for (int j = 0; j < 16; ++j) if ((i + 1) * (j + 1) <= 16) cd[cand_off(i) + j] = peer::setlow(a12[0][i] + a12[1][j], 0xFFu, (unsigned)(i * 16 + j));
#pragma unroll
        for (int n = 50; n < 64; ++n) cd[n] = -3.0e38f;
        __builtin_amdgcn_sched_barrier(0);
        float best[16], t[16];
#pragma unroll
        for (int blk = 0; blk < 4; ++blk) {
#pragma unroll
            for (int r = 0; r < 16; ++r) { if (blk == 0) best[r] = cd[r]; else t[r] = cd[blk * 16 + r]; }
            if (blk == 0) {   }
            else if (blk < 3) { peer::sort16(t); peer::merge_top16(best, t); }
            else { peer::sort16(t);
#pragma unroll
                for (int i = 0; i < 16; ++i) best[i] = peer::vmax(best[i], t[15 - i]); }
            __builtin_amdgcn_sched_barrier(0);
        }
#pragma unroll
        for (int p = 0; p < 2; ++p)
#pragma unroll
            for (int q = 0; q < 4; ++q) { unsigned w = 0;
#pragma unroll
                for (int e = 0; e < 4; ++e) w |= (__float_as_uint(a12[p][4 * q + e]) & 0x7Fu) << (8 * e);
                xs[(p * 4 + q) * 64 + lane] = w; }
        const float mx = cd[0]; float ex[16], sum = 0.f;
#pragma unroll
        for (int k = 0; k < 16; ++k) { ex[k] = __expf(best[k] - mx); sum += ex[k]; }
        const float inv = __builtin_amdgcn_rcpf(sum);
        unsigned ids[8]; float wts[8]; const unsigned him = 0u - (unsigned)hi;
#pragma unroll
        for (int k = 0; k < 8; ++k) { const float bsel = __uint_as_float((__float_as_uint(best[8 + k]) & him) | (__float_as_uint(best[k]) & ~him)); const float esel = __uint_as_float((__float_as_uint(ex[8 + k]) & him) | (__float_as_uint(ex[k]) & ~him));
            const unsigned code = __float_as_uint(bsel) & 0xFFu, ii = code >> 4, jj = code & 15u;
            const unsigned w1 = xs[(ii >> 2) * 64 + lane], w2 = xs[(4 + (jj >> 2)) * 64 + lane];
            const unsigned i1 = (w1 >> (8 * (ii & 3))) & 0x7Fu, i2 = (w2 >> (8 * (jj & 3))) & 0x7Fu;
            ids[k] = i1 * PKEYS + i2; wts[k] = esel * inv; }
        LAS unsigned* di = sid + r32 * 16 + hi * 8; LAS float* dw = sw + r32 * 16 + hi * 8;
        *(LAS u32x4*)di = (u32x4){ids[0], ids[1], ids[2], ids[3]}; *(LAS u32x4*)(di + 4) = (u32x4){ids[4], ids[5], ids[6], ids[7]};
        *(LAS f32x4*)dw = (f32x4){wts[0], wts[1], wts[2], wts[3]}; *(LAS f32x4*)(dw + 4) = (f32x4){wts[4], wts[5], wts[6], wts[7]};
        asm volatile("s_waitcnt lgkmcnt(0)" ::: "memory");
#pragma unroll 1
        for (int t4 = 0; t4 < ntb; ++t4) gather_token(a, l, t0 + t4, sid + t4 * 128, sw + t4 * 128, lane, dry);
    }
    __syncthreads();
}

typedef float f32x2v __attribute__((ext_vector_type(2)));
typedef float v32f __attribute__((ext_vector_type(32)));
typedef int v6i __attribute__((ext_vector_type(6)));
typedef unsigned u32x3 __attribute__((ext_vector_type(3)));
__device__ __forceinline__ float dpp_sum63(float v) {
#define DPP_ADD(ctrl, rmask) v += __builtin_bit_cast(float, __builtin_amdgcn_update_dpp(0, __builtin_bit_cast(int, v), ctrl, rmask, 0xf, false))
    DPP_ADD(0x111, 0xf); DPP_ADD(0x112, 0xf); DPP_ADD(0x114, 0xf); DPP_ADD(0x118, 0xf);
    DPP_ADD(0x142, 0xa); DPP_ADD(0x143, 0xc);
#undef DPP_ADD
    return v;
}
__device__ __forceinline__ void fp8x16(const u32x4 w, float (&f)[16]) {
#pragma unroll
    for (int j = 0; j < 4; ++j) { const f32x2v lo = __builtin_amdgcn_cvt_pk_f32_fp8((int)w[j], false), hi = __builtin_amdgcn_cvt_pk_f32_fp8((int)w[j], true);
        f[4 * j] = lo[0]; f[4 * j + 1] = lo[1]; f[4 * j + 2] = hi[0]; f[4 * j + 3] = hi[1]; }
}
__device__ __forceinline__ float reduce8(const float (&d)[8], int lane) {
    const bool b0 = lane & 1, b1 = lane & 2, b2 = lane & 4;
    float r1[4], r2[2];
#pragma unroll
    for (int p = 0; p < 4; ++p) { const float t = b0 ? d[2 * p + 1] : d[2 * p], u = b0 ? d[2 * p] : d[2 * p + 1]; r1[p] = t + DPPX(u, 0xB1); }
#pragma unroll
    for (int p = 0; p < 2; ++p) { const float t = b1 ? r1[2 * p + 1] : r1[2 * p], u = b1 ? r1[2 * p] : r1[2 * p + 1]; r2[p] = t + DPPX(u, 0x4E); }
    float r;
    { const float t = b2 ? r2[1] : r2[0], u = b2 ? r2[0] : r2[1];
      int x = __builtin_amdgcn_update_dpp(0, __builtin_bit_cast(int, u), 0x104, 0xf, 0x5, false);
      x = __builtin_amdgcn_update_dpp(x, __builtin_bit_cast(int, u), 0x114, 0xf, 0xa, false);
      r = t + __builtin_bit_cast(float, x); }
    r += DPPX(r, 0x128);
    r += __builtin_bit_cast(float, __builtin_amdgcn_ds_swizzle(__builtin_bit_cast(int, r), 0x401F));
    { auto rr = __builtin_amdgcn_permlane32_swap(__float_as_uint(r), __float_as_uint(r), false, false); r = __uint_as_float(rr[0]) + __uint_as_float(rr[1]); }
    return r;
}
__device__ __forceinline__ void gather_token(const Args& a, int l, int tok, const LAS unsigned* sid, const LAS float* sw, int lane, const bool dry) {
    const bf16_t* XN2 = (const bf16_t*)(a.ws + WS_XN2);
    const unsigned char* PU = a.ws + WS_PU + (size_t)l * PEXP * PROW; const unsigned char* PV = a.ws + WS_PV + (size_t)l * PEXP * PROW;
    const float* SU = (const float*)(a.ws + WS_PSU) + (size_t)l * PEXP; const float* SV = (const float*)(a.ws + WS_PSV) + (size_t)l * PEXP;
    const float* mod = (const float*)(a.ws + WS_MOD) + (size_t)l * 9 * MODW;
    float* hctx = (float*)(a.ws + WS_HCTX);
    {
        float x[16];
        { const u32x4 x0 = *(const u32x4*)(XN2 + (size_t)tok * DM + lane * 16), x1 = *(const u32x4*)(XN2 + (size_t)tok * DM + lane * 16 + 8);
#pragma unroll
          for (int i = 0; i < 4; ++i) { x[2 * i] = bflo(x0[i]); x[2 * i + 1] = bfhi(x0[i]); x[8 + 2 * i] = bflo(x1[i]); x[8 + 2 * i + 1] = bfhi(x1[i]); } }
        float out[16];
#pragma unroll
        for (int i = 0; i < 16; ++i) out[i] = 0.f;
#pragma unroll 1
        for (int half = 0; half < 2; ++half) {
            const unsigned id = sid[half * 64 + lane]; const float w = sw[half * 64 + lane];
            const float su = SU[id], sv = SV[id];
            float dotv = 0.f;
#if PEER_FP4
            typedef unsigned u32x2 __attribute__((ext_vector_type(2)));
            u32x2 b0[8], b1[8];
            const unsigned lo8 = (unsigned)lane * 8u;
#define PG_LOAD(dst, TAB, e0) _Pragma("unroll") for (int q = 0; q < 8; ++q) { const unsigned idq = (unsigned)__builtin_amdgcn_readlane((int)id, (e0) + q); dst[q] = *(const u32x2*)(TAB + (idq * 512u + lo8)); }
#define PG_CVT(src, q) const f32x2 f[8] = {__builtin_amdgcn_cvt_scalef32_pk_f32_fp4(src[q][0], 1.0f, 0), __builtin_amdgcn_cvt_scalef32_pk_f32_fp4(src[q][0], 1.0f, 1), __builtin_amdgcn_cvt_scalef32_pk_f32_fp4(src[q][0], 1.0f, 2), __builtin_amdgcn_cvt_scalef32_pk_f32_fp4(src[q][0], 1.0f, 3), \
                __builtin_amdgcn_cvt_scalef32_pk_f32_fp4(src[q][1], 1.0f, 0), __builtin_amdgcn_cvt_scalef32_pk_f32_fp4(src[q][1], 1.0f, 1), __builtin_amdgcn_cvt_scalef32_pk_f32_fp4(src[q][1], 1.0f, 2), __builtin_amdgcn_cvt_scalef32_pk_f32_fp4(src[q][1], 1.0f, 3)};
#define PG_DOT(src, e0) { float d8[8]; _Pragma("unroll") for (int q = 0; q < 8; ++q) { PG_CVT(src, q) f32x2 a0 = {0.f, 0.f}; \
                _Pragma("unroll") for (int i = 0; i < 8; ++i) { const f32x2 xx = {x[2 * i], x[2 * i + 1]}; a0 += f[i] * xx; } d8[q] = a0[0] + a0[1]; } \
                const float tot = reduce8(d8, lane); dotv = ((lane >> 3) == ((e0) >> 3)) ? tot : dotv; }
#define PG_ACC(src, e0) _Pragma("unroll") for (int q = 0; q < 8; ++q) { PG_CVT(src, q) \
                const float c0 = __builtin_bit_cast(float, __builtin_amdgcn_readlane(__builtin_bit_cast(int, coef), (e0) + q)); const f32x2 cc0 = {c0, c0}; \
                _Pragma("unroll") for (int i = 0; i < 8; ++i) { f32x2 o2 = {out[2 * i], out[2 * i + 1]}; o2 += cc0 * f[i]; out[2 * i] = o2[0]; out[2 * i + 1] = o2[1]; } }
#else
            u32x3 b0[8], b1[8];
            const unsigned lo12 = (unsigned)lane * 12u;
#define PG_LOAD(dst, TAB, e0) _Pragma("unroll") for (int q = 0; q < 8; ++q) { const unsigned idq = (unsigned)__builtin_amdgcn_readlane((int)id, (e0) + q); dst[q] = *(const u32x3*)(TAB + (idq * 768u + lo12)); }
#define PG_CVT(src, q) const v6i pk_ = {(int)src[q][0], (int)src[q][1], (int)src[q][2], (int)src[(q) + 1][0], (int)src[(q) + 1][1], (int)src[(q) + 1][2]}; const v32f f = __builtin_amdgcn_cvt_scalef32_pk32_f32_fp6(pk_, 1.0f);
#define F2(i) ((f32x2){f[2 * (i)], f[2 * (i) + 1]})
#define PG_DOT(src, e0) { float d8[8]; _Pragma("unroll") for (int q = 0; q < 8; q += 2) { PG_CVT(src, q) f32x2 a0 = {0.f, 0.f}, a1 = {0.f, 0.f}; \
                _Pragma("unroll") for (int i = 0; i < 8; ++i) { const f32x2 xx = {x[2 * i], x[2 * i + 1]}; a0 += F2(i) * xx; a1 += F2(8 + i) * xx; } d8[q] = a0[0] + a0[1]; d8[q + 1] = a1[0] + a1[1]; } \
                const float tot = reduce8(d8, lane); dotv = ((lane >> 3) == ((e0) >> 3)) ? tot : dotv; }
#define PG_ACC(src, e0) _Pragma("unroll") for (int q = 0; q < 8; q += 2) { PG_CVT(src, q) \
                const float c0 = __builtin_bit_cast(float, __builtin_amdgcn_readlane(__builtin_bit_cast(int, coef), (e0) + q)), c1 = __builtin_bit_cast(float, __builtin_amdgcn_readlane(__builtin_bit_cast(int, coef), (e0) + q + 1)); \
                const f32x2 cc0 = {c0, c0}, cc1 = {c1, c1}; \
                _Pragma("unroll") for (int i = 0; i < 8; ++i) { f32x2 o2 = {out[2 * i], out[2 * i + 1]}; o2 += cc0 * F2(i); o2 += cc1 * F2(8 + i); out[2 * i] = o2[0]; out[2 * i + 1] = o2[1]; } }
#endif
#if PEER_FP4
            u32x2 b2[8];
#else
            u32x3 b2[8];
#endif
#define PG_STEPA(cur, nxt, kb) { const int kl_ = (kb) + 2; if (kl_ < 8) { PG_LOAD(nxt, PU, kl_ * 8) } else { PG_LOAD(nxt, PV, (kl_ - 8) * 8) } PG_DOT(cur, (kb) * 8) }
#define PG_STEPB(cur, nxt, kb) { const int kl_ = (kb) + 2; if (kl_ < 8) { PG_LOAD(nxt, PV, kl_ * 8) } PG_ACC(cur, (kb) * 8) }
            PG_LOAD(b0, PU, 0) PG_LOAD(b1, PU, 8)
#pragma unroll 1
            for (int kb = 0; kb < 6; kb += 3) { PG_STEPA(b0, b2, kb) PG_STEPA(b1, b0, kb + 1) PG_STEPA(b2, b1, kb + 2) }
            PG_STEPA(b0, b2, 6) PG_STEPA(b1, b0, 7)
            const float coef = w * gelu_tanh(dotv * su) * sv;
#pragma unroll 1
            for (int kb = 0; kb < 6; kb += 3) { PG_STEPB(b2, b1, kb) PG_STEPB(b0, b2, kb + 1) PG_STEPB(b1, b0, kb + 2) }
            PG_STEPB(b2, b1, 6) PG_STEPB(b0, b2, 7)
#undef PG_STEPA
#undef PG_STEPB
#undef PG_LOAD
#undef PG_CVT
#undef PG_DOT
#undef PG_ACC
        }
        if (dry) { float sink = 0.f;
#pragma unroll
            for (int i = 0; i < 16; ++i) sink += out[i];
            asm volatile("" :: "v"(sink)); return; }
        bf16_t* hr = (bf16_t*)(a.ws + WS_HB) + (size_t)tok * DM + lane * 16;
        const float* gt = mod + (size_t)modrow_of(tok) * MODW + 5 * DM + lane * 16;
        f32x4 hv[4]; float ss = 0.f;
        unpack8(*(const u32x4*)hr, hv[0], hv[1]); unpack8(*(const u32x4*)(hr + 8), hv[2], hv[3]);
#pragma unroll
        for (int j = 0; j < 4; ++j) { const f32x4 g4 = *(const f32x4*)(gt + 4 * j);
#pragma unroll
            for (int i = 0; i < 4; ++i) hv[j][i] += g4[i] * out[4 * j + i];
            ss += (hv[j][0] * hv[j][0] + hv[j][1] * hv[j][1]) + (hv[j][2] * hv[j][2] + hv[j][3] * hv[j][3]); }
        if (l + 1 < DEPTH) { *(u32x4*)hr = pack8(hv[0], hv[1]); *(u32x4*)(hr + 8) = pack8(hv[2], hv[3]); }
        else { float* orow_ = a.out + (size_t)tok * DM + lane * 16;
#pragma unroll
            for (int j = 0; j < 4; ++j) *(f32x4*)(orow_ + 4 * j) = hv[j]; }
        if (l + 1 < DEPTH) {
            ss = wave_sum(ss, lane);
            const float rstd = __builtin_amdgcn_rsqf(ss * (1.0f / DM) + EPS);
            const float* g = a.in[I_NMG] + (size_t)(l + 1) * DM + lane * 16; const float* mr = mod + 9 * MODW + (size_t)modrow_of(tok) * MODW + lane * 16;
            unsigned char* orow = a.ws + WS_XN + (size_t)tok * DM + lane * 16;
            f32x4 o[4];
#pragma unroll
            for (int j = 0; j < 4; ++j) { const f32x4 gg = *(const f32x4*)(g + 4 * j), s1 = *(const f32x4*)(mr + DM + 4 * j), s0 = *(const f32x4*)(mr + 4 * j);
                o[j] = hv[j] * rstd * gg * (1.0f + s1) + s0; }
            { const u32x2 lo8 = pack8_fp8(o[0], o[1]), hi8 = pack8_fp8(o[2], o[3]); *(u32x4*)orow = (u32x4){lo8.x, lo8.y, hi8.x, hi8.y}; }
        }
    }
}

constexpr int NPH_LAYER = 10, NPHASE = 2 + NPH_LAYER * DEPTH;
__global__ void __launch_bounds__(512, 2) mega_fwd(Args a_in) {
    extern __shared__ __attribute__((aligned(16))) unsigned char lds_[];
    LAS unsigned char* lds = (LAS unsigned char*)lds_;
    const int bx = blockIdx.x, G = gridDim.x, NGW = G * 8;
#define PHASE_IDS const int lane = lane_id_now(), wave = wave_s, tid = wave_s * 64 + lane, gw = bx * 8 + wave; (void)lane; (void)gw; (void)tid; \
    const __attribute__((address_space(4))) Args* ap_ = (const __attribute__((address_space(4))) Args*)__builtin_amdgcn_kernarg_segment_ptr(); asm volatile("" : "+s"(ap_)); const Args& a = *(const Args*)ap_; \
    unsigned char* ws = a.ws; (void)ws;
    const int wave_s = __builtin_amdgcn_readfirstlane(threadIdx.x >> 6);
    volatile LAS unsigned* MISC = (volatile LAS unsigned*)(lds + MISC_OFF);
    if (threadIdx.x < 32) MISC[threadIdx.x] = 0u;
    __syncthreads();
    unsigned* ctl = (unsigned*)(a_in.ws + WS_CTL);
    XcdBarrier bar; bar.bar = ctl + CW_BAR; bar.x = 0; bar.st = MISC + 8;
    if (!MK_MULTI) bar = xcd_barrier_post(ctl + CW_BAR, MISC + 8);
    int lo = a_in.ph_lo, hi = a_in.ph_hi;
#define IN(k) (lo <= (k) && (k) < hi)
#define SEAM(k) do { if (!MK_MULTI && IN(k) && IN((k) + 1)) xcd_barrier(bar, wave_s == 0 && lane_id_now() == 0); } while (0)
#define XN ((bf16_t*)(ws + WS_XN))
#define XN2 ((bf16_t*)(ws + WS_XN2))
#define Qb ((bf16_t*)(ws + WS_Q))
#define KB ((bf16_t*)(ws + WS_KB))
#define VB ((bf16_t*)(ws + WS_VB))
#define UCAT ((bf16_t*)(ws + WS_UCAT))
#define GA ((bf16_t*)(ws + WS_GA))
#define GBb ((bf16_t*)(ws + WS_GB))
#define YG ((bf16_t*)(ws + WS_YG))
#define SSMO ((bf16_t*)(ws + WS_SSMO))
#define Y XN
#define PQ GA
#define hctx ((float*)(ws + WS_HCTX))
#define wl (ws + WS_WT + (size_t)l * WT_LAYER)
#define mod ((const float*)(ws + WS_MOD) + (size_t)l * 9 * MODW)

    if (DG(0) && IN(0)) REPS(0) { PHASE_IDS p0a(a, lds, bx, G, tid); }
    SEAM(0);
    if (DG(1) && IN(1)) { PHASE_IDS norm_pass(a, 0, 0, XN, gw, NGW, lane, NTOK, a.in[I_X]); }
    SEAM(1);

    for (int l = 0; l < DEPTH; ++l) {
        const int pb = 2 + NPH_LAYER * l;
        asm volatile("" : "+s"(lo), "+s"(hi));
        const int MR = (l + 1 < DEPTH) ? NTOK : NLAT;
        if (DG(2) && IN(pb + 0)) REPS(2) { PHASE_IDS
            ssm_tables(a, l, lds, bx, G, tid);
            pg8::Gemm g{XN, (const bf16_t*)(ws + WS_WIN8 + (size_t)l * INW * DM)}; pg8::SplitOrder S; S.init(NTOK, INW, G, bx);
            pg8::EpiIn E{ws, 1.0f / WSCALE8};
            pg8::gemm_phase<DM / 2, DM / 2, DM / 2, 0, 0, true>(lds, g, S, E, tid);
        }
        SEAM(pb + 0);
        if (DG(3) && IN(pb + 1)) REPS(3) { PHASE_IDS
            qk_pass(a, l, gw, NGW, lane);
            v8t_pass(a, lds, gw, NGW, lane, wave);
            __syncthreads();
            pg8::Gemm g{UCAT, (const bf16_t*)(ws + WS_WSTATE)}; pg8::BatchOrder S; S.init(NCOLP / 256, 1, SG, G, (G % 8 == 0) ? (bx % 8) * (G / 8) + bx / 8 : bx);
            pg8::EpiSX E{(float*)(ws + WS_SX)};
            pg8::gemm_phase<256, KCAT / 2, 256, (size_t)NCOLP * KCAT, (size_t)256 * 512, true>(lds, g, S, E, tid);
        }
        SEAM(pb + 1);
        if (DG(4) && IN(pb + 2)) REPS(4) { PHASE_IDS
            float nm0;
            { float gq = fmaxf(fabsf(a.in[I_QNG][(size_t)l * HD + lane]), fabsf(a.in[I_QNG][(size_t)l * HD + 64 + lane])), gk = fmaxf(fabsf(a.in[I_KNG][(size_t)l * HD + lane]), fabsf(a.in[I_KNG][(size_t)l * HD + 64 + lane]));
#pragma unroll
              for (int o = 1; o < 64; o <<= 1) { gq = fmaxf(gq, shflx(gq, o, lane)); gk = fmaxf(gk, shflx(gk, o, lane)); }
              nm0 = -(float)HD * gq * gk * att::SCALE * 1.4426950408889634f * 1.01f; }
            for (int vb = G - 1 - bx; vb < 64; vb += G) ssm_carry(a, l, vb, tid);
            __syncthreads();
            const int x8 = bx & 7, j32 = bx >> 3;
            const int nlat = (G == 256) ? 4 : (bx < NB * NQH * 16 ? (NB * NQH * 16 - 1 - bx) / G + 1 : 0);
            const int nctx = (l + 1 < DEPTH && bx < NB * NQH) ? (NB * NQH - 1 - bx) / G + 1 : 0;
#pragma unroll 1
            for (int i = 0; i < nlat + nctx; ++i) {
                size_t qoff, koff; int seq, lpos0;
                if (i < nlat) {
                    int b, h, qb;
                    if (G == 256) { const int combo = x8 + 8 * (i >> 1), un = (i & 1) * 32 + j32; b = combo >> 1; h = (combo & 1) * 4 + (un >> 4); qb = un & 15; }
                    else { const int u = bx + i * G; b = u >> 7; h = (u >> 4) & 7; qb = u & 15; }
                    qoff = ((size_t)b * SEQ + qb * 256) * DM + h * HD; koff = (size_t)b * KVLEN * KVW + (h >> 2) * HD; seq = KVLEN; lpos0 = qb * 256;
                } else {
                    const int u = bx + (i - nlat) * G, b = u >> 3, h = u & 7;
                    qoff = ((size_t)NLAT + b * CTXL) * DM + h * HD; koff = ((size_t)b * KVLEN + SEQ) * KVW + (h >> 2) * HD; seq = CTXL; lpos0 = -1;
                }
                att::attn_dense_body_dma((bf16_t*)((unsigned char*)(ws + WS_Q) + qoff), KB + koff, seq, (char*)lds_, lds, wave_s * 64 + lane_id_now(), (PROBE_PHASE == 4 && rep_ + 1 < PROBE_REPS) ? (long)WS_YG - (long)WS_Q : 0L, nm0,
                                         a.in[I_QNG] + (size_t)l * HD, (const float*)(ws + WS_ROPE), lpos0, (const unsigned char*)(ws + WS_K8) + koff, (const unsigned char*)(ws + WS_V8T) + (((size_t)(koff / ((size_t)KVLEN * KVW)) * NKVH + (koff % KVW) / HD) * (KVLEN / 64) + (seq == KVLEN ? 0 : SEQ / 64)) * 8192, (unsigned char*)(ws + WS_XN2) + qoff);
            }
        }
        SEAM(pb + 2);
        if (DG(5) && IN(pb + 3)) REPS(5) { PHASE_IDS
            pg8::Gemm g{UCAT, (const bf16_t*)(ws + WS_WCAT)}; pg8::BatchOrder S; S.init(l + 1 < DEPTH ? NCOLP / 256 : NCOLP / 256 - 1, 2, SG, G, (G % 8 == 0) ? (bx % 8) * (G / 8) + bx / 8 : bx, l + 1 < DEPTH ? NCOLP / 256 - 1 : -1);
            pg8::EpiS3 E{UCAT, a.in[I_SD] + (size_t)l * SSMW, YG};
            pg8::gemm_phase<KCAT / 2, KCAT / 2, KCAT / 2, (size_t)NCOLP * KCAT, (size_t)512 * KCAT, true>(lds, g, S, E, tid);
        }
        SEAM(pb + 3);
        if (DG(6) && IN(pb + 4)) REPS(6) { PHASE_IDS
            pg8::Gemm g{YG, (const bf16_t*)(ws + WS_WIN8 + W8_GLU + (size_t)l * SSMW * SSMW)}; pg8::SplitOrder S; S.init(MR, SSMW, G, bx);
            pg8::EpiGlu E{YG, a.in[I_BGLU] + (size_t)l * SSMW, SSMO};
            pg8::gemm_phase<SSMW / 2, SSMW / 2, SSMW / 2, 0, 0, true>(lds, g, S, E, tid);
        }
        SEAM(pb + 4);
        if (DG(7) && IN(pb + 5)) REPS(7) { PHASE_IDS
            pg8::SplitOrder S; S.init(MR, DM, G, bx);
            const unsigned char* w8 = ws + WS_WIN8 + W8_MIX + (size_t)l * W8_MIX_LAYER;
            { pg8::Gemm g{XN2, (const bf16_t*)(w8 + W8_BA)}; pg8::EpiMerge<false> E{GA, Y, (unsigned char*)(ws + WS_Q), 1.0f / WSCALE8}; pg8::gemm_phase<DM / 2, DM / 2, DM / 2, 0, 0, true>(lds, g, S, E, tid); }
            { pg8::Gemm g{SSMO, (const bf16_t*)(w8 + W8_BS)}; pg8::EpiMerge<true> E{GBb, Y, (unsigned char*)(ws + WS_Q), 1.0f / WSCALE8}; pg8::gemm_phase<SSMW / 2, SSMW / 2, SSMW / 2, 0, 0, true>(lds, g, S, E, tid); }
        }
        SEAM(pb + 5);
        if (DG(8) && IN(pb + 6)) REPS(8) { PHASE_IDS
            pg8::Gemm g{Qb, (const bf16_t*)(ws + WS_WIN8 + W8_MIX + (size_t)l * W8_MIX_LAYER + W8_O)}; pg8::SplitOrder S; S.init(MR, DM, G, bx);
            pg8::EpiWo E{l == 0 ? a.in[I_X] : (const float*)nullptr, (bf16_t*)(ws + WS_HB), mod + 2 * DM};
            pg8::gemm_phase<DM / 2, DM / 2, DM / 2, 0, 0, true>(lds, g, S, E, tid);
        }
        SEAM(pb + 6);
        if (DG(9) && IN(pb + 7)) REPS(9) { PHASE_IDS norm_pass(a, l, 1, XN2, gw, NGW, lane, MR, a.out); }
        SEAM(pb + 7);
        if (DG(10) && IN(pb + 8)) REPS(10) { PHASE_IDS
            pg8::Gemm g{XN2, (const bf16_t*)(wl + WT_Q)}; pg8::SplitOrder S; S.init(MR, PQW, G, bx);
            pg8::EpiBf16 E{PQ, PQW};
            pg8::gemm_phase<DM, DM, DM, 0, 0>(lds, g, S, E, tid);
        }
        SEAM(pb + 8);
        if (DG(11) && IN(pb + 9)) REPS(11) { PHASE_IDS peer_topk(a, l, lds, gw, NGW, tid, MR, PROBE_PHASE == 11 && rep_ + 1 < PROBE_REPS); }
        SEAM(pb + 9);
    }
#undef IN
#undef SEAM
}

extern "C" void kernel_launch(void* const* d_in, const int* in_sizes, int n_in, void* d_out, int out_size, void* d_ws, size_t ws_size, hipStream_t stream) {
    static int grid = 0;
    if (grid == 0) {
        if (n_in != 28 || out_size != NLAT * DM || ws_size < WS_END) { fprintf(stderr, "kernel_launch: unexpected shapes (n_in %d out %d ws %zu, need ws >= %zu)\n", n_in, out_size, ws_size, (size_t)WS_END); grid = -1; return; }
        int dev = 0, cus = 0;
        if (hipGetDevice(&dev) != hipSuccess || hipDeviceGetAttribute(&cus, hipDeviceAttributeMultiprocessorCount, dev) != hipSuccess) { grid = -1; return; }
        if (hipFuncSetAttribute((const void*)mega_fwd, hipFuncAttributeMaxDynamicSharedMemorySize, LDS_BYTES) != hipSuccess) { fprintf(stderr, "kernel_launch: hipFuncSetAttribute failed\n"); grid = -1; return; }
        int per_cu = 0;
        if (hipOccupancyMaxActiveBlocksPerMultiprocessor(&per_cu, (const void*)mega_fwd, 512, LDS_BYTES) != hipSuccess || per_cu < 1) fprintf(stderr, "kernel_launch: occupancy query reports %d\n", per_cu);
        (void)hipGetLastError();
        grid = cus;
    }
    if (grid < 0) return;
    (void)hipMemsetAsync((char*)d_ws + WS_CTL, 0, CTL_ZERO_BYTES, stream);
    Args a{};
    for (int i = 0; i < 28; ++i) a.in[i] = (const float*)d_in[i];
    a.out = (float*)d_out; a.ws = (unsigned char*)d_ws;
#if MK_MULTI
    for (int p = 0; p < NPHASE; ++p) { a.ph_lo = p; a.ph_hi = p + 1; hipLaunchKernelGGL(mega_fwd, dim3(grid), dim3(512), LDS_BYTES, stream, a); }
#else
    a.ph_lo = 0; a.ph_hi = NPHASE;
    hipLaunchKernelGGL(mega_fwd, dim3(grid), dim3(512), LDS_BYTES, stream, a);
#endif
    const hipError_t le = hipPeekAtLastError();
    if (le != hipSuccess) fprintf(stderr, "kernel_launch: launch failed: %s\n", hipGetErrorName(le));
}
```
